# Optimizing an MI355X kernel written in HIP

```python
import jax
import jax.numpy as jnp
from jax import lax
import numpy as np

D_MODEL = 2048
BATCH = 16
SEQ = 256
DEPTH = 2
DEC_BATCH = 8
DEC_SEQ = 1024
PAST_LEN = 512

GRID_W = 64
N_BRANCH = 4
BRANCH_W = D_MODEL // N_BRANCH
NA_HEAD_DIM = 64
NA_HEADS = BRANCH_W // NA_HEAD_DIM
NA_WIN_ROWS = 8
NA_WIN_COLS = 16
RPB_ROWS = 2 * NA_WIN_ROWS - 1
RPB_COLS = 2 * NA_WIN_COLS - 1
ROPE_BASE = 10000.0
ATTN_BLOCK = 128
GMLP_CHUNK = 128
GMLP_GROUPS = 4
GMLP_GROUP_CH = BRANCH_W // GMLP_GROUPS
FNET_GROUPS = 4
FNET_GROUP_CH = BRANCH_W // FNET_GROUPS
POOL_WINDOWS = (2, 4, 8, 16)
POOL_GROUP_CH = BRANCH_W // len(POOL_WINDOWS)
MIX_WIDTH = N_BRANCH * BRANCH_W
D_FF = 4 * D_MODEL
EPS = 1e-6
NEG_INF = -1e30
IN_COLS = 7 * BRANCH_W + N_BRANCH * D_MODEL
SPLIT_POINTS = tuple(BRANCH_W * i for i in range(1, 8))

kernel_name = 'hybrid_diffusion_trunk_step'


def rmsnorm(x, g):
    xf = x.astype(jnp.float32)
    y = xf * lax.rsqrt(jnp.mean(xf * xf, axis=-1, keepdims=True) + EPS)
    return (y * g.astype(jnp.float32)).astype(x.dtype)


def axial_angles(n):
    t = jnp.arange(n)
    pos = jnp.stack([t // GRID_W, t % GRID_W], axis=-1).astype(jnp.float32)
    half = NA_HEAD_DIM // 2
    inv = 1.0 / (ROPE_BASE ** (jnp.arange(0, half, 2, dtype=jnp.float32) / half))
    return pos[:, :, None] * inv


def apply_axial_rope(x, ang):
    B, N, H, Dh = x.shape
    xs = x.astype(jnp.float32).reshape(B, N, H, 2, 2, Dh // 4)
    cos = jnp.cos(ang)[None, :, None]
    sin = jnp.sin(ang)[None, :, None]
    x1 = xs[..., 0, :]
    x2 = xs[..., 1, :]
    out = jnp.stack([x1 * cos - x2 * sin, x1 * sin + x2 * cos], axis=-2)
    return out.reshape(x.shape).astype(x.dtype)


def context_attention(q, k, v):
    B, S, H, Dh = q.shape
    nb = S // ATTN_BLOCK
    scale = Dh ** -0.5
    kt = k.transpose(0, 2, 1, 3)
    vt = v.transpose(0, 2, 1, 3)
    qb = q.reshape(B, nb, ATTN_BLOCK, H, Dh).transpose(1, 0, 2, 3, 4)

    def block(qi):
        s = jnp.einsum('bqhd,bhkd->bhqk', qi, kt).astype(jnp.float32) * scale
        p = jax.nn.softmax(s, axis=-1).astype(vt.dtype)
        return jnp.einsum('bhqk,bhkd->bqhd', p, vt)

    o = lax.map(block, qb)
    return o.transpose(1, 0, 2, 3, 4).reshape(B, S, H * Dh), kt, vt


def latent_neighbourhood_attention(q, k, v, k_ctx, v_ctx, rpb):
    B, N, H, Dh = q.shape
    rows = N // GRID_W
    wr = min(NA_WIN_ROWS, rows)
    scale = Dh ** -0.5
    ang = axial_angles(N)
    qr = apply_axial_rope(q, ang).reshape(B, rows, GRID_W, H, Dh)
    kr = apply_axial_rope(k, ang).reshape(B, rows, GRID_W, H, Dh)
    qp = q.reshape(B, rows, GRID_W, H, Dh)
    vg = v.reshape(B, rows, GRID_W, H, Dh)
    cq = jnp.arange(GRID_W)
    cs = jnp.clip(cq - NA_WIN_COLS // 2, 0, GRID_W - NA_WIN_COLS)
    kc = jnp.arange(GRID_W)
    col_ok = (kc[None, :] >= cs[:, None]) & (kc[None, :] < cs[:, None] + NA_WIN_COLS)
    col_mask = jnp.where(col_ok, 0.0, NEG_INF).astype(jnp.float32)
    dc_idx = jnp.clip(kc[None, :] - cq[:, None], -(NA_WIN_COLS - 1), NA_WIN_COLS - 1) + NA_WIN_COLS - 1
    rpb_c = rpb[:, :, dc_idx]

    def row_block(r):
        rs = jnp.clip(r - NA_WIN_ROWS // 2, 0, rows - wr)
        q_r = lax.dynamic_index_in_dim(qr, r, axis=1, keepdims=False)
        qp_r = lax.dynamic_index_in_dim(qp, r, axis=1, keepdims=False)
        k_b = lax.dynamic_slice_in_dim(kr, rs, wr, axis=1)
        v_b = lax.dynamic_slice_in_dim(vg, rs, wr, axis=1)
        dr_idx = rs + jnp.arange(wr) - r + NA_WIN_ROWS - 1
        bias = jnp.take(rpb_c, dr_idx, axis=1).transpose(0, 2, 1, 3).astype(jnp.float32)
        bias = bias + col_mask[None, :, None, :]
        s_loc = jnp.einsum('bqhd,bwkhd->bhqwk', q_r, k_b).astype(jnp.float32) * scale + bias[None]
        s_ctx = jnp.einsum('bqhd,bhld->bhql', qp_r, k_ctx).astype(jnp.float32) * scale
        s = jnp.concatenate([s_loc.reshape(B, H, GRID_W, wr * GRID_W), s_ctx], axis=-1)
        p = jax.nn.softmax(s, axis=-1).astype(v.dtype)
        p_loc = p[..., :wr * GRID_W].reshape(B, H, GRID_W, wr, GRID_W)
        p_ctx = p[..., wr * GRID_W:]
        return (jnp.einsum('bhqwk,bwkhd->bqhd', p_loc, v_b)
                + jnp.einsum('bhql,bhld->bqhd', p_ctx, v_ctx))

    o = lax.map(row_block, jnp.arange(rows))
    return o.transpose(1, 0, 2, 3, 4).reshape(B, N, H * Dh)


def spatial_gating(u, vg, norm_g, w_s, b_s):
    B, N, _ = u.shape
    u = jax.nn.gelu(u)
    vg = rmsnorm(jax.nn.gelu(vg), norm_g)
    vc = vg.reshape(B, N // GMLP_CHUNK, GMLP_CHUNK, GMLP_GROUPS, GMLP_GROUP_CH)
    mixed = jnp.einsum('gpq,bnqgc->bnpgc', w_s, vc) + b_s.T[None, None, :, :, None]
    return u * mixed.reshape(B, N, BRANCH_W)


def fourier_mix(xf):
    B, N, _ = xf.shape
    z = xf.astype(jnp.float32).reshape(B, N, FNET_GROUPS, FNET_GROUP_CH)
    y = jnp.fft.fft2(z, axes=(1, 3), norm='ortho').real
    return y.reshape(B, N, BRANCH_W).astype(xf.dtype)


def multiscale_pool(xp, w_pool, pool_scale):
    B, N, _ = xp.shape
    xf = xp.astype(jnp.float32).reshape(B, N, len(POOL_WINDOWS), POOL_GROUP_CH)
    csum = jnp.concatenate([jnp.zeros_like(xf[:, :1]), jnp.cumsum(xf, axis=1)], axis=1)
    t = jnp.arange(N)
    means = []
    for gi, w in enumerate(POOL_WINDOWS):
        lo = jnp.clip(t - w // 2, 0, N - 1)
        hi = jnp.clip(t + w // 2 - 1, 0, N - 1)
        cg = csum[:, :, gi]
        s = jnp.take(cg, hi + 1, axis=1) - jnp.take(cg, lo, axis=1)
        means.append(s / (hi - lo + 1).astype(jnp.float32)[None, :, None])
    pooled = (jnp.stack(means, axis=2) - xf).astype(xp.dtype)
    y = jnp.einsum('bngc,gcd->bngd', pooled, w_pool).reshape(B, N, BRANCH_W)
    return y * pool_scale


def token_mixers(h, ctx_kv, w_in, b_gate, q_norm_g, k_norm_g, rpb, gmlp_norm_g,
                 w_spatial, b_spatial, w_pool, pool_scale, w_branch, w_out):
    B, N, _ = h.shape
    q, k, v, u, vg, xf, xp, gl = jnp.split(h @ w_in, SPLIT_POINTS, axis=-1)
    q = rmsnorm(q.reshape(B, N, NA_HEADS, NA_HEAD_DIM), q_norm_g)
    k = rmsnorm(k.reshape(B, N, NA_HEADS, NA_HEAD_DIM), k_norm_g)
    v = v.reshape(B, N, NA_HEADS, NA_HEAD_DIM)
    if ctx_kv is None:
        a, kt, vt = context_attention(q, k, v)
        kv = (kt, vt)
    else:
        a = latent_neighbourhood_attention(q, k, v, ctx_kv[0], ctx_kv[1], rpb)
        kv = None
    branches = (a,
                spatial_gating(u, vg, gmlp_norm_g, w_spatial, b_spatial),
                fourier_mix(xf),
                multiscale_pool(xp, w_pool, pool_scale))
    gates = jax.nn.sigmoid(gl + b_gate).reshape(B, N, N_BRANCH, D_MODEL)
    merged = gates[:, :, 0] * (branches[0] @ w_branch[0:BRANCH_W])
    for i in range(1, N_BRANCH):
        merged = merged + gates[:, :, i] * (branches[i] @ w_branch[i * BRANCH_W:(i + 1) * BRANCH_W])
    return merged @ w_out, kv


def trunk_layer(x, cond, ctx_kv, norm1_g, w_in, b_gate, q_norm_g, k_norm_g, rpb, gmlp_norm_g,
                w_spatial, b_spatial, w_pool, pool_scale, w_branch, w_out, norm2_g,
                w_mlp1, w_mlp2, w_ada, b_ada):
    m = jax.nn.silu(cond) @ w_ada + b_ada
    sh1, sc1, g1, sh2, sc2, g2 = [t[:, None, :] for t in jnp.split(m, 6, axis=-1)]
    h = rmsnorm(x, norm1_g) * (1 + sc1) + sh1
    mix, kv = token_mixers(h, ctx_kv, w_in, b_gate, q_norm_g, k_norm_g, rpb, gmlp_norm_g,
                           w_spatial, b_spatial, w_pool, pool_scale, w_branch, w_out)
    x = x + g1 * mix
    h2 = rmsnorm(x, norm2_g) * (1 + sc2) + sh2
    x = x + g2 * (jnp.square(jax.nn.relu(h2 @ w_mlp1)) @ w_mlp2)
    return x, kv


def setup_inputs(seed: int = 0) -> dict:
    key = jax.random.key(seed)
    ks = jax.random.split(key, 24)
    f32 = jnp.float32
    nrm = lambda k, shape, s: jax.random.normal(k, shape, f32) * s
    kv_shape = (DEC_BATCH, DEPTH, NA_HEADS, PAST_LEN, NA_HEAD_DIM)
    return {
        'x_prompt': nrm(ks[0], (BATCH, SEQ, D_MODEL), 1.0),
        'x_sample': nrm(ks[1], (DEC_BATCH, DEC_SEQ, D_MODEL), 1.0),
        'cache_k': nrm(ks[2], kv_shape, 1.0),
        'cache_v': nrm(ks[3], kv_shape, 1.0),
        'c': nrm(ks[4], (DEC_BATCH, D_MODEL), 1.0),
        'c_ctx': nrm(ks[5], (D_MODEL,), 1.0),
        'norm1_g': 1.0 + nrm(ks[6], (DEPTH, D_MODEL), 0.02),
        'w_in': nrm(ks[7], (DEPTH, D_MODEL, IN_COLS), D_MODEL ** -0.5),
        'b_gate': nrm(ks[8], (DEPTH, N_BRANCH * D_MODEL), 0.02),
        'q_norm_g': 1.0 + nrm(ks[9], (DEPTH, NA_HEAD_DIM), 0.02),
        'k_norm_g': 1.0 + nrm(ks[10], (DEPTH, NA_HEAD_DIM), 0.02),
        'rpb': nrm(ks[11], (DEPTH, NA_HEADS, RPB_ROWS, RPB_COLS), 0.1),
        'gmlp_norm_g': 1.0 + nrm(ks[12], (DEPTH, BRANCH_W), 0.02),
        'w_spatial': nrm(ks[13], (DEPTH, GMLP_GROUPS, GMLP_CHUNK, GMLP_CHUNK), GMLP_CHUNK ** -0.5),
        'b_spatial': 1.0 + nrm(ks[14], (DEPTH, GMLP_GROUPS, GMLP_CHUNK), 0.02),
        'w_pool': nrm(ks[15], (DEPTH, len(POOL_WINDOWS), POOL_GROUP_CH, POOL_GROUP_CH), POOL_GROUP_CH ** -0.5),
        'pool_scale': 1.0 + nrm(ks[16], (DEPTH, BRANCH_W), 0.02),
        'w_branch': nrm(ks[17], (DEPTH, MIX_WIDTH, D_MODEL), BRANCH_W ** -0.5),
        'w_out': nrm(ks[18], (DEPTH, D_MODEL, D_MODEL), D_MODEL ** -0.5),
        'norm2_g': 1.0 + nrm(ks[19], (DEPTH, D_MODEL), 0.02),
        'w_mlp1': nrm(ks[20], (DEPTH, D_MODEL, D_FF), D_MODEL ** -0.5),
        'w_mlp2': nrm(ks[21], (DEPTH, D_FF, D_MODEL), D_FF ** -0.5),
        'w_ada': nrm(ks[22], (DEPTH, D_MODEL, 6 * D_MODEL), D_MODEL ** -0.5),
        'b_ada': nrm(ks[23], (DEPTH, 6 * D_MODEL), 0.02),
    }


def reference(x_prompt, x_sample, cache_k, cache_v, c, c_ctx, norm1_g, w_in, b_gate,
              q_norm_g, k_norm_g, rpb, gmlp_norm_g, w_spatial, b_spatial, w_pool, pool_scale,
              w_branch, w_out, norm2_g, w_mlp1, w_mlp2, w_ada, b_ada):
    layer_weights = (norm1_g, w_in, b_gate, q_norm_g, k_norm_g, rpb, gmlp_norm_g, w_spatial,
                     b_spatial, w_pool, pool_scale, w_branch, w_out, norm2_g, w_mlp1, w_mlp2,
                     w_ada, b_ada)
    yp = x_prompt
    new_k = []
    new_v = []
    for l in range(DEPTH):
        yp, (k_l, v_l) = trunk_layer(yp, c_ctx[None, :], None, *[w[l] for w in layer_weights])
        new_k.append(k_l)
        new_v.append(v_l)
    ys = x_sample
    for l in range(DEPTH):
        ys, _ = trunk_layer(ys, c, (cache_k[:, l], cache_v[:, l]), *[w[l] for w in layer_weights])
    new_cache_k = jnp.stack(new_k, axis=1)
    new_cache_v = jnp.stack(new_v, axis=1)
    return (yp, ys, new_cache_k, new_cache_v)
```

```cpp
#include <hip/hip_runtime.h>
#include <hip/hip_cooperative_groups.h>
#include <cstdio>
#include <cstdint>
namespace cg = cooperative_groups;


#ifndef N_LAUNCH_MODE
#define N_LAUNCH_MODE 1
#endif

#define LAS __attribute__((address_space(3)))
typedef unsigned short bf16_t;
typedef short bf16x8 __attribute__((ext_vector_type(8)));
typedef float f32x4 __attribute__((ext_vector_type(4)));
typedef float f32x2 __attribute__((ext_vector_type(2)));
typedef unsigned u32x4 __attribute__((ext_vector_type(4)));
typedef unsigned u32x2 __attribute__((ext_vector_type(2)));

constexpr int DM = 2048, NTOK = 12288, NCTXT = 4096, DFF = 8192, INC = 11776;
constexpr int NCOND = 9;
constexpr size_t MiB = 1u << 20;
constexpr size_t O_CTL = 0, O_WINT = 1 * MiB, O_WBT = 97 * MiB, O_WOT = 113 * MiB, O_W1T = 129 * MiB, O_W2T = 193 * MiB,
                 O_WFN = 257 * MiB, O_WBD = 261 * MiB, O_BDP = 265 * MiB, O_CS = 266 * MiB, O_DFT256 = 267 * MiB, O_DFT1024 = 268 * MiB,
                 O_WSB = 272 * MiB, O_MODP = 273 * MiB, O_MOD = 287 * MiB, O_CK = 288 * MiB, O_VTC = 296 * MiB, O_H = 304 * MiB,
                 O_ZM = 352 * MiB, O_ZG = 448 * MiB, O_QP = 640 * MiB, O_QR = 652 * MiB, O_KB = 660 * MiB, O_VT = 672 * MiB,
                 O_VNT = 684 * MiB, O_TT = 696 * MiB, O_BR = 720 * MiB, WS_NEED = 768 * MiB;
constexpr size_t OUTK = (size_t)NTOK * DM, OUTV = OUTK + (size_t)16 * 2 * 8 * 256 * 64;
constexpr int LDS_BYTES = 147456;
constexpr int NPHASE = 2 + 9 * 2;

struct Args { const float* in[24]; float* out; unsigned char* ws; int ph_lo, ph_hi; };
enum { I_XP = 0, I_XS, I_CK, I_CV, I_C, I_CCTX, I_N1G, I_WIN, I_BGATE, I_QNG, I_KNG, I_RPB, I_GNG, I_WSP, I_BSP, I_WPOOL, I_PSC, I_WBR, I_WOUT, I_N2G, I_W1, I_W2, I_WADA, I_BADA };

typedef __bf16 bf16x2_t __attribute__((ext_vector_type(2)));
__device__ __forceinline__ unsigned cvt_pk_bf16(float lo, float hi) { const f32x2 v = {lo, hi}; const bf16x2_t b = __builtin_convertvector(v, bf16x2_t); return __builtin_bit_cast(unsigned, b); }
__device__ __forceinline__ float bf2f(unsigned short u) { return __uint_as_float(((unsigned)u) << 16); }
__device__ __forceinline__ float bflo(unsigned u) { return __uint_as_float(u << 16); }
__device__ __forceinline__ float bfhi(unsigned u) { return __uint_as_float(u & 0xffff0000u); }
__device__ __forceinline__ bf16_t f2bf(float f) { return (bf16_t)(cvt_pk_bf16(f, 0.f) & 0xffffu); }
__device__ __forceinline__ float wave_sum(float v) {
#pragma unroll
    for (int o = 1; o < 64; o <<= 1) v += __shfl_xor(v, o);
    return v;
}
__device__ __forceinline__ float fast_exp(float x) { return __builtin_amdgcn_exp2f(x * 1.44269504089f); }
__device__ __forceinline__ float sigmoidf_(float x) { return __builtin_amdgcn_rcpf(1.0f + fast_exp(-x)); }
__device__ __forceinline__ float gelu_tanh(float x) { const float u = 0.7978845608f * (x + 0.044715f * x * x * x); return x * sigmoidf_(2.0f * u); }
#define LDS_WAIT() asm volatile("s_waitcnt lgkmcnt(0)" ::: "memory")
#define VM_WAIT() asm volatile("s_waitcnt vmcnt(0)" ::: "memory")

namespace pg8 {
constexpr int BM = 256, BK = 64, HALF = 128, HTB = HALF * BK * 2, STAGE_BYTES = 8 * HTB;
__device__ __forceinline__ int lds_byte(int r, int c) { const int st = (r >> 4) * 2 + (c >> 5), rr = r & 15, cc = c & 31, ob = rr * 64 + cc * 2; return st * 1024 + (ob ^ (((ob >> 9) & 1) << 5)); }
__device__ __forceinline__ void stage_rc(int b, int& R, int& C) { const int st = b / 1024, sb = b % 1024, swz = sb ^ (((sb >> 9) & 1) << 5); R = (st >> 1) * 16 + swz / 64; C = (st & 1) * 32 + (swz % 64) / 2; }
__device__ __forceinline__ int perm32(int rho) { const int n = rho >> 4, i = rho & 15; return 8 * (i >> 2) + 4 * n + (i & 3); }

struct Unit { const char* A; const char* B; int orow0, orow1, ocol, aux; };
__device__ __forceinline__ void tile_map(int L, int nM, int nN, int& pm, int& pn) {
    const int nwg = nM * nN; int wgid = L;
    { const int q = nwg / 8, r = nwg % 8, xcd = wgid % 8, off = wgid / 8; wgid = (xcd < r ? xcd * (q + 1) : r * (q + 1) + (xcd - r) * q) + off; }
    const int nig = 8 * nN, gid = wgid / nig, fm = gid * 8, gsz = (nM - fm) < 8 ? (nM - fm) : 8;
    pm = fm + ((wgid % nig) % gsz); pn = (wgid % nig) / gsz;
}
template <class Epi, class Sched>
__device__ __forceinline__ void gemm_phase(LAS unsigned char* lds, const int lda, const int ldb, const int K, const Sched& S, const Epi& E) {
    int tid = threadIdx.x; asm volatile("" : "+v"(tid));
    const int wid = __builtin_amdgcn_readfirstlane(tid >> 6), lane = tid & 63, wr = wid >> 2, wc = wid & 3, fr = lane & 15, fq = lane >> 4;
    const int nt = K / BK;
    unsigned voffA[2], voffB[2];
#pragma unroll
    for (int i = 0; i < 2; ++i) { int R, C; stage_rc(tid * 16 + i * 8192, R, C); const int Rb = (R & ~31) + perm32(R & 31);
        voffA[i] = (unsigned)(R * lda + C) * 2u; voffB[i] = (unsigned)(Rb * ldb + C) * 2u; }
    const size_t kstep = (size_t)(BK * 2);
    const size_t hstepA = (size_t)HALF * lda * 2, hstepB = (size_t)HALF * ldb * 2;
    const unsigned ldsw = (unsigned)wid * 1024u;
    const int aoff = lds_byte(wr * 64 + fr, fq * 8), boff = lds_byte(wc * 32 + fr, fq * 8);
#define PG8_SA(b, h) (((b) * 2 + (h)) * HTB)
#define PG8_SB(b, h) ((4 + (b) * 2 + (h)) * HTB)
#define PG8_STAGE(bufoff, gbase, voff) do { _Pragma("unroll") for (int _i = 0; _i < 2; ++_i) \
        __builtin_amdgcn_global_load_lds((const unsigned*)((const char*)(gbase) + (voff)[_i]), (LAS unsigned*)(lds + (bufoff) + ldsw + _i * 8192), 16, 0, 0); } while (0)
#define PG8_LDA(dst, b, h) do { _Pragma("unroll") for (int m = 0; m < 4; ++m) _Pragma("unroll") for (int k = 0; k < 2; ++k) dst[m][k] = *(const LAS bf16x8*)(lds + PG8_SA(b, h) + aoff + m * 2048 + k * 1024); } while (0)
#define PG8_LDB(dst, b, h) do { _Pragma("unroll") for (int n = 0; n < 2; ++n) _Pragma("unroll") for (int k = 0; k < 2; ++k) dst[n][k] = *(const LAS bf16x8*)(lds + PG8_SB(b, h) + boff + n * 2048 + k * 1024); } while (0)
#define PG8_MMA(ai, bj, At, Bt) do { __builtin_amdgcn_s_setprio(1); _Pragma("unroll") for (int m = 0; m < 4; ++m) _Pragma("unroll") for (int n = 0; n < 2; ++n) _Pragma("unroll") for (int k = 0; k < 2; ++k) \
        acc[ai][bj][m][n] = __builtin_amdgcn_mfma_f32_16x16x32_bf16(Bt[n][k], At[m][k], acc[ai][bj][m][n], 0, 0, 0); __builtin_amdgcn_s_setprio(0); } while (0)
#define PG8_WAIT_V(n) asm volatile("s_waitcnt vmcnt(" #n ")" ::: "memory")
#define PG8_WAIT_L(n) asm volatile("s_waitcnt lgkmcnt(" #n ")" ::: "memory")
#define PG8_BAR __builtin_amdgcn_s_barrier()
#define PG8_SCHED __builtin_amdgcn_sched_barrier(0)
    Unit cur, nxt; int ui = 0;
    if (!S.next(0, cur)) return;
    f32x4 acc[2][2][4][2];
#pragma unroll
    for (int a = 0; a < 2; ++a)
#pragma unroll
        for (int b = 0; b < 2; ++b)
#pragma unroll
            for (int m = 0; m < 4; ++m)
#pragma unroll
                for (int n = 0; n < 2; ++n) acc[a][b][m][n] = (f32x4){0.f, 0.f, 0.f, 0.f};
    bf16x8 At[4][2], B0[2][2], B1[2][2];
    const char* cA = cur.A; const char* cB = cur.B;
    PG8_STAGE(PG8_SB(0, 0), cB, voffB); PG8_STAGE(PG8_SB(0, 1), cB + hstepB, voffB); PG8_STAGE(PG8_SA(0, 0), cA, voffA); PG8_STAGE(PG8_SA(0, 1), cA + hstepA, voffA);
    if (wr == 1) PG8_BAR;
    PG8_WAIT_V(2); PG8_BAR;
    PG8_STAGE(PG8_SB(1, 0), cB + kstep, voffB); PG8_STAGE(PG8_SA(1, 0), cA + kstep, voffA); PG8_STAGE(PG8_SB(1, 1), cB + hstepB + kstep, voffB);
    PG8_WAIT_V(6); PG8_BAR;
    for (;;) {
        const bool has_next = S.next(ui + 1, nxt);
        const char* nA = has_next ? nxt.A : cA; const char* nB = has_next ? nxt.B : cB;
        for (int t = 0; t < nt; t += 2) {
            const bool last = (t == nt - 2);
            const char* a1 = cA + (size_t)(t + 1) * kstep;
            const char* a2 = last ? nA : cA + (size_t)(t + 2) * kstep; const char* b2 = last ? nB : cB + (size_t)(t + 2) * kstep;
            const char* a3 = a2 + kstep; const char* b3 = b2 + kstep;
            PG8_LDB(B0, 0, 0); PG8_LDB(B1, 0, 1); PG8_SCHED; PG8_LDA(At, 0, 0); PG8_STAGE(PG8_SA(1, 1), a1 + hstepA, voffA);
            PG8_WAIT_V(8); PG8_WAIT_L(0); PG8_BAR; PG8_MMA(0, 0, At, B0); PG8_MMA(0, 1, At, B1); PG8_BAR; PG8_SCHED;
            PG8_LDA(At, 0, 1); PG8_STAGE(PG8_SB(0, 0), b2, voffB); PG8_STAGE(PG8_SB(0, 1), b2 + hstepB, voffB); PG8_STAGE(PG8_SA(0, 0), a2, voffA);
            PG8_WAIT_V(8); PG8_WAIT_L(0); PG8_BAR; PG8_MMA(1, 0, At, B0); PG8_MMA(1, 1, At, B1); PG8_BAR; PG8_SCHED;
            PG8_LDB(B0, 1, 0); PG8_LDB(B1, 1, 1); PG8_SCHED; PG8_LDA(At, 1, 0); PG8_STAGE(PG8_SA(0, 1), a2 + hstepA, voffA);
            PG8_WAIT_V(8); PG8_WAIT_L(0); PG8_BAR; PG8_MMA(0, 0, At, B0); PG8_MMA(0, 1, At, B1); PG8_BAR; PG8_SCHED;
            PG8_LDA(At, 1, 1); PG8_STAGE(PG8_SB(1, 0), b3, voffB); PG8_STAGE(PG8_SB(1, 1), b3 + hstepB, voffB); PG8_STAGE(PG8_SA(1, 0), a3, voffA);
            PG8_WAIT_V(8); PG8_WAIT_L(0); PG8_BAR; PG8_MMA(1, 0, At, B0); PG8_MMA(1, 1, At, B1); PG8_BAR; PG8_SCHED;
            if constexpr (Epi::MID) { if (((t + 2) & 7) == 0 && t + 2 < nt) E.mid(acc, cur, (t + 2) >> 3, wr, wc, fr, fq); }
        }
        if (wr == 0) PG8_BAR;
        E(acc, cur, wr, wc, fr, fq);
        if (!has_next) break;
#pragma unroll
        for (int a = 0; a < 2; ++a)
#pragma unroll
            for (int b = 0; b < 2; ++b)
#pragma unroll
                for (int m = 0; m < 4; ++m)
#pragma unroll
                    for (int n = 0; n < 2; ++n) acc[a][b][m][n] = (f32x4){0.f, 0.f, 0.f, 0.f};
        cur = nxt; cA = nA; cB = nB; ++ui;
        if (wr == 1) PG8_BAR;
    }
    PG8_WAIT_V(0);
    PG8_BAR;
#undef PG8_SA
#undef PG8_SB
#undef PG8_STAGE
#undef PG8_LDA
#undef PG8_LDB
#undef PG8_MMA
#undef PG8_WAIT_V
#undef PG8_WAIT_L
#undef PG8_BAR
#undef PG8_SCHED
}

struct SchedMN {
    const char* A; const char* B; int lda, ldb, nM, nN, G, c, ocol_off, lim, split, L0, nsplit, khalf_bytes;
    __device__ __forceinline__ bool next(int i, Unit& u) const {
        int L, kh = 0, aux = 0;
        if (!split) { L = i * G + c; if (c < 0 || L >= lim) return false; }
        else { if (i > 0 || c >= 2 * nsplit) return false; const int j = c >> 1; kh = c & 1; L = L0 + j; aux = (j << 2) | 2 | kh; }
        int pm, pn; tile_map(L, nM, nN, pm, pn);
        u.A = A + (size_t)pm * 256 * lda * 2 + (size_t)kh * khalf_bytes; u.B = B + (size_t)pn * 256 * ldb * 2 + (size_t)kh * khalf_bytes;
        u.orow0 = pm * 256; u.orow1 = pm * 256 + 128; u.ocol = pn * 256 + ocol_off; u.aux = aux; return true;
    }
};
struct SchedBR {
    const char* A; const char* B; int G, c;
    __device__ __forceinline__ bool next(int i, Unit& u) const {
#ifdef EXP_B3
        const int L = i * G + c; if (L >= 48 * 8) return false;
        const int b = 3; int pm, pn; tile_map(L, 48, 8, pm, pn);
#else
        const int L = (i >> 2) * G + c; if (L >= 48 * 8) return false;
        const int b = i & 3; int pm, pn; tile_map(L, 48, 8, pm, pn);
#endif
        u.A = A + (size_t)pm * 256 * 2048 * 2 + b * 1024; u.B = B + (size_t)pn * 256 * 2048 * 2 + b * 1024; u.orow0 = pm * 256; u.orow1 = pm * 256 + 128; u.ocol = pn * 256; u.aux = b; return true;
    }
};
struct SchedFold {
    const char* A0; const char* B0; int mode, c;
    __device__ __forceinline__ bool next(int i, Unit& u) const {
        if (i > 0 || c < 0) return false;
        if (mode == 0) { if (c >= 64) return false; const int l = c >> 5, g = (c >> 3) & 3, pn = c & 7;
            u.A = A0; u.B = B0 + ((size_t)(l * 4 + g) * 2048 + pn * 256) * 128 * 2; u.orow0 = l * 12288 + 2560 + g * 128; u.orow1 = l * 12288 + 3072 + g * 128; u.ocol = pn * 256; u.aux = g; }
        else { if (c >= 32) return false; const int l = c >> 4, pm = (c & 15) >> 1, pn = c & 1;
            u.A = A0 + ((size_t)l * 2048 + pm * 256) * 512 * 2; u.B = B0 + ((size_t)l * 512 + pn * 256) * 512 * 2; u.orow0 = l * 2048 + pm * 256; u.orow1 = u.orow0 + 128; u.ocol = 1536 + pn * 256; u.aux = 0; }
        return true;
    }
};
struct SchedDFT {
    const char* Amat; const char* TT; int latent, c;
    __device__ __forceinline__ bool next(int i, Unit& u) const {
        if (i > 0 || c < 0) return false;
        if (latent) { if (c >= 64) return false; const int bb = c >> 3, pm = (c & 7) >> 1, pn = c & 1;
            u.A = Amat + (size_t)pm * 256 * 2048 * 2; u.B = TT + ((size_t)bb * 512 + pn * 256) * 2048 * 2; u.orow0 = NCTXT + bb * 1024 + pm * 256; u.orow1 = u.orow0 + 128; u.ocol = 1024 + pn * 256; }
        else { if (c >= 32) return false; const int bb = c >> 1, pn = c & 1;
            u.A = Amat; u.B = TT + ((size_t)bb * 512 + pn * 256) * 512 * 2; u.orow0 = bb * 256; u.orow1 = u.orow0 + 128; u.ocol = 1024 + pn * 256; }
        u.aux = 0; return true;
    }
};

__device__ __forceinline__ u32x4 pack8(const f32x4 v0, const f32x4 v1) { u32x4 w; w.x = cvt_pk_bf16(v0[0], v0[1]); w.y = cvt_pk_bf16(v0[2], v0[3]); w.z = cvt_pk_bf16(v1[0], v1[1]); w.w = cvt_pk_bf16(v1[2], v1[3]); return w; }
struct EpiStore {
    static constexpr bool MID = false;
    bf16_t* O; int ldc;
    __device__ __forceinline__ void operator()(const f32x4 (&acc)[2][2][4][2], const Unit& u, int wr, int wc, int fr, int fq) const {
        asm volatile("" : "+v"(fr), "+v"(fq));
#pragma unroll
        for (int ai = 0; ai < 2; ++ai)
#pragma unroll
            for (int m = 0; m < 4; ++m) { bf16_t* rowp = O + (size_t)((ai ? u.orow1 : u.orow0) + wr * 64 + m * 16 + fr) * ldc + u.ocol + wc * 32 + 8 * fq;
#pragma unroll
                for (int bj = 0; bj < 2; ++bj) *(u32x4*)(rowp + bj * 128) = pack8(acc[ai][bj][m][0], acc[ai][bj][m][1]); }
    }
};
struct EpiZ {
    static constexpr bool MID = false;
    bf16_t* Zm; bf16_t* Zg; const float* bgate;
    __device__ __forceinline__ void operator()(const f32x4 (&acc)[2][2][4][2], const Unit& u, int wr, int wc, int fr, int fq) const {
        asm volatile("" : "+v"(fr), "+v"(fq));
        const int pn = u.ocol >> 8; const int cb = wc * 32 + 8 * fq;
        if (pn >= 16) {
            const int col0 = u.ocol - 4096 + cb;
            f32x4 bv[2][2];
#pragma unroll
            for (int bj = 0; bj < 2; ++bj)
#pragma unroll
                for (int n = 0; n < 2; ++n) bv[bj][n] = *(const f32x4*)(bgate + col0 + bj * 128 + 4 * n);
#pragma unroll
            for (int ai = 0; ai < 2; ++ai)
#pragma unroll
                for (int m = 0; m < 4; ++m) { bf16_t* rowp = Zg + (size_t)((ai ? u.orow1 : u.orow0) + wr * 64 + m * 16 + fr) * 8192 + col0;
#pragma unroll
                    for (int bj = 0; bj < 2; ++bj) { f32x4 v0 = acc[ai][bj][m][0] + bv[bj][0], v1 = acc[ai][bj][m][1] + bv[bj][1];
#pragma unroll
                        for (int e = 0; e < 4; ++e) { v0[e] = sigmoidf_(v0[e]); v1[e] = sigmoidf_(v1[e]); }
                        *(u32x4*)(rowp + bj * 128) = pack8(v0, v1); } }
        } else {
            const bool gel = (pn >= 6 && pn < 10);
#pragma unroll
            for (int ai = 0; ai < 2; ++ai)
#pragma unroll
                for (int m = 0; m < 4; ++m) { bf16_t* rowp = Zm + (size_t)((ai ? u.orow1 : u.orow0) + wr * 64 + m * 16 + fr) * 4096 + u.ocol + cb;
#pragma unroll
                    for (int bj = 0; bj < 2; ++bj) { f32x4 v0 = acc[ai][bj][m][0], v1 = acc[ai][bj][m][1];
                        if (gel) {
#pragma unroll
                            for (int e = 0; e < 4; ++e) { v0[e] = gelu_tanh(v0[e]); v1[e] = gelu_tanh(v1[e]); } }
                        *(u32x4*)(rowp + bj * 128) = pack8(v0, v1); } }
        }
    }
};
struct EpiHid {
    static constexpr bool MID = false;
    bf16_t* O;
    __device__ __forceinline__ void operator()(const f32x4 (&acc)[2][2][4][2], const Unit& u, int wr, int wc, int fr, int fq) const {
        asm volatile("" : "+v"(fr), "+v"(fq));
#pragma unroll
        for (int ai = 0; ai < 2; ++ai)
#pragma unroll
            for (int m = 0; m < 4; ++m) { bf16_t* rowp = O + (size_t)((ai ? u.orow1 : u.orow0) + wr * 64 + m * 16 + fr) * DFF + u.ocol + wc * 32 + 8 * fq;
#pragma unroll
                for (int bj = 0; bj < 2; ++bj) { f32x4 v0 = acc[ai][bj][m][0], v1 = acc[ai][bj][m][1];
#pragma unroll
                    for (int e = 0; e < 4; ++e) { const float a = fmaxf(v0[e], 0.f), b = fmaxf(v1[e], 0.f); v0[e] = a * a; v1[e] = b * b; }
                    *(u32x4*)(rowp + bj * 128) = pack8(v0, v1); } }
    }
};
__device__ __forceinline__ void ho_send(const f32x4 (&acc)[2][2][4][2], unsigned long long* sb, unsigned* flag, int tidp) {
#pragma unroll
    for (int ai = 0; ai < 2; ++ai)
#pragma unroll
        for (int m = 0; m < 4; ++m)
#pragma unroll
            for (int bj = 0; bj < 2; ++bj)
#pragma unroll
                for (int n = 0; n < 2; ++n) { const f32x4 v = acc[ai][bj][m][n]; unsigned long long* p = sb + (size_t)((((ai * 4 + m) * 2 + bj) * 2 + n) * 1024);
                    __hip_atomic_store(p, ((unsigned long long)__float_as_uint(v[1]) << 32) | __float_as_uint(v[0]), __ATOMIC_RELAXED, __HIP_MEMORY_SCOPE_AGENT);
                    __hip_atomic_store(p + 1, ((unsigned long long)__float_as_uint(v[3]) << 32) | __float_as_uint(v[2]), __ATOMIC_RELAXED, __HIP_MEMORY_SCOPE_AGENT); }
    asm volatile("s_waitcnt vmcnt(0)" ::: "memory");
    __syncthreads();
    if (tidp == 0) __hip_atomic_store(flag, 1u, __ATOMIC_RELEASE, __HIP_MEMORY_SCOPE_AGENT);
}
__device__ __forceinline__ void ho_wait(unsigned* flag, int tidp) {
    if (tidp == 0) { unsigned spin = 0; while (__hip_atomic_load(flag, __ATOMIC_ACQUIRE, __HIP_MEMORY_SCOPE_AGENT) == 0u) { __builtin_amdgcn_s_sleep(2); if (++spin > (1u << 24)) break; } }
    __syncthreads();
}
__device__ __forceinline__ f32x4 ho_get(unsigned long long* sb, int ai, int m, int bj, int n) {
    unsigned long long* p = sb + (size_t)((((ai * 4 + m) * 2 + bj) * 2 + n) * 1024);
    const unsigned long long a0 = __hip_atomic_load(p, __ATOMIC_RELAXED, __HIP_MEMORY_SCOPE_AGENT), a1 = __hip_atomic_load(p + 1, __ATOMIC_RELAXED, __HIP_MEMORY_SCOPE_AGENT);
    return (f32x4){__uint_as_float((unsigned)a0), __uint_as_float((unsigned)(a0 >> 32)), __uint_as_float((unsigned)a1), __uint_as_float((unsigned)(a1 >> 32))};
}
struct EpiRes {
    static constexpr bool MID = false;
    const float* xp; const float* xs; float* out; const float* mod; int gsel;
    float* S; unsigned* flags;
    __device__ __forceinline__ void operator()(const f32x4 (&acc)[2][2][4][2], const Unit& u, int wr, int wc, int fr, int fq) const {
        asm volatile("" : "+v"(fr), "+v"(fq));
        const int sp = u.aux & 2, jt = u.aux >> 2;
        const int tidp = (wr * 4 + wc) * 64 + fq * 16 + fr;
        unsigned long long* sb = (unsigned long long*)(S + (size_t)jt * 65536) + (size_t)tidp * 2;
        if (sp && (u.aux & 1)) { ho_send(acc, sb, flags + jt * 16, tidp); return; }
        if (sp) ho_wait(flags + jt * 16, tidp);
        const int pm = u.orow0 >> 8; const int cond = pm < 16 ? 0 : 1 + ((pm - 16) >> 2);
        const int col0 = u.ocol + wc * 32 + 8 * fq;
        const float* gp = mod + ((size_t)cond * 6 + gsel) * 2048 + col0;
        f32x4 gv[2][2];
#pragma unroll
        for (int bj = 0; bj < 2; ++bj)
#pragma unroll
            for (int n = 0; n < 2; ++n) gv[bj][n] = *(const f32x4*)(gp + bj * 128 + 4 * n);
        const float* src = pm < 16 ? xp : xs - (size_t)NCTXT * DM;
#pragma unroll
        for (int ai = 0; ai < 2; ++ai)
#pragma unroll
            for (int m = 0; m < 4; ++m) { const size_t off = (size_t)((ai ? u.orow1 : u.orow0) + wr * 64 + m * 16 + fr) * DM + col0;
#pragma unroll
                for (int bj = 0; bj < 2; ++bj)
#pragma unroll
                    for (int n = 0; n < 2; ++n) { const f32x4 xv = *(const f32x4*)(src + off + bj * 128 + 4 * n);
                        f32x4 v = acc[ai][bj][m][n];
                        if (sp) v += ho_get(sb, ai, m, bj, n);
                        *(f32x4*)(out + off + bj * 128 + 4 * n) = xv + gv[bj][n] * v; }
                if (m & 1) asm volatile("" ::: "memory"); }
    }
};
struct EpiBR {
    static constexpr bool MID = true;
    const bf16_t* Zg; bf16_t* merged; float* S; unsigned* flags;
    __device__ __forceinline__ void scale(f32x4 (&acc)[2][2][4][2], const Unit& u, int b, bool ratio, int wr, int wc, int fr, int fq) const {
        const int col0 = u.ocol + wc * 32 + 8 * fq;
#pragma unroll
        for (int ai = 0; ai < 2; ++ai) {
            u32x4 gw[4][2], nw[4][2];
#pragma unroll
            for (int m = 0; m < 4; ++m)
#pragma unroll
                for (int bj = 0; bj < 2; ++bj) { const bf16_t* gp = Zg + (size_t)((ai ? u.orow1 : u.orow0) + wr * 64 + m * 16 + fr) * 8192 + b * 2048 + col0 + bj * 128;
                    gw[m][bj] = *(const u32x4*)gp; if (ratio) nw[m][bj] = *(const u32x4*)(gp + 2048); }
#pragma unroll
            for (int m = 0; m < 4; ++m)
#pragma unroll
                for (int bj = 0; bj < 2; ++bj) { const u32x4 g4 = gw[m][bj];
                    float g[8] = {bflo(g4.x), bfhi(g4.x), bflo(g4.y), bfhi(g4.y), bflo(g4.z), bfhi(g4.z), bflo(g4.w), bfhi(g4.w)};
#pragma unroll
                    for (int e = 0; e < 8; ++e) g[e] = fmaxf(g[e], 1e-6f);
                    if (ratio) { const u32x4 n4 = nw[m][bj];
                        const float gn[8] = {bflo(n4.x), bfhi(n4.x), bflo(n4.y), bfhi(n4.y), bflo(n4.z), bfhi(n4.z), bflo(n4.w), bfhi(n4.w)};
#pragma unroll
                        for (int e = 0; e < 8; ++e) g[e] *= __builtin_amdgcn_rcpf(fmaxf(gn[e], 1e-6f)); }
                    f32x4 v0 = acc[ai][bj][m][0], v1 = acc[ai][bj][m][1];
                    v0[0] *= g[0]; v0[1] *= g[1]; v0[2] *= g[2]; v0[3] *= g[3]; v1[0] *= g[4]; v1[1] *= g[5]; v1[2] *= g[6]; v1[3] *= g[7];
                    acc[ai][bj][m][0] = v0; acc[ai][bj][m][1] = v1; }
            asm volatile("" ::: "memory"); }
    }
    __device__ __forceinline__ void mid(f32x4 (&acc)[2][2][4][2], const Unit& u, int seg, int wr, int wc, int fr, int fq) const {
        asm volatile("" : "+v"(fr), "+v"(fq));
        const int base = (u.aux & 2) ? (u.aux & 1) * 2 : 0;
        scale(acc, u, base + seg - 1, true, wr, wc, fr, fq);
    }
    __device__ __forceinline__ void operator()(f32x4 (&acc)[2][2][4][2], const Unit& u, int wr, int wc, int fr, int fq) const {
        asm volatile("" : "+v"(fr), "+v"(fq));
        const int sp = u.aux & 2, kh = u.aux & 1, jt = u.aux >> 2;
        const int tidp = (wr * 4 + wc) * 64 + fq * 16 + fr;
        unsigned long long* sb = (unsigned long long*)(S + (size_t)jt * 65536) + (size_t)tidp * 2;
        scale(acc, u, sp ? kh * 2 + 1 : 3, false, wr, wc, fr, fq);
        if (sp && kh) { ho_send(acc, sb, flags + jt * 16, tidp); return; }
        if (sp) ho_wait(flags + jt * 16, tidp);
        const int col0 = u.ocol + wc * 32 + 8 * fq;
#pragma unroll
        for (int ai = 0; ai < 2; ++ai)
#pragma unroll
            for (int m = 0; m < 4; ++m) { const size_t row = (size_t)((ai ? u.orow1 : u.orow0) + wr * 64 + m * 16 + fr);
#pragma unroll
                for (int bj = 0; bj < 2; ++bj) { f32x4 v0 = acc[ai][bj][m][0], v1 = acc[ai][bj][m][1];
                    if (sp) { v0 += ho_get(sb, ai, m, bj, 0); v1 += ho_get(sb, ai, m, bj, 1); }
                    *(u32x4*)(merged + row * DM + col0 + bj * 128) = pack8(v0, v1); }
                asm volatile("" ::: "memory"); }
    }
};
}

__device__ __forceinline__ void transpose_item(const float* W, int N, int k0, int n0, bf16_t* D, int ldo, int dn0, int dk0, LAS float* scr, int lane) {
#pragma unroll 8
    for (int i = 0; i < 32; ++i) { const int kk = 2 * i + (lane >> 5); scr[kk * 33 + (lane & 31)] = W[(size_t)(k0 + kk) * N + n0 + (lane & 31)]; }
    LDS_WAIT(); asm volatile("" ::: "memory");
    const int c = lane & 7;
#pragma unroll
    for (int j = 0; j < 4; ++j) { const int n = (lane >> 3) + 8 * j; const LAS float* s = scr + (8 * c) * 33 + n;
        u32x4 o; o.x = cvt_pk_bf16(s[0 * 33], s[1 * 33]); o.y = cvt_pk_bf16(s[2 * 33], s[3 * 33]); o.z = cvt_pk_bf16(s[4 * 33], s[5 * 33]); o.w = cvt_pk_bf16(s[6 * 33], s[7 * 33]);
        *(u32x4*)(D + (size_t)(dn0 + n) * ldo + dk0 + 8 * c) = o; }
    LDS_WAIT(); asm volatile("" ::: "memory");
}

__device__ __forceinline__ void phase_p0(const Args& a, LAS unsigned char* lds, int tid, int lane, int wave, int G, int bid) {
    unsigned char* ws = a.ws;
    LAS float* scr = (LAS float*)(lds + wave * 16384);
    const int gw = bid * 8 + wave, NGW = G * 8;
    if (bid == 0 && tid < 16) ((unsigned*)(ws + O_CTL))[64 * tid] = 0u;
    if (bid == 0 && tid < 32) ((unsigned*)(ws + O_CTL))[1024 + 64 * tid] = 0u;
    constexpr int IT_WIN = 32 * 368, IT_WBR = 32 * 64, IT_WOUT = 32 * 64, IT_W1 = 32 * 256, IT_W2 = 128 * 64, IT_L = IT_WIN + IT_WBR + IT_WOUT + IT_W1 + IT_W2;
    constexpr int IT_CV = 128 * 16;
    for (int it = gw; it < 2 * IT_L + IT_CV; it += NGW) {
        if (it >= 2 * IT_L) {
            const int r = it - 2 * IT_L, mtx = r >> 4, kb = (r >> 1) & 7, nb = r & 1;
            transpose_item(a.in[I_CV] + (size_t)mtx * 512 * 64, 64, kb * 64, nb * 32, (bf16_t*)(ws + O_VTC) + (size_t)mtx * 64 * 512, 512, nb * 32, kb * 64, scr, lane);
            continue;
        }
        const int l = it / IT_L; int r = it % IT_L;
        if (r < IT_WIN) {
            const int kb = r / 368, nb = r % 368, k0 = kb * 64, n0 = nb * 32;
            const float* W = a.in[I_WIN] + (size_t)l * DM * INC;
            if (n0 >= 2560 && n0 < 3072) {
                const int g = (n0 - 2560) >> 7, c0 = (n0 - 2560) & 127;
                bf16_t* D = (bf16_t*)(ws + O_WFN) + ((size_t)(l * 4 + g) * 2048) * 128;
#pragma unroll 8
                for (int i = 0; i < 32; ++i) { const int kk = 2 * i + (lane >> 5); D[(size_t)(k0 + kk) * 128 + c0 + (lane & 31)] = f2bf(W[(size_t)(k0 + kk) * INC + n0 + (lane & 31)]); }
            } else {
                const int dn0 = n0 < 2560 ? n0 : n0 + 512;
                transpose_item(W, INC, k0, n0, (bf16_t*)(ws + O_WINT) + (size_t)l * 12288 * 2048, 2048, dn0, k0, scr, lane);
            }
            continue;
        } r -= IT_WIN;
        if (r < IT_WBR) {
            const int kb = r / 64, nb = r % 64, k0 = kb * 64, n0 = nb * 32;
            const float* W = a.in[I_WBR] + (size_t)l * DM * DM;
            if (k0 < 1536) transpose_item(W, DM, k0, n0, (bf16_t*)(ws + O_WBT) + (size_t)l * DM * DM, 2048, n0, k0, scr, lane);
            else transpose_item(W, DM, k0, n0, (bf16_t*)(ws + O_WBD) + (size_t)l * DM * 512, 512, n0, k0 - 1536, scr, lane);
            continue;
        } r -= IT_WBR;
        if (r < IT_WOUT) { const int kb = r / 64, nb = r % 64; transpose_item(a.in[I_WOUT] + (size_t)l * DM * DM, DM, kb * 64, nb * 32, (bf16_t*)(ws + O_WOT) + (size_t)l * DM * DM, 2048, nb * 32, kb * 64, scr, lane); continue; } r -= IT_WOUT;
        if (r < IT_W1) { const int kb = r / 256, nb = r % 256; transpose_item(a.in[I_W1] + (size_t)l * DM * DFF, DFF, kb * 64, nb * 32, (bf16_t*)(ws + O_W1T) + (size_t)l * DFF * DM, 2048, nb * 32, kb * 64, scr, lane); continue; } r -= IT_W1;
        { const int kb = r / 64, nb = r % 64; transpose_item(a.in[I_W2] + (size_t)l * DFF * DM, DM, kb * 64, nb * 32, (bf16_t*)(ws + O_W2T) + (size_t)l * DM * DFF, 8192, nb * 32, kb * 64, scr, lane); }
    }
    const int gt = bid * 512 + tid, NGT = G * 512;
    for (int i = gt; i < 2 * 512 * 512; i += NGT) {
        const int l = i >> 18, c = (i >> 9) & 511, d = i & 511; float v = 0.f;
        if ((c >> 7) == (d >> 7)) v = a.in[I_WPOOL][(((size_t)l * 4 + (c >> 7)) * 128 + (c & 127)) * 128 + (d & 127)] * a.in[I_PSC][l * 512 + d];
        ((bf16_t*)(ws + O_BDP))[i] = f2bf(v);
    }
    for (int i = gt; i < 256 * 256; i += NGT) {
        const int r = i >> 8, c = i & 255, cp = r & 127; const float t = (float)((cp * c) & 127) * (2.0f / 128.0f);
        ((bf16_t*)(ws + O_CS))[i] = f2bf(c < 128 ? (r < 128 ? cospif(t) : sinpif(t)) * 0.08838834764831845f : 0.f);
    }
    for (int i = gt; i < 256 * 512; i += NGT) {
        const int k = i >> 9, c = i & 511, n = c & 255; const float t = (float)((k * n) & 255) * (2.0f / 256.0f);
        ((bf16_t*)(ws + O_DFT256))[i] = f2bf((c < 256 ? cospif(t) : -sinpif(t)) * 0.0625f);
    }
    for (int i = gt; i < 1024 * 2048; i += NGT) {
        const int k = i >> 11, c = i & 2047, n = c & 1023; const float t = (float)((k * n) & 1023) * (2.0f / 1024.0f);
        ((bf16_t*)(ws + O_DFT1024))[i] = f2bf((c < 1024 ? cospif(t) : -sinpif(t)) * 0.03125f);
    }
    for (int i = gt; i < 2 * 4 * 128 * 128; i += NGT) ((bf16_t*)(ws + O_WSB))[i] = f2bf(a.in[I_WSP][i]);
    for (int i = gt; i < 8 * 2 * 8 * 512 * 64 / 4; i += NGT) { const f32x4 v = ((const f32x4*)a.in[I_CK])[i]; u32x2 w; w.x = cvt_pk_bf16(v[0], v[1]); w.y = cvt_pk_bf16(v[2], v[3]); ((u32x2*)(ws + O_CK))[i] = w; }
    __syncthreads();
    for (int it = gw; it < 2 * 16 * 48; it += NGW) {
        const int l = it / 768, rem = it % 768, dch = rem / 48, cb = rem % 48, j0 = cb * 256 + lane * 4, d0 = dch * 128;
        for (int i = lane; i < NCOND * 128; i += 64) { const int cond = i >> 7, d = i & 127; const float x = cond == 0 ? a.in[I_CCTX][d0 + d] : a.in[I_C][(size_t)(cond - 1) * DM + d0 + d]; scr[i] = x * sigmoidf_(x); }
        LDS_WAIT(); asm volatile("" ::: "memory");
        f32x4 acc[NCOND];
#pragma unroll
        for (int c = 0; c < NCOND; ++c) acc[c] = (f32x4){0.f, 0.f, 0.f, 0.f};
        const float* wp = a.in[I_WADA] + ((size_t)l * DM + d0) * 12288 + j0;
#pragma unroll 4
        for (int d = 0; d < 128; ++d) { const f32x4 w = *(const f32x4*)(wp + (size_t)d * 12288);
#pragma unroll
            for (int c = 0; c < NCOND; ++c) acc[c] += w * scr[c * 128 + d]; }
#pragma unroll
        for (int c = 0; c < NCOND; ++c) *(f32x4*)((float*)(ws + O_MODP) + ((size_t)(dch * 2 + l) * NCOND + c) * 12288 + j0) = acc[c];
        LDS_WAIT(); asm volatile("" ::: "memory");
    }
}

__device__ __forceinline__ void phase_p1_modreduce(const Args& a, int tid, int G, int bid) {
    const int gt = bid * 512 + tid, NGT = G * 512;
    const float* P = (const float*)(a.ws + O_MODP); float* M = (float*)(a.ws + O_MOD);
    for (int i = gt; i < 2 * NCOND * 2048; i += NGT) {
        const int l = i / (NCOND * 2048), cond = (i / 2048) % NCOND, col = i & 2047;
        float m[6];
#pragma unroll
        for (int s = 0; s < 6; ++s) { float v = a.in[I_BADA][l * 12288 + s * 2048 + col];
            for (int dch = 0; dch < 16; ++dch) v += P[((size_t)(dch * 2 + l) * NCOND + cond) * 12288 + s * 2048 + col];
            m[s] = v; }
        float* o = M + ((size_t)(l * NCOND + cond) * 6) * 2048 + col;
        o[0] = a.in[I_N1G][l * 2048 + col] * (1.f + m[1]); o[2048] = m[0]; o[2 * 2048] = m[2];
        o[3 * 2048] = a.in[I_N2G][l * 2048 + col] * (1.f + m[4]); o[4 * 2048] = m[3]; o[5 * 2048] = m[5];
    }
}

__device__ __forceinline__ void phase_norm(const Args& a, int l, int which, bool from_input, int lane, int wave, int G, int bid) {
    const int gw = bid * 8 + wave, NGW = G * 8;
    bf16_t* H = (bf16_t*)(a.ws + O_H);
    const int chunk = (NTOK + NGW - 1) / NGW;
    int row = gw * chunk; const int rend = (row + chunk) < NTOK ? (row + chunk) : NTOK;
    if (row >= rend) return;
#define NORM_XPTR(r) (from_input ? ((r) < NCTXT ? a.in[I_XP] + (size_t)(r) * DM : a.in[I_XS] + (size_t)((r) - NCTXT) * DM) : a.out + (size_t)(r) * DM)
    f32x4 v[8], av[8], sv[8]; int ccond = -1;
    { const float* xr = NORM_XPTR(row);
#pragma unroll
      for (int j = 0; j < 8; ++j) v[j] = *(const f32x4*)(xr + j * 256 + lane * 4); }
    for (; row < rend; ++row) {
        f32x4 vn[8];
        if (row + 1 < rend) { const float* xr = NORM_XPTR(row + 1);
#pragma unroll
            for (int j = 0; j < 8; ++j) vn[j] = *(const f32x4*)(xr + j * 256 + lane * 4); }
        const int cond = row < NCTXT ? 0 : 1 + ((row - NCTXT) >> 10);
        if (cond != ccond) { ccond = cond; const float* ap = (const float*)(a.ws + O_MOD) + ((size_t)(l * NCOND + cond) * 6 + which) * 2048;
#pragma unroll
            for (int j = 0; j < 8; ++j) { av[j] = *(const f32x4*)(ap + j * 256 + lane * 4); sv[j] = *(const f32x4*)(ap + 2048 + j * 256 + lane * 4); } }
        float s = 0.f;
#pragma unroll
        for (int j = 0; j < 8; ++j) s += (v[j][0] * v[j][0] + v[j][1] * v[j][1]) + (v[j][2] * v[j][2] + v[j][3] * v[j][3]);
        const float r = rsqrtf(wave_sum(s) * (1.0f / DM) + 1e-6f);
#pragma unroll
        for (int j = 0; j < 8; ++j) { const f32x4 o = v[j] * r * av[j] + sv[j]; u32x2 w; w.x = cvt_pk_bf16(o[0], o[1]); w.y = cvt_pk_bf16(o[2], o[3]);
            *(u32x2*)(H + (size_t)row * DM + j * 256 + lane * 4) = w; }
#pragma unroll
        for (int j = 0; j < 8; ++j) v[j] = vn[j];
    }
#undef NORM_XPTR
}

template <bool SCALE>
__device__ __forceinline__ void transpose128(const bf16_t* src, int ld_src, bf16_t* dst, int ld_dst, LAS unsigned char* lds, int tid, const LAS float* rtab, const float* gvec) {
    LAS bf16_t* T = (LAS bf16_t*)lds;
#pragma unroll
    for (int j = 0; j < 4; ++j) { const int ch = tid + j * 512, row = ch >> 4, cc = ch & 15;
        u32x4 v = *(const u32x4*)(src + (size_t)row * ld_src + cc * 8);
        if (SCALE) { const float r = rtab[row]; const f32x4 g0 = *(const f32x4*)(gvec + cc * 8), g1 = *(const f32x4*)(gvec + cc * 8 + 4);
            v.x = cvt_pk_bf16(bflo(v.x) * r * g0[0], bfhi(v.x) * r * g0[1]); v.y = cvt_pk_bf16(bflo(v.y) * r * g0[2], bfhi(v.y) * r * g0[3]);
            v.z = cvt_pk_bf16(bflo(v.z) * r * g1[0], bfhi(v.z) * r * g1[1]); v.w = cvt_pk_bf16(bflo(v.w) * r * g1[2], bfhi(v.w) * r * g1[3]); }
        *(LAS u32x4*)(T + row * 136 + cc * 8) = v; }
    __syncthreads();
#pragma unroll
    for (int j = 0; j < 4; ++j) { const int ch = tid + j * 512, c = ch & 127, qc = ch >> 7;
        unsigned short e[8];
#pragma unroll
        for (int k = 0; k < 8; ++k) e[k] = T[(qc * 8 + k) * 136 + c];
        u32x4 o; o.x = e[0] | ((unsigned)e[1] << 16); o.y = e[2] | ((unsigned)e[3] << 16); o.z = e[4] | ((unsigned)e[5] << 16); o.w = e[6] | ((unsigned)e[7] << 16);
        *(u32x4*)(dst + (size_t)c * ld_dst + qc * 8) = o; }
    __syncthreads();
}

template <int W>
__device__ __forceinline__ void pool_rows(const bf16_t* base, bf16_t* outp, int pos0, int npos, int tl0, int tsub) {
#pragma unroll 2
    for (int it = 0; it < 16; ++it) {
        const int tl = tl0 + it * 4 + tsub, pos = pos0 + tl;
        int lo = pos - (W >> 1); if (lo < 0) lo = 0; int hi = pos + (W >> 1) - 1; if (hi > npos - 1) hi = npos - 1;
        u32x4 x[W];
#pragma unroll
        for (int j = 0; j < W; ++j) { int p = pos - (W >> 1) + j; p = p < lo ? lo : (p > hi ? hi : p); x[j] = *(const u32x4*)(base + (size_t)p * 4096); }
        float s[8] = {0.f, 0.f, 0.f, 0.f, 0.f, 0.f, 0.f, 0.f};
#pragma unroll
        for (int j = 0; j < W; ++j) { const int p = pos - (W >> 1) + j; const float wgt = (p >= lo && p <= hi) ? 1.f : 0.f;
            s[0] += wgt * bflo(x[j].x); s[1] += wgt * bfhi(x[j].x); s[2] += wgt * bflo(x[j].y); s[3] += wgt * bfhi(x[j].y);
            s[4] += wgt * bflo(x[j].z); s[5] += wgt * bfhi(x[j].z); s[6] += wgt * bflo(x[j].w); s[7] += wgt * bfhi(x[j].w); }
        const u32x4 xc = x[W >> 1]; const float inv = 1.0f / (float)(hi - lo + 1);
        u32x4 o; o.x = cvt_pk_bf16(s[0] * inv - bflo(xc.x), s[1] * inv - bfhi(xc.x)); o.y = cvt_pk_bf16(s[2] * inv - bflo(xc.y), s[3] * inv - bfhi(xc.y));
        o.z = cvt_pk_bf16(s[4] * inv - bflo(xc.z), s[5] * inv - bfhi(xc.z)); o.w = cvt_pk_bf16(s[6] * inv - bflo(xc.w), s[7] * inv - bfhi(xc.w));
        *(u32x4*)(outp + (size_t)tl * 2048) = o;
    }
}

__device__ __forceinline__ void phase_prep(const Args& a, int l, LAS unsigned char* lds, int tid, int lane, int wave, int G, int bid) {
    unsigned char* ws = a.ws;
    const bf16_t* Zm = (const bf16_t*)(ws + O_ZM);
    unsigned* qctr = (unsigned*)(ws + O_CTL) + 64 * (8 + l);
    LAS int* qslot = (LAS int*)(lds + 131072 + 128);
    for (;;) {
        __syncthreads();
        if (tid == 0) *qslot = (int)atomicAdd(qctr, 1u);
        __syncthreads();
        const int qi = *qslot; if (qi >= 96 * 6) break;
        const int ord = qi / 96, tt = qi % 96; const int task = ord == 0 ? 0 : (ord == 1 ? 5 : ord - 1);
        const bool ctx = tt < 32; const int bb = ctx ? (tt >> 1) : ((tt - 32) >> 3); const int pos0 = ctx ? (tt & 1) * 128 : ((tt - 32) & 7) * 128; const int npos = ctx ? 256 : 1024;
        const int tok0 = tt * 128;
        if (task == 0) {
            const int j = lane & 7, hd = lane >> 3;
            const f32x4 gq0 = *(const f32x4*)(a.in[I_QNG] + l * 64 + j * 8), gq1 = *(const f32x4*)(a.in[I_QNG] + l * 64 + j * 8 + 4);
            const f32x4 gk0 = *(const f32x4*)(a.in[I_KNG] + l * 64 + j * 8), gk1 = *(const f32x4*)(a.in[I_KNG] + l * 64 + j * 8 + 4);
            const int ax = j >> 2; const bool isx2 = (j & 2) != 0; const int i0 = (j & 1) * 8;
            float invf[8];
#pragma unroll
            for (int e = 0; e < 8; ++e) invf[e] = __builtin_amdgcn_exp2f(-(float)(i0 + e) * (13.287712379549449f / 16.0f));
#pragma unroll 1
            for (int tb = 0; tb < 4; ++tb) {
                u32x4 qw4[4], kw4[4];
#pragma unroll
                for (int u = 0; u < 4; ++u) { const int tok = tok0 + wave * 16 + tb * 4 + u; qw4[u] = *(const u32x4*)(Zm + (size_t)tok * 4096 + lane * 8); kw4[u] = *(const u32x4*)(Zm + (size_t)tok * 4096 + 512 + lane * 8); }
#pragma unroll
                for (int u = 0; u < 4; ++u) {
                    const int tl = wave * 16 + tb * 4 + u, tok = tok0 + tl, pos = pos0 + tl;
                    const u32x4 qw = qw4[u], kw = kw4[u];
                    float q[8] = {bflo(qw.x), bfhi(qw.x), bflo(qw.y), bfhi(qw.y), bflo(qw.z), bfhi(qw.z), bflo(qw.w), bfhi(qw.w)};
                    float k[8] = {bflo(kw.x), bfhi(kw.x), bflo(kw.y), bfhi(kw.y), bflo(kw.z), bfhi(kw.z), bflo(kw.w), bfhi(kw.w)};
                    float sq = 0.f, sk = 0.f;
#pragma unroll
                    for (int e = 0; e < 8; ++e) { sq += q[e] * q[e]; sk += k[e] * k[e]; }
                    sq += __shfl_xor(sq, 1); sq += __shfl_xor(sq, 2); sq += __shfl_xor(sq, 4);
                    sk += __shfl_xor(sk, 1); sk += __shfl_xor(sk, 2); sk += __shfl_xor(sk, 4);
                    const float rq = rsqrtf(sq * (1.f / 64.f) + 1e-6f), rk = rsqrtf(sk * (1.f / 64.f) + 1e-6f);
#pragma unroll
                    for (int e = 0; e < 8; ++e) { q[e] *= rq * (e < 4 ? gq0[e & 3] : gq1[e & 3]); k[e] *= rk * (e < 4 ? gk0[e & 3] : gk1[e & 3]); }
                    { u32x4 o; o.x = cvt_pk_bf16(q[0] * 0.125f, q[1] * 0.125f); o.y = cvt_pk_bf16(q[2] * 0.125f, q[3] * 0.125f); o.z = cvt_pk_bf16(q[4] * 0.125f, q[5] * 0.125f); o.w = cvt_pk_bf16(q[6] * 0.125f, q[7] * 0.125f);
                      *(u32x4*)((bf16_t*)(ws + O_QP) + (size_t)tok * 512 + lane * 8) = o; }
                    if (ctx) {
                        u32x4 o; o.x = cvt_pk_bf16(k[0], k[1]); o.y = cvt_pk_bf16(k[2], k[3]); o.z = cvt_pk_bf16(k[4], k[5]); o.w = cvt_pk_bf16(k[6], k[7]);
                        *(u32x4*)((bf16_t*)(ws + O_KB) + (size_t)tok * 512 + lane * 8) = o;
                        float* ok = a.out + OUTK + ((((size_t)bb * 2 + l) * 8 + hd) * 256 + pos) * 64 + j * 8;
                        *(f32x4*)ok = (f32x4){k[0], k[1], k[2], k[3]}; *(f32x4*)(ok + 4) = (f32x4){k[4], k[5], k[6], k[7]};
                    } else {
                        const float p = (float)(ax == 0 ? (pos >> 6) : (pos & 63));
                        float qr[8], kr[8];
#pragma unroll
                        for (int e = 0; e < 8; ++e) {
                            const float ang = p * invf[e]; const float cs = __cosf(ang), sn = __sinf(ang);
                            const float pq = __shfl_xor(q[e], 2), pk = __shfl_xor(k[e], 2);
                            qr[e] = q[e] * cs + (isx2 ? pq : -pq) * sn; kr[e] = k[e] * cs + (isx2 ? pk : -pk) * sn;
                        }
                        u32x4 o; o.x = cvt_pk_bf16(qr[0] * 0.125f, qr[1] * 0.125f); o.y = cvt_pk_bf16(qr[2] * 0.125f, qr[3] * 0.125f); o.z = cvt_pk_bf16(qr[4] * 0.125f, qr[5] * 0.125f); o.w = cvt_pk_bf16(qr[6] * 0.125f, qr[7] * 0.125f);
                        *(u32x4*)((bf16_t*)(ws + O_QR) + (size_t)(tok - NCTXT) * 512 + lane * 8) = o;
                        u32x4 o2; o2.x = cvt_pk_bf16(kr[0], kr[1]); o2.y = cvt_pk_bf16(kr[2], kr[3]); o2.z = cvt_pk_bf16(kr[4], kr[5]); o2.w = cvt_pk_bf16(kr[6], kr[7]);
                        *(u32x4*)((bf16_t*)(ws + O_KB) + (size_t)tok * 512 + lane * 8) = o2;
                    }
                }
            }
        } else if (task == 1) {
            bf16_t* vt = (bf16_t*)(ws + O_VT) + (ctx ? (size_t)bb * 512 * 256 : (size_t)16 * 512 * 256 + (size_t)bb * 512 * 1024) + pos0;
            if (ctx) {
                const int j = lane & 7, hd = lane >> 3;
#pragma unroll 1
                for (int tb = 0; tb < 2; ++tb) {
                    u32x4 w8[8];
#pragma unroll
                    for (int u = 0; u < 8; ++u) w8[u] = *(const u32x4*)(Zm + (size_t)(tok0 + wave * 16 + tb * 8 + u) * 4096 + 1024 + lane * 8);
#pragma unroll
                    for (int u = 0; u < 8; ++u) { const int pos = pos0 + wave * 16 + tb * 8 + u; const u32x4 w = w8[u];
                        float* ov = a.out + OUTV + ((((size_t)bb * 2 + l) * 8 + hd) * 256 + pos) * 64 + j * 8;
                        *(f32x4*)ov = (f32x4){bflo(w.x), bfhi(w.x), bflo(w.y), bfhi(w.y)}; *(f32x4*)(ov + 4) = (f32x4){bflo(w.z), bfhi(w.z), bflo(w.w), bfhi(w.w)}; }
                }
            }
            for (int sub = 0; sub < 4; ++sub)
                transpose128<false>(Zm + (size_t)tok0 * 4096 + 1024 + sub * 128, 4096, vt + (size_t)sub * 128 * npos, npos, lds, tid, nullptr, nullptr);
        } else if (task == 2) {
            LAS float* rtab = (LAS float*)(lds + 40960);
#pragma unroll 1
            for (int tb = 0; tb < 2; ++tb) {
                u32x4 w8[8];
#pragma unroll
                for (int u = 0; u < 8; ++u) w8[u] = *(const u32x4*)(Zm + (size_t)(tok0 + wave * 16 + tb * 8 + u) * 4096 + 2048 + lane * 8);
#pragma unroll
                for (int u = 0; u < 8; ++u) { const u32x4 w = w8[u];
                    float s = bflo(w.x) * bflo(w.x) + bfhi(w.x) * bfhi(w.x) + bflo(w.y) * bflo(w.y) + bfhi(w.y) * bfhi(w.y) + bflo(w.z) * bflo(w.z) + bfhi(w.z) * bfhi(w.z) + bflo(w.w) * bflo(w.w) + bfhi(w.w) * bfhi(w.w);
                    s = wave_sum(s); if (lane == 0) rtab[wave * 16 + tb * 8 + u] = rsqrtf(s * (1.f / 512.f) + 1e-6f); }
            }
            __syncthreads();
            for (int sub = 0; sub < 4; ++sub)
                transpose128<true>(Zm + (size_t)tok0 * 4096 + 2048 + sub * 128, 4096, (bf16_t*)(ws + O_VNT) + ((size_t)tt * 512 + sub * 128) * 128, 128, lds, tid, rtab, a.in[I_GNG] + l * 512 + sub * 128);
        } else if (task == 3 || task == 4) {
            const int part = task - 3;
            bf16_t* tb = (bf16_t*)(ws + O_TT) + (ctx ? (size_t)bb * 512 * 512 : (size_t)16 * 512 * 512 + (size_t)bb * 512 * 2048) + part * npos + pos0;
            for (int sub = 0; sub < 4; ++sub)
                transpose128<false>(Zm + (size_t)tok0 * 4096 + 2560 + part * 512 + sub * 128, 4096, tb + (size_t)sub * 128 * 2 * npos, 2 * npos, lds, tid, nullptr, nullptr);
        } else {
            const int gi = wave & 3, half = wave >> 2, tsub = lane >> 4, c8 = gi * 16 + (lane & 15);
            const bf16_t* base = Zm + (size_t)(tok0 - pos0) * 4096 + 3584 + c8 * 8;
            bf16_t* outp = (bf16_t*)(ws + O_BR) + (size_t)tok0 * 2048 + 1536 + c8 * 8;
            if (gi == 0) pool_rows<2>(base, outp, pos0, npos, half * 64, tsub);
            else if (gi == 1) pool_rows<4>(base, outp, pos0, npos, half * 64, tsub);
            else if (gi == 2) pool_rows<8>(base, outp, pos0, npos, half * 64, tsub);
            else pool_rows<16>(base, outp, pos0, npos, half * 64, tsub);
        }
    }
}

#define MFMA16(a, b, c) __builtin_amdgcn_mfma_f32_16x16x32_bf16(a, b, c, 0, 0, 0)
struct KVF { bf16x8 k[4]; bf16x8 v[4]; };
struct KVOff { unsigned k0, k1, v[4]; };
__device__ __forceinline__ KVOff kv_off(int ldk, int ldv, int lane) {
    const int i = lane & 15, g = lane >> 4; const int ko0 = 8 * (i >> 2) + (i & 3);
    KVOff o; o.k0 = (unsigned)(ko0 * ldk + 8 * g) * 2u; o.k1 = o.k0 + (unsigned)(4 * ldk) * 2u;
#pragma unroll
    for (int dt = 0; dt < 4; ++dt) o.v[dt] = (unsigned)((16 * dt + i) * ldv + 8 * g) * 2u;
    return o;
}
__device__ __forceinline__ void kv_load(KVF& f, const bf16_t* kp, const bf16_t* vp, const KVOff& o) {
    const char* kc = (const char*)kp; const char* vc = (const char*)vp;
    f.k[0] = *(const bf16x8*)(kc + o.k0); f.k[1] = *(const bf16x8*)(kc + o.k0 + 64); f.k[2] = *(const bf16x8*)(kc + o.k1); f.k[3] = *(const bf16x8*)(kc + o.k1 + 64);
#pragma unroll
    for (int dt = 0; dt < 4; ++dt) f.v[dt] = *(const bf16x8*)(vc + o.v[dt]);
}
struct QSt { f32x4 o[4]; float m, lsum; };
__device__ __forceinline__ void attn_step(const KVF& f, const bf16x8 (&qf)[2], const float (&sb)[8], bool use_sb, QSt& st) {
    f32x4 s0 = {0.f, 0.f, 0.f, 0.f}, s1 = {0.f, 0.f, 0.f, 0.f};
    s0 = MFMA16(f.k[0], qf[0], s0); s0 = MFMA16(f.k[1], qf[1], s0);
    s1 = MFMA16(f.k[2], qf[0], s1); s1 = MFMA16(f.k[3], qf[1], s1);
    float s[8] = {s0[0], s0[1], s0[2], s0[3], s1[0], s1[1], s1[2], s1[3]};
    if (use_sb) {
#pragma unroll
        for (int e = 0; e < 8; ++e) s[e] = sb[e] < -1e29f ? -3e30f : s[e] + sb[e];
    }
    float mx = fmaxf(fmaxf(fmaxf(s[0], s[1]), fmaxf(s[2], s[3])), fmaxf(fmaxf(s[4], s[5]), fmaxf(s[6], s[7])));
    mx = fmaxf(mx, __shfl_xor(mx, 16)); mx = fmaxf(mx, __shfl_xor(mx, 32));
    const float mn = fmaxf(st.m, mx); const float alpha = fast_exp(st.m - mn); st.m = mn;
    float ps = 0.f;
#pragma unroll
    for (int e = 0; e < 8; ++e) { s[e] = fast_exp(s[e] - mn); ps += s[e]; }
    st.lsum = st.lsum * alpha + ps;
#pragma unroll
    for (int dt = 0; dt < 4; ++dt) st.o[dt] *= alpha;
    u32x4 pw; pw.x = cvt_pk_bf16(s[0], s[1]); pw.y = cvt_pk_bf16(s[2], s[3]); pw.z = cvt_pk_bf16(s[4], s[5]); pw.w = cvt_pk_bf16(s[6], s[7]);
    const bf16x8 pf = __builtin_bit_cast(bf16x8, pw);
#pragma unroll
    for (int dt = 0; dt < 4; ++dt) st.o[dt] = MFMA16(f.v[dt], pf, st.o[dt]);
}
__device__ __forceinline__ void attn_step2(const KVF& f0, const KVF& f1, const bf16x8 (&qf)[2], QSt& st) {
    f32x4 s0 = {0.f, 0.f, 0.f, 0.f}, s1 = {0.f, 0.f, 0.f, 0.f}, s2 = {0.f, 0.f, 0.f, 0.f}, s3 = {0.f, 0.f, 0.f, 0.f};
    s0 = MFMA16(f0.k[0], qf[0], s0); s1 = MFMA16(f0.k[2], qf[0], s1); s2 = MFMA16(f1.k[0], qf[0], s2); s3 = MFMA16(f1.k[2], qf[0], s3);
    s0 = MFMA16(f0.k[1], qf[1], s0); s1 = MFMA16(f0.k[3], qf[1], s1); s2 = MFMA16(f1.k[1], qf[1], s2); s3 = MFMA16(f1.k[3], qf[1], s3);
    float s[16] = {s0[0], s0[1], s0[2], s0[3], s1[0], s1[1], s1[2], s1[3], s2[0], s2[1], s2[2], s2[3], s3[0], s3[1], s3[2], s3[3]};
    float mx = fmaxf(fmaxf(fmaxf(s[0], s[1]), fmaxf(s[2], s[3])), fmaxf(fmaxf(s[4], s[5]), fmaxf(s[6], s[7])));
    mx = fmaxf(mx, fmaxf(fmaxf(fmaxf(s[8], s[9]), fmaxf(s[10], s[11])), fmaxf(fmaxf(s[12], s[13]), fmaxf(s[14], s[15]))));
    mx = fmaxf(mx, __shfl_xor(mx, 16)); mx = fmaxf(mx, __shfl_xor(mx, 32));
    const float mn = fmaxf(st.m, mx); const float alpha = fast_exp(st.m - mn); st.m = mn;
    float ps = 0.f;
#pragma unroll
    for (int e = 0; e < 16; ++e) { s[e] = fast_exp(s[e] - mn); ps += s[e]; }
    st.lsum = st.lsum * alpha + ps;
#pragma unroll
    for (int dt = 0; dt < 4; ++dt) st.o[dt] *= alpha;
    u32x4 pw0, pw1; pw0.x = cvt_pk_bf16(s[0], s[1]); pw0.y = cvt_pk_bf16(s[2], s[3]); pw0.z = cvt_pk_bf16(s[4], s[5]); pw0.w = cvt_pk_bf16(s[6], s[7]);
    pw1.x = cvt_pk_bf16(s[8], s[9]); pw1.y = cvt_pk_bf16(s[10], s[11]); pw1.z = cvt_pk_bf16(s[12], s[13]); pw1.w = cvt_pk_bf16(s[14], s[15]);
    const bf16x8 pf0 = __builtin_bit_cast(bf16x8, pw0), pf1 = __builtin_bit_cast(bf16x8, pw1);
#pragma unroll
    for (int dt = 0; dt < 4; ++dt) { st.o[dt] = MFMA16(f0.v[dt], pf0, st.o[dt]); st.o[dt] = MFMA16(f1.v[dt], pf1, st.o[dt]); }
}
__device__ __forceinline__ void attn_store(const QSt& st0, bf16_t* op) {
    QSt st = st0; st.lsum += __shfl_xor(st.lsum, 16); st.lsum += __shfl_xor(st.lsum, 32);
    const float inv = 1.0f / st.lsum;
#pragma unroll
    for (int dt = 0; dt < 4; ++dt) { u32x2 w2; w2.x = cvt_pk_bf16(st.o[dt][0] * inv, st.o[dt][1] * inv); w2.y = cvt_pk_bf16(st.o[dt][2] * inv, st.o[dt][3] * inv); *(u32x2*)(op + 16 * dt) = w2; }
}
__device__ __forceinline__ void local_bias(float (&sb)[8], const float* rpb, int dr, int kc0, int g, int cq, int cs) {
    asm volatile("" : "+v"(g));
#pragma unroll
    for (int e = 0; e < 8; ++e) { const int kc = kc0 + 8 * g + e; const bool vis = (kc >= cs) && (kc < cs + 16);
        const int idx = vis ? (kc - cq + 15) : 15; const float bv = rpb[dr * 31 + idx]; sb[e] = vis ? bv : -1e30f; }
}

__device__ __forceinline__ void attn_item(const Args& a, int l, int item, int lane) {
    unsigned char* ws = a.ws;
    const int q = lane & 15, g = lane >> 4;
    QSt sA, sB;
#pragma unroll
    for (int dt = 0; dt < 4; ++dt) { sA.o[dt] = (f32x4){0.f, 0.f, 0.f, 0.f}; sB.o[dt] = (f32x4){0.f, 0.f, 0.f, 0.f}; }
    sA.m = -1e30f; sA.lsum = 0.f; sB.m = -1e30f; sB.lsum = 0.f;
    float nb0[8];
    int tokq, h;
    if (item < 2048) {
        const int bb = item >> 8; h = (item >> 5) & 7; const int r = (item >> 1) & 15, p = item & 1;
        tokq = NCTXT + bb * 1024 + r * 64 + 32 * p + q;
        bf16x8 qA[2], qB[2];
        { const bf16_t* pp = (const bf16_t*)(ws + O_QP) + (size_t)tokq * 512 + h * 64 + 8 * g; qA[0] = *(const bf16x8*)pp; qA[1] = *(const bf16x8*)(pp + 32); qB[0] = *(const bf16x8*)(pp + 16 * 512); qB[1] = *(const bf16x8*)(pp + 16 * 512 + 32); }
        const bf16_t* ck = (const bf16_t*)(ws + O_CK) + (((size_t)bb * 2 + l) * 8 + h) * 512 * 64;
        const bf16_t* cv = (const bf16_t*)(ws + O_VTC) + (((size_t)bb * 2 + l) * 8 + h) * 64 * 512;
        int rs = r - 4; if (rs < 0) rs = 0; if (rs > 8) rs = 8;
        const int cqA = 32 * p + q, cqB = cqA + 16; int csA = cqA - 8; if (csA < 0) csA = 0; if (csA > 48) csA = 48; int csB = cqB - 8; if (csB < 0) csB = 0; if (csB > 48) csB = 48;
        const float* rpb = a.in[I_RPB] + (size_t)(l * 8 + h) * 15 * 31;
        const bf16_t* kl = (const bf16_t*)(ws + O_KB) + (size_t)(NCTXT + bb * 1024) * 512 + h * 64;
        const bf16_t* vl = (const bf16_t*)(ws + O_VT) + (size_t)16 * 512 * 256 + ((size_t)bb * 512 + h * 64) * 1024;
        KVF f0, f1; KVOff oc = kv_off(64, 512, lane);
#pragma unroll 1
        for (int kb = 0; kb < 16; kb += 2) {
            kv_load(f0, ck + (size_t)kb * 32 * 64, cv + kb * 32, oc);
            kv_load(f1, ck + (size_t)(kb + 1) * 32 * 64, cv + (kb + 1) * 32, oc);
            attn_step2(f0, f1, qA, sA); attn_step2(f0, f1, qB, sB);
        }
        { const bf16_t* p2 = (const bf16_t*)(ws + O_QR) + (size_t)(tokq - NCTXT) * 512 + h * 64 + 8 * g; qA[0] = *(const bf16x8*)p2; qA[1] = *(const bf16x8*)(p2 + 32); qB[0] = *(const bf16x8*)(p2 + 16 * 512); qB[1] = *(const bf16x8*)(p2 + 16 * 512 + 32); }
        oc = kv_off(512, 1024, lane);
        const int kcA = (32 * p - 8) < 0 ? 0 : (32 * p - 8), kcB = (32 * p + 8) > 32 ? 32 : (32 * p + 8);
#pragma unroll 1
        for (int wi = 0; wi < 8; ++wi) {
            const int dr = rs + wi - r + 7; const int key0 = (rs + wi) * 64;
            kv_load(f0, kl + (size_t)(key0 + kcA) * 512, vl + key0 + kcA, oc);
            kv_load(f1, kl + (size_t)(key0 + kcB) * 512, vl + key0 + kcB, oc);
            local_bias(nb0, rpb, dr, kcA, g, cqA, csA); attn_step(f0, qA, nb0, true, sA);
            local_bias(nb0, rpb, dr, kcB, g, cqB, csB); attn_step(f1, qB, nb0, true, sB);
        }
    } else {
        const int it = item - 2048; const int bb = it >> 6; h = (it >> 3) & 7; const int qb = it & 7;
        tokq = bb * 256 + qb * 32 + q;
        bf16x8 qpA[2], qpB[2];
        { const bf16_t* pp = (const bf16_t*)(ws + O_QP) + (size_t)tokq * 512 + h * 64 + 8 * g; qpA[0] = *(const bf16x8*)pp; qpA[1] = *(const bf16x8*)(pp + 32); qpB[0] = *(const bf16x8*)(pp + 16 * 512); qpB[1] = *(const bf16x8*)(pp + 16 * 512 + 32); }
        const bf16_t* kl = (const bf16_t*)(ws + O_KB) + (size_t)(bb * 256) * 512 + h * 64;
        const bf16_t* vl = (const bf16_t*)(ws + O_VT) + ((size_t)bb * 512 + h * 64) * 256;
        KVF f0, f1; const KVOff oc = kv_off(512, 256, lane);
#pragma unroll 1
        for (int kb = 0; kb < 8; kb += 2) {
            kv_load(f0, kl + (size_t)kb * 32 * 512, vl + kb * 32, oc);
            kv_load(f1, kl + (size_t)(kb + 1) * 32 * 512, vl + (kb + 1) * 32, oc);
            attn_step2(f0, f1, qpA, sA); attn_step2(f0, f1, qpB, sB);
        }
    }
    bf16_t* op = (bf16_t*)(ws + O_BR) + (size_t)tokq * 2048 + h * 64 + 4 * g;
    attn_store(sA, op); attn_store(sB, op + (size_t)16 * 2048);
}

__device__ __forceinline__ void gmlp_item(const Args& a, int l, int item, int lane) {
    unsigned char* ws = a.ws;
    const int tt = item >> 4, gg = (item >> 2) & 3, pb = item & 3;
    const int i = lane & 15, g = lane >> 4;
    const bf16_t* A = (const bf16_t*)(ws + O_VNT) + ((size_t)tt * 512 + gg * 128) * 128;
    const bf16_t* B = (const bf16_t*)(ws + O_WSB) + ((size_t)(l * 4 + gg) * 128 + pb * 32) * 128;
    f32x4 acc[8][2];
#pragma unroll
    for (int mi = 0; mi < 8; ++mi) { acc[mi][0] = (f32x4){0.f, 0.f, 0.f, 0.f}; acc[mi][1] = (f32x4){0.f, 0.f, 0.f, 0.f}; }
#pragma unroll
    for (int ks = 0; ks < 4; ++ks) {
        const bf16x8 b0 = *(const bf16x8*)(B + (size_t)i * 128 + 32 * ks + 8 * g), b1 = *(const bf16x8*)(B + (size_t)(16 + i) * 128 + 32 * ks + 8 * g);
#pragma unroll
        for (int mi = 0; mi < 8; ++mi) { const bf16x8 af = *(const bf16x8*)(A + (size_t)(16 * mi + i) * 128 + 32 * ks + 8 * g);
            acc[mi][0] = MFMA16(af, b0, acc[mi][0]); acc[mi][1] = MFMA16(af, b1, acc[mi][1]); }
    }
    const bf16_t* Zm = (const bf16_t*)(ws + O_ZM);
#pragma unroll
    for (int nj = 0; nj < 2; ++nj) { const int p = pb * 32 + 16 * nj + i; const int tok = tt * 128 + p; const float bs = a.in[I_BSP][(l * 4 + gg) * 128 + p];
        u32x2 uw[8];
#pragma unroll
        for (int mi = 0; mi < 8; ++mi) uw[mi] = *(const u32x2*)(Zm + (size_t)tok * 4096 + 1536 + gg * 128 + 16 * mi + 4 * g);
#pragma unroll
        for (int mi = 0; mi < 8; ++mi) { const int c = gg * 128 + 16 * mi + 4 * g; const f32x4 v = acc[mi][nj];
            u32x2 ow; ow.x = cvt_pk_bf16(bflo(uw[mi].x) * (v[0] + bs), bfhi(uw[mi].x) * (v[1] + bs)); ow.y = cvt_pk_bf16(bflo(uw[mi].y) * (v[2] + bs), bfhi(uw[mi].y) * (v[3] + bs));
            *(u32x2*)((bf16_t*)(ws + O_BR) + (size_t)tok * 2048 + 512 + c) = ow; } }
}

#define XB_TMO      128
#define XB_XCNT(j)  (256  + 64 * (j))
#define XB_XSUB(j)  (1280 + 64 * (j))
#define XB_XGEN(j)  (2304 + 64 * (j))
#define XB_TOP      3328
#define XB_TOPGEN   3392
#define XCD_BAR_WORDS 3456
#define XB_SPIN_CAP (1u << 22)
constexpr int CW_BAR = 4096, CW_FLAG = 8192;
__device__ __forceinline__ unsigned xb_ld(unsigned* p)              { return __hip_atomic_load(p, __ATOMIC_RELAXED, __HIP_MEMORY_SCOPE_AGENT); }
__device__ __forceinline__ unsigned xb_add(unsigned* p, unsigned v) { return __hip_atomic_fetch_add(p, v, __ATOMIC_RELAXED, __HIP_MEMORY_SCOPE_AGENT); }
__device__ __forceinline__ unsigned xb_xcc_id() { return (unsigned)__builtin_amdgcn_s_getreg((3 << 11) | 20) & 0xFu; }
#define XB_SPIN(cond, bar) do { unsigned _sp = 0; while (cond) { __builtin_amdgcn_s_sleep(1); \
    if ((++_sp & 255u) == 0u) { if (xb_ld(&(bar)[XB_TMO])) break; if (_sp > XB_SPIN_CAP) { atomicAdd(&(bar)[XB_TMO], 1u); break; } } } } while (0)
struct XcdBarrier { unsigned* bar; unsigned x; volatile LAS unsigned* st; };
__device__ __forceinline__ XcdBarrier xcd_barrier_post(unsigned* bar, volatile LAS unsigned* st) {
    XcdBarrier b; b.bar = bar; b.x = xb_xcc_id(); b.st = st;
    if (threadIdx.x == 0) (void)xb_add(&bar[XB_XCNT(b.x)], 1u);
    return b;
}
__device__ __forceinline__ void xcd_barrier_complete(unsigned* bar, unsigned x, unsigned& nloc, unsigned& nx) {
    const unsigned G = gridDim.x * gridDim.y * gridDim.z;
    unsigned sum, cnt, mine, sp = 0u;
    for (;;) {
        sum = 0u; cnt = 0u; mine = 0u;
#pragma unroll
        for (unsigned j = 0; j < 16; ++j) { const unsigned c = xb_ld(&bar[XB_XCNT(j)]); sum += c; cnt += (c > 0u) ? 1u : 0u; mine = (j == x) ? c : mine; }
        if (sum == G) break;
        __builtin_amdgcn_s_sleep(1);
        if ((++sp & 255u) == 0u) { if (xb_ld(&bar[XB_TMO])) break; if (sp > XB_SPIN_CAP) { atomicAdd(&bar[XB_TMO], 1u); break; } }
    }
    nloc = mine > 0u ? mine : 1u; nx = cnt > 0u ? cnt : 1u;
}
__device__ __forceinline__ void xcd_barrier(const XcdBarrier& b) {
    asm volatile("s_waitcnt vmcnt(0)" ::: "memory");
    __syncthreads();
    if (threadIdx.x == 0) {
        unsigned* bar = b.bar;
        __builtin_amdgcn_s_waitcnt(0);
        unsigned nloc = b.st[0], nx = b.st[1];
        if (nloc == 0u) { xcd_barrier_complete(bar, b.x, nloc, nx); b.st[0] = nloc; b.st[1] = nx; }
        const unsigned old = xb_add(&bar[XB_XSUB(b.x)], 1u);
        const unsigned gen = old / nloc;
        if (old + 1u == (gen + 1u) * nloc) {
            __builtin_amdgcn_fence(__ATOMIC_RELEASE, "agent");
            asm volatile("s_waitcnt vmcnt(0)" ::: "memory");
            const unsigned og = xb_add(&bar[XB_TOP], 1u);
            const unsigned tg = og / nx;
            if (og + 1u == (tg + 1u) * nx) xb_add(&bar[XB_TOPGEN], 1u);
            else XB_SPIN(xb_ld(&bar[XB_TOPGEN]) == tg, bar);
            __builtin_amdgcn_fence(__ATOMIC_ACQUIRE, "agent");
            xb_add(&bar[XB_XGEN(b.x)], 1u);
            asm volatile("s_waitcnt vmcnt(0)" ::: "memory");
        } else {
            XB_SPIN(xb_ld(&bar[XB_XGEN(b.x)]) == gen, bar);
            __builtin_amdgcn_fence(__ATOMIC_ACQUIRE, "agent");
            asm volatile("s_waitcnt vmcnt(0)" ::: "memory");
        }
    }
    __syncthreads();
}

__global__ void __launch_bounds__(512, 2) fwd(Args a) {
    extern __shared__ __attribute__((aligned(16))) unsigned char lds_raw[];
    LAS unsigned char* lds = (LAS unsigned char*)lds_raw;
    cg::grid_group grid = cg::this_grid();
    int tid0 = threadIdx.x; const int wave = __builtin_amdgcn_readfirstlane(tid0 >> 6), G = gridDim.x, bid = blockIdx.x;
#define OPQ int tid = tid0; asm volatile("" : "+v"(tid)); const int lane = tid & 63; (void)lane;
    unsigned char* ws = a.ws;
    const int lo = a.ph_lo, hi = a.ph_hi;
    int ph = 0;
#ifndef EN
#define EN 0xFFFF
#endif
#define RUN(k) ((k) >= lo && (k) < hi)
#define ENB(t) if constexpr ((EN >> (t)) & 1)
#ifndef DUP
#define DUP 0
#endif
#define REP(t) _Pragma("nounroll") for (int rep = 0; rep < ((((DUP) >> (t)) & 1) ? 2 : 1); ++rep)
#define REPSYNC(t) do { if (((((DUP) >> (t)) & 1)) && rep == 0) xcd_barrier(xbar); } while (0)
#define SEAM(k) do { if ((k) + 1 < hi) xcd_barrier(xbar); } while (0)

    const bool ksplit = (G == 256) && (hi - lo > 1);
    XcdBarrier xbar; xbar.bar = (unsigned*)(ws + O_CTL) + CW_BAR; xbar.x = 0; xbar.st = (volatile LAS unsigned*)(lds + 131072 + 64);
    if (hi - lo > 1) {
        if (tid0 < 2) xbar.st[tid0] = 0u;
        if (bid == 0) { for (int i = tid0; i < XCD_BAR_WORDS; i += 512) xbar.bar[i] = 0u; if (tid0 < 16) ((unsigned*)(ws + O_CTL))[64 * tid0] = 0u; if (tid0 < 32) ((unsigned*)(ws + O_CTL))[1024 + 64 * tid0] = 0u;
            for (int i = tid0; i < 12288; i += 512) ((unsigned*)(ws + O_CTL))[CW_FLAG + i] = 0u; }
        grid.sync();
        xbar = xcd_barrier_post(xbar.bar, xbar.st);
    }
    if (RUN(0)) { REP(0) { ENB(0) { OPQ phase_p0(a, lds, tid, lane, wave, G, bid); } REPSYNC(0); } SEAM(0); }
    if (RUN(1)) { ENB(1) {
#pragma nounroll
        for (int pass = 0; pass < 2; ++pass) {
            pg8::SchedFold S{(const char*)(ws + (pass ? O_WBD : O_CS)), (const char*)(ws + (pass ? O_BDP : O_WFN)), pass, pass ? bid - 64 : bid};
            pg8::EpiStore E{(bf16_t*)(ws + (pass ? O_WBT : O_WINT)), 2048};
            pg8::gemm_phase(lds, pass ? 512 : 256, pass ? 512 : 128, pass ? 512 : 256, S, E); }
        { OPQ phase_p1_modreduce(a, tid, G, bid); } }
        SEAM(1);
    }
    for (int l = 0; l < 2; ++l) {
        const int p0 = 2 + 9 * l;
        const float* mod_l = (const float*)(ws + O_MOD) + (size_t)l * NCOND * 6 * 2048;
        if (RUN(p0 + 0)) {
#ifdef EXP_NANFILL
            { OPQ for (int i = bid * 512 + tid; i < 12288 * 1024; i += G * 512) ((u32x4*)(ws + O_ZG))[i] = (u32x4){0x7fc07fc0u, 0x7fc07fc0u, 0x7fc07fc0u, 0x7fc07fc0u}; }
#endif
            REP(2) { ENB(2) { OPQ phase_norm(a, l, 0, l == 0, lane, wave, G, bid); } REPSYNC(2); } SEAM(p0 + 0); }
        if (RUN(p0 + 1)) { REP(3) { ENB(3) {
            pg8::SchedMN S{(const char*)(ws + O_H), (const char*)(ws + O_WINT) + (size_t)l * 12288 * 2048 * 2, 2048, 2048, 48, 48, G, bid, 0, 48 * 48, 0, 0, 0, 0};
            pg8::EpiZ E{(bf16_t*)(ws + O_ZM), (bf16_t*)(ws + O_ZG), a.in[I_BGATE] + (size_t)l * 8192};
            pg8::gemm_phase(lds, 2048, 2048, 2048, S, E); } REPSYNC(3); }
            SEAM(p0 + 1);
        }
        if (RUN(p0 + 2)) { REP(4) { ENB(4) { OPQ phase_prep(a, l, lds, tid, lane, wave, G, bid); } REPSYNC(4); } SEAM(p0 + 2); }
        if (RUN(p0 + 3)) { REP(5) { ENB(5) {
#pragma nounroll
            for (int pass = 0; pass < 2; ++pass) { const int lat = 1 - pass, Kd = lat ? 2048 : 512;
              pg8::SchedDFT S{(const char*)(ws + (lat ? O_DFT1024 : O_DFT256)), (const char*)(ws + O_TT) + (lat ? (size_t)16 * 512 * 512 * 2 : 0), lat, lat ? bid : bid - 64}; pg8::EpiStore E{(bf16_t*)(ws + O_BR), 2048};
              pg8::gemm_phase(lds, Kd, Kd, Kd, S, E); }
            } ENB(10) { OPQ
            unsigned* cbase = (unsigned*)(ws + O_CTL) + 1024 + (l + 2 * rep) * 8 * 64;
            const int myx = (int)(xb_xcc_id() & 7u);
            constexpr int CPX = (3072 + 1536) / 8;
#pragma unroll 1
            for (int k = 0; k < 8; ++k) {
                const int x = (myx + k) & 7; unsigned* ctr = cbase + x * 64;
                for (;;) {
                    int c = CPX;
                    if (lane == 0) { if (__hip_atomic_load(ctr, __ATOMIC_RELAXED, __HIP_MEMORY_SCOPE_AGENT) < (unsigned)CPX) c = (int)atomicAdd(ctr, 1u); }
                    c = __builtin_amdgcn_readfirstlane(c);
                    if (c >= CPX) break;
                    const int idx = c * 8 + x;
                    if (idx < 3072) attn_item(a, l, idx, lane); else gmlp_item(a, l, idx - 3072, lane);
                }
            } } REPSYNC(5); }
            SEAM(p0 + 3);
        }
        if (RUN(p0 + 4)) { REP(6) { ENB(6) {
            const int nps = ksplit ? 2 : 1;
#pragma nounroll
            for (int pass = 0; pass < nps; ++pass) {
                pg8::SchedMN S{(const char*)(ws + O_BR), (const char*)(ws + O_WBT) + (size_t)l * DM * DM * 2, 2048, 2048, 48, 8, G, bid, 0, ksplit ? 256 : 384, pass, 256, 128, 1024 * 2};
                pg8::EpiBR E{(const bf16_t*)(ws + O_ZG), (bf16_t*)(ws + O_H), (float*)(ws + O_ZM), (unsigned*)(ws + O_CTL) + CW_FLAG + (4 + l) * 128 * 16};
                pg8::gemm_phase(lds, 2048, 2048, pass ? 1024 : 2048, S, E); } } REPSYNC(6); }
            SEAM(p0 + 4);
        }
        if (RUN(p0 + 5)) { ENB(7) {
            const int nps = ksplit ? 2 : 1;
#pragma nounroll
            for (int pass = 0; pass < nps; ++pass) {
                pg8::SchedMN S{(const char*)(ws + O_H), (const char*)(ws + O_WOT) + (size_t)l * DM * DM * 2, 2048, 2048, 48, 8, G, bid, 0, ksplit ? 256 : 384, pass, 256, 128, 1024 * 2};
                pg8::EpiRes E{l == 0 ? a.in[I_XP] : a.out, l == 0 ? a.in[I_XS] : a.out + (size_t)NCTXT * DM, a.out, mod_l, 2, (float*)(ws + O_ZM), (unsigned*)(ws + O_CTL) + CW_FLAG + (l * 2 + 0) * 128 * 16};
                pg8::gemm_phase(lds, 2048, 2048, pass ? 1024 : 2048, S, E); } }
            SEAM(p0 + 5);
        }
        if (RUN(p0 + 6)) { ENB(2) { OPQ phase_norm(a, l, 3, false, lane, wave, G, bid); } SEAM(p0 + 6); }
        if (RUN(p0 + 7)) { REP(8) { ENB(8) {
            pg8::SchedMN S{(const char*)(ws + O_H), (const char*)(ws + O_W1T) + (size_t)l * DFF * DM * 2, 2048, 2048, 48, 32, G, bid, 0, 48 * 32, 0, 0, 0, 0};
            pg8::EpiHid E{(bf16_t*)(ws + O_ZG)};
            pg8::gemm_phase(lds, 2048, 2048, 2048, S, E); } REPSYNC(8); }
            SEAM(p0 + 7);
        }
        if (RUN(p0 + 8)) { ENB(9) {
            const int nps = ksplit ? 2 : 1;
#pragma nounroll
            for (int pass = 0; pass < nps; ++pass) {
                pg8::SchedMN S{(const char*)(ws + O_ZG), (const char*)(ws + O_W2T) + (size_t)l * DM * DFF * 2, 8192, 8192, 48, 8, G, bid, 0, ksplit ? 256 : 384, pass, 256, 128, 4096 * 2};
                pg8::EpiRes E{a.out, a.out + (size_t)NCTXT * DM, a.out, mod_l, 5, (float*)(ws + O_ZM), (unsigned*)(ws + O_CTL) + CW_FLAG + (l * 2 + 1) * 128 * 16};
                pg8::gemm_phase(lds, 8192, 8192, pass ? 4096 : 8192, S, E); } }
            SEAM(p0 + 8);
        }
    }
    (void)ph;
}

extern "C" void kernel_launch(void* const* d_in, const int* in_sizes, int n_in, void* d_out, int out_size, void* d_ws, size_t ws_size, hipStream_t stream) {
    static int grid = 0;
    if (grid == 0) {
        if (n_in != 24 || ws_size < WS_NEED) { fprintf(stderr, "kernel_launch: need 24 inputs and %zu B of workspace (got %d, %zu)\n", (size_t)WS_NEED, n_in, ws_size); grid = -1; return; }
        int dev = 0, cus = 0, per_cu = 0;
        hipGetDevice(&dev); hipDeviceGetAttribute(&cus, hipDeviceAttributeMultiprocessorCount, dev);
        if (hipFuncSetAttribute((const void*)fwd, hipFuncAttributeMaxDynamicSharedMemorySize, LDS_BYTES) != hipSuccess) { fprintf(stderr, "kernel_launch: hipFuncSetAttribute failed\n"); grid = -1; return; }
        if (hipOccupancyMaxActiveBlocksPerMultiprocessor(&per_cu, (const void*)fwd, 512, LDS_BYTES) != hipSuccess || per_cu < 1) { fprintf(stderr, "kernel_launch: occupancy query says %d\n", per_cu); per_cu = 1; }
        (void)hipGetLastError();
        grid = cus;
    }
    if (grid < 0) return;
    Args a{};
    for (int i = 0; i < 24; ++i) a.in[i] = (const float*)d_in[i];
    a.out = (float*)d_out; a.ws = (unsigned char*)d_ws;
#if N_LAUNCH_MODE == 1
    a.ph_lo = 0; a.ph_hi = NPHASE;
    void* args[] = {&a};
    hipError_t e = hipLaunchCooperativeKernel((const void*)fwd, dim3(grid), dim3(512), args, LDS_BYTES, stream);
    if (e != hipSuccess) fprintf(stderr, "kernel_launch: cooperative launch failed: %s (grid %d)\n", hipGetErrorString(e), grid);
#else
    for (int p = 0; p < NPHASE; ++p) { a.ph_lo = p; a.ph_hi = p + 1; hipLaunchKernelGGL(fwd, dim3(grid), dim3(512), LDS_BYTES, stream, a); }
#endif
}
```

```cpp
#include <hip/hip_runtime.h>
#include <hip/hip_cooperative_groups.h>
#include <cstdio>
#include <cstdint>
namespace cg = cooperative_groups;


#ifndef N_LAUNCH_MODE
#define N_LAUNCH_MODE 1
#endif

#define LAS __attribute__((address_space(3)))
typedef unsigned short bf16_t;
typedef short bf16x8 __attribute__((ext_vector_type(8)));
typedef float f32x4 __attribute__((ext_vector_type(4)));
typedef float f32x2 __attribute__((ext_vector_type(2)));
typedef unsigned u32x4 __attribute__((ext_vector_type(4)));
typedef unsigned u32x2 __attribute__((ext_vector_type(2)));

constexpr int DM = 2048, NTOK = 12288, NCTXT = 4096, DFF = 8192, INC = 11776;
constexpr int NCOND = 9;
constexpr size_t MiB = 1u << 20;
constexpr size_t O_CTL = 0, O_WINT = 1 * MiB, O_WBT = 97 * MiB, O_WOT = 113 * MiB, O_W1T = 129 * MiB, O_W2T = 193 * MiB,
                 O_WFN = 257 * MiB, O_WBD = 261 * MiB, O_BDP = 265 * MiB, O_CS = 266 * MiB, O_DFT256 = 267 * MiB, O_DFT1024 = 268 * MiB,
                 O_WSB = 272 * MiB, O_MODP = 273 * MiB, O_MOD = 287 * MiB, O_CK = 288 * MiB, O_VTC = 296 * MiB, O_H = 304 * MiB,
                 O_ZM = 352 * MiB, O_ZG = 448 * MiB, O_QP = 640 * MiB, O_QR = 652 * MiB, O_KB = 660 * MiB, O_VT = 672 * MiB,
                 O_VNT = 684 * MiB, O_TT = 696 * MiB, O_BR = 720 * MiB, WS_NEED = 768 * MiB;
constexpr size_t OUTK = (size_t)NTOK * DM, OUTV = OUTK + (size_t)16 * 2 * 8 * 256 * 64;
constexpr int LDS_BYTES = 147456;
constexpr int NPHASE = 2 + 9 * 2;

struct Args { const float* in[24]; float* out; unsigned char* ws; int ph_lo, ph_hi; };
enum { I_XP = 0, I_XS, I_CK, I_CV, I_C, I_CCTX, I_N1G, I_WIN, I_BGATE, I_QNG, I_KNG, I_RPB, I_GNG, I_WSP, I_BSP, I_WPOOL, I_PSC, I_WBR, I_WOUT, I_N2G, I_W1, I_W2, I_WADA, I_BADA };

typedef __bf16 bf16x2_t __attribute__((ext_vector_type(2)));
__device__ __forceinline__ unsigned cvt_pk_bf16(float lo, float hi) { const f32x2 v = {lo, hi}; const bf16x2_t b = __builtin_convertvector(v, bf16x2_t); return __builtin_bit_cast(unsigned, b); }
__device__ __forceinline__ float bf2f(unsigned short u) { return __uint_as_float(((unsigned)u) << 16); }
__device__ __forceinline__ float bflo(unsigned u) { return __uint_as_float(u << 16); }
__device__ __forceinline__ float bfhi(unsigned u) { return __uint_as_float(u & 0xffff0000u); }
__device__ __forceinline__ bf16_t f2bf(float f) { return (bf16_t)(cvt_pk_bf16(f, 0.f) & 0xffffu); }
__device__ __forceinline__ float wave_sum(float v) {
#pragma unroll
    for (int o = 1; o < 64; o <<= 1) v += __shfl_xor(v, o);
    return v;
}
__device__ __forceinline__ float fast_exp(float x) { return __builtin_amdgcn_exp2f(x * 1.44269504089f); }
__device__ __forceinline__ float sigmoidf_(float x) { return __builtin_amdgcn_rcpf(1.0f + fast_exp(-x)); }
__device__ __forceinline__ float gelu_tanh(float x) { const float u = 0.7978845608f * (x + 0.044715f * x * x * x); return x * sigmoidf_(2.0f * u); }
#define LDS_WAIT() asm volatile("s_waitcnt lgkmcnt(0)" ::: "memory")
#define VM_WAIT() asm volatile("s_waitcnt vmcnt(0)" ::: "memory")

namespace pg8 {
constexpr int BM = 256, BK = 64, HALF = 128, HTB = HALF * BK * 2, STAGE_BYTES = 8 * HTB;
__device__ __forceinline__ int lds_byte(int r, int c) { const int st = (r >> 4) * 2 + (c >> 5), rr = r & 15, cc = c & 31, ob = rr * 64 + cc * 2; return st * 1024 + (ob ^ (((ob >> 9) & 1) << 5)); }
__device__ __forceinline__ void stage_rc(int b, int& R, int& C) { const int st = b / 1024, sb = b % 1024, swz = sb ^ (((sb >> 9) & 1) << 5); R = (st >> 1) * 16 + swz / 64; C = (st & 1) * 32 + (swz % 64) / 2; }
__device__ __forceinline__ int perm32(int rho) { const int n = rho >> 4, i = rho & 15; return 8 * (i >> 2) + 4 * n + (i & 3); }

struct Unit { const char* A; const char* B; long hA; int orow0, orow1, ocol, aux; };
__device__ __forceinline__ void tile_map(int L, int nM, int nN, int& pm, int& pn) {
    const int nwg = nM * nN; int wgid = L;
    { const int q = nwg / 8, r = nwg % 8, xcd = wgid % 8, off = wgid / 8; wgid = (xcd < r ? xcd * (q + 1) : r * (q + 1) + (xcd - r) * q) + off; }
    const int nig = 8 * nN, gid = wgid / nig, fm = gid * 8, gsz = (nM - fm) < 8 ? (nM - fm) : 8;
    pm = fm + ((wgid % nig) % gsz); pn = (wgid % nig) / gsz;
}
template <class Epi, class Sched>
__device__ __forceinline__ void gemm_phase(LAS unsigned char* lds, const int lda, const int ldb, const int K, const Sched& S, const Epi& E) {
    int tid = threadIdx.x; asm volatile("" : "+v"(tid));
    const int wid = __builtin_amdgcn_readfirstlane(tid >> 6), lane = tid & 63, wr = wid >> 2, wc = wid & 3, fr = lane & 15, fq = lane >> 4;
    const int nt = K / BK;
    unsigned voffA[2], voffB[2];
#pragma unroll
    for (int i = 0; i < 2; ++i) { int R, C; stage_rc(tid * 16 + i * 8192, R, C); const int Rb = (R & ~31) + perm32(R & 31);
        voffA[i] = (unsigned)(R * lda + C) * 2u; voffB[i] = (unsigned)(Rb * ldb + C) * 2u; }
    const size_t kstep = (size_t)(BK * 2);
    const size_t hstepB = (size_t)HALF * ldb * 2;
    const unsigned ldsw = (unsigned)wid * 1024u;
    const int aoff = lds_byte(wr * 64 + fr, fq * 8), boff = lds_byte(wc * 32 + fr, fq * 8);
#define PG8_SA(b, h) (((b) * 2 + (h)) * HTB)
#define PG8_SB(b, h) ((4 + (b) * 2 + (h)) * HTB)
#define PG8_STAGE(bufoff, gbase, voff) do { _Pragma("unroll") for (int _i = 0; _i < 2; ++_i) \
        __builtin_amdgcn_global_load_lds((const unsigned*)((const char*)(gbase) + (voff)[_i]), (LAS unsigned*)(lds + (bufoff) + ldsw + _i * 8192), 16, 0, 0); } while (0)
#define PG8_LDA(dst, b, h) do { _Pragma("unroll") for (int m = 0; m < 4; ++m) _Pragma("unroll") for (int k = 0; k < 2; ++k) dst[m][k] = *(const LAS bf16x8*)(lds + PG8_SA(b, h) + aoff + m * 2048 + k * 1024); } while (0)
#define PG8_LDB(dst, b, h) do { _Pragma("unroll") for (int n = 0; n < 2; ++n) _Pragma("unroll") for (int k = 0; k < 2; ++k) dst[n][k] = *(const LAS bf16x8*)(lds + PG8_SB(b, h) + boff + n * 2048 + k * 1024); } while (0)
#define PG8_MMA(ai, bj, At, Bt) do { __builtin_amdgcn_s_setprio(1); _Pragma("unroll") for (int m = 0; m < 4; ++m) _Pragma("unroll") for (int n = 0; n < 2; ++n) _Pragma("unroll") for (int k = 0; k < 2; ++k) \
        acc[ai][bj][m][n] = __builtin_amdgcn_mfma_f32_16x16x32_bf16(Bt[n][k], At[m][k], acc[ai][bj][m][n], 0, 0, 0); __builtin_amdgcn_s_setprio(0); } while (0)
#define PG8_WAIT_V(n) asm volatile("s_waitcnt vmcnt(" #n ")" ::: "memory")
#define PG8_WAIT_L(n) asm volatile("s_waitcnt lgkmcnt(" #n ")" ::: "memory")
#define PG8_BAR __builtin_amdgcn_s_barrier()
#define PG8_SCHED __builtin_amdgcn_sched_barrier(0)
    Unit cur, nxt; int ui = 0;
    if (!S.next(0, cur)) return;
    f32x4 acc[2][2][4][2];
#pragma unroll
    for (int a = 0; a < 2; ++a)
#pragma unroll
        for (int b = 0; b < 2; ++b)
#pragma unroll
            for (int m = 0; m < 4; ++m)
#pragma unroll
                for (int n = 0; n < 2; ++n) acc[a][b][m][n] = (f32x4){0.f, 0.f, 0.f, 0.f};
    bf16x8 At[4][2], B0[2][2], B1[2][2];
    const char* cA = cur.A; const char* cB = cur.B; long chA = cur.hA;
    PG8_STAGE(PG8_SB(0, 0), cB, voffB); PG8_STAGE(PG8_SB(0, 1), cB + hstepB, voffB); PG8_STAGE(PG8_SA(0, 0), cA, voffA); PG8_STAGE(PG8_SA(0, 1), cA + chA, voffA);
    if (wr == 1) PG8_BAR;
    PG8_WAIT_V(2); PG8_BAR;
    PG8_STAGE(PG8_SB(1, 0), cB + kstep, voffB); PG8_STAGE(PG8_SA(1, 0), cA + kstep, voffA); PG8_STAGE(PG8_SB(1, 1), cB + hstepB + kstep, voffB);
    PG8_WAIT_V(6); PG8_BAR;
    for (;;) {
        const bool has_next = S.next(ui + 1, nxt);
        const char* nA = has_next ? nxt.A : cA; const char* nB = has_next ? nxt.B : cB; const long nhA = has_next ? nxt.hA : chA;
        for (int t = 0; t < nt; t += 2) {
            const bool last = (t == nt - 2);
            const char* a1 = cA + (size_t)(t + 1) * kstep;
            const char* a2 = last ? nA : cA + (size_t)(t + 2) * kstep; const char* b2 = last ? nB : cB + (size_t)(t + 2) * kstep;
            const char* a3 = a2 + kstep; const char* b3 = b2 + kstep; const long h2 = last ? nhA : chA;
            PG8_LDB(B0, 0, 0); PG8_LDB(B1, 0, 1); PG8_SCHED; PG8_LDA(At, 0, 0); PG8_STAGE(PG8_SA(1, 1), a1 + chA, voffA);
            PG8_WAIT_V(8); PG8_WAIT_L(0); PG8_BAR; PG8_MMA(0, 0, At, B0); PG8_MMA(0, 1, At, B1); PG8_BAR; PG8_SCHED;
            PG8_LDA(At, 0, 1); PG8_STAGE(PG8_SB(0, 0), b2, voffB); PG8_STAGE(PG8_SB(0, 1), b2 + hstepB, voffB); PG8_STAGE(PG8_SA(0, 0), a2, voffA);
            PG8_WAIT_V(8); PG8_WAIT_L(0); PG8_BAR; PG8_MMA(1, 0, At, B0); PG8_MMA(1, 1, At, B1); PG8_BAR; PG8_SCHED;
            PG8_LDB(B0, 1, 0); PG8_LDB(B1, 1, 1); PG8_SCHED; PG8_LDA(At, 1, 0); PG8_STAGE(PG8_SA(0, 1), a2 + h2, voffA);
            PG8_WAIT_V(8); PG8_WAIT_L(0); PG8_BAR; PG8_MMA(0, 0, At, B0); PG8_MMA(0, 1, At, B1); PG8_BAR; PG8_SCHED;
            PG8_LDA(At, 1, 1); PG8_STAGE(PG8_SB(1, 0), b3, voffB); PG8_STAGE(PG8_SB(1, 1), b3 + hstepB, voffB); PG8_STAGE(PG8_SA(1, 0), a3, voffA);
            PG8_WAIT_V(8); PG8_WAIT_L(0); PG8_BAR; PG8_MMA(1, 0, At, B0); PG8_MMA(1, 1, At, B1); PG8_BAR; PG8_SCHED;
            if constexpr (Epi::MID) { if (((t + 2) & 7) == 0 && t + 2 < nt) E.mid(acc, cur, (t + 2) >> 3, wr, wc, fr, fq); }
        }
        if (wr == 0) PG8_BAR;
        E(acc, cur, wr, wc, fr, fq);
        if (!has_next) break;
#pragma unroll
        for (int a = 0; a < 2; ++a)
#pragma unroll
            for (int b = 0; b < 2; ++b)
#pragma unroll
                for (int m = 0; m < 4; ++m)
#pragma unroll
                    for (int n = 0; n < 2; ++n) acc[a][b][m][n] = (f32x4){0.f, 0.f, 0.f, 0.f};
        cur = nxt; cA = nA; cB = nB; chA = nhA; ++ui;
        if (wr == 1) PG8_BAR;
    }
    PG8_WAIT_V(0);
    PG8_BAR;
#undef PG8_SA
#undef PG8_SB
#undef PG8_STAGE
#undef PG8_LDA
#undef PG8_LDB
#undef PG8_MMA
#undef PG8_WAIT_V
#undef PG8_WAIT_L
#undef PG8_BAR
#undef PG8_SCHED
}

struct SchedMN {
    const char* A; const char* B; int lda, ldb, nM, nN, G, c, ocol_off, lim, split, L0, nsplit, khalf_bytes;
    __device__ __forceinline__ bool next(int i, Unit& u) const {
        int L, kh = 0, aux = 0;
        if (!split) { L = i * G + c; if (c < 0 || L >= lim) return false; }
        else { if (i > 0 || c >= 2 * nsplit) return false; const int j = c >> 1; kh = c & 1; L = L0 + j; aux = (j << 2) | 2 | kh; }
        int pm, pn; tile_map(L, nM, nN, pm, pn);
        const long h = (long)128 * lda * 2;
        u.A = A + (size_t)pm * 256 * lda * 2 + (size_t)kh * khalf_bytes + (kh ? h : 0); u.B = B + (size_t)pn * 256 * ldb * 2 + (size_t)kh * khalf_bytes;
        u.hA = kh ? -h : h;
        u.orow0 = pm * 256 + (kh ? 128 : 0); u.orow1 = pm * 256 + (kh ? 0 : 128); u.ocol = pn * 256 + ocol_off; u.aux = aux; return true;
    }
};
struct SchedBR {
    const char* A; const char* B; int G, c;
    __device__ __forceinline__ bool next(int i, Unit& u) const {
#ifdef EXP_B3
        const int L = i * G + c; if (L >= 48 * 8) return false;
        const int b = 3; int pm, pn; tile_map(L, 48, 8, pm, pn);
#else
        const int L = (i >> 2) * G + c; if (L >= 48 * 8) return false;
        const int b = i & 3; int pm, pn; tile_map(L, 48, 8, pm, pn);
#endif
        u.A = A + (size_t)pm * 256 * 2048 * 2 + b * 1024; u.B = B + (size_t)pn * 256 * 2048 * 2 + b * 1024; u.hA = (long)128 * 2048 * 2; u.orow0 = pm * 256; u.orow1 = pm * 256 + 128; u.ocol = pn * 256; u.aux = b; return true;
    }
};
struct SchedFold {
    const char* A0; const char* B0; int mode, c;
    __device__ __forceinline__ bool next(int i, Unit& u) const {
        if (i > 0 || c < 0) return false;
        if (mode == 0) { if (c >= 64) return false; const int l = c >> 5, g = (c >> 3) & 3, pn = c & 7;
            u.A = A0; u.hA = (long)128 * 256 * 2; u.B = B0 + ((size_t)(l * 4 + g) * 2048 + pn * 256) * 128 * 2; u.orow0 = l * 12288 + 2560 + g * 128; u.orow1 = l * 12288 + 3072 + g * 128; u.ocol = pn * 256; u.aux = g; }
        else { if (c >= 32) return false; const int l = c >> 4, pm = (c & 15) >> 1, pn = c & 1;
            u.A = A0 + ((size_t)l * 2048 + pm * 256) * 512 * 2; u.hA = (long)128 * 512 * 2; u.B = B0 + ((size_t)l * 512 + pn * 256) * 512 * 2; u.orow0 = l * 2048 + pm * 256; u.orow1 = u.orow0 + 128; u.ocol = 1536 + pn * 256; u.aux = 0; }
        return true;
    }
};
struct SchedDFT {
    const char* Amat; const char* TT; int latent, c;
    __device__ __forceinline__ bool next(int i, Unit& u) const {
        if (i > 0 || c < 0) return false;
        if (latent) { if (c >= 64) return false; const int bb = c >> 3, pm = (c & 7) >> 1, pn = c & 1;
            u.A = Amat + (size_t)pm * 256 * 2048 * 2; u.hA = (long)128 * 2048 * 2; u.B = TT + ((size_t)bb * 512 + pn * 256) * 2048 * 2; u.orow0 = NCTXT + bb * 1024 + pm * 256; u.orow1 = u.orow0 + 128; u.ocol = 1024 + pn * 256; }
        else { if (c >= 32) return false; const int bb = c >> 1, pn = c & 1;
            u.A = Amat; u.hA = (long)128 * 512 * 2; u.B = TT + ((size_t)bb * 512 + pn * 256) * 512 * 2; u.orow0 = bb * 256; u.orow1 = u.orow0 + 128; u.ocol = 1024 + pn * 256; }
        u.aux = 0; return true;
    }
};

__device__ __forceinline__ u32x4 pack8(const f32x4 v0, const f32x4 v1) { u32x4 w; w.x = cvt_pk_bf16(v0[0], v0[1]); w.y = cvt_pk_bf16(v0[2], v0[3]); w.z = cvt_pk_bf16(v1[0], v1[1]); w.w = cvt_pk_bf16(v1[2], v1[3]); return w; }
struct EpiStore {
    static constexpr bool MID = false;
    bf16_t* O; int ldc;
    __device__ __forceinline__ void operator()(const f32x4 (&acc)[2][2][4][2], const Unit& u, int wr, int wc, int fr, int fq) const {
        asm volatile("" : "+v"(fr), "+v"(fq));
#pragma unroll
        for (int ai = 0; ai < 2; ++ai)
#pragma unroll
            for (int m = 0; m < 4; ++m) { bf16_t* rowp = O + (size_t)((ai ? u.orow1 : u.orow0) + wr * 64 + m * 16 + fr) * ldc + u.ocol + wc * 32 + 8 * fq;
#pragma unroll
                for (int bj = 0; bj < 2; ++bj) *(u32x4*)(rowp + bj * 128) = pack8(acc[ai][bj][m][0], acc[ai][bj][m][1]); }
    }
};
struct EpiZ {
    static constexpr bool MID = false;
    bf16_t* Zm; bf16_t* Zg; const float* bgate;
    __device__ __forceinline__ void operator()(const f32x4 (&acc)[2][2][4][2], const Unit& u, int wr, int wc, int fr, int fq) const {
        asm volatile("" : "+v"(fr), "+v"(fq));
        const int pn = u.ocol >> 8; const int cb = wc * 32 + 8 * fq;
        if (pn >= 16) {
            const int col0 = u.ocol - 4096 + cb;
            f32x4 bv[2][2];
#pragma unroll
            for (int bj = 0; bj < 2; ++bj)
#pragma unroll
                for (int n = 0; n < 2; ++n) bv[bj][n] = *(const f32x4*)(bgate + col0 + bj * 128 + 4 * n);
#pragma unroll
            for (int ai = 0; ai < 2; ++ai)
#pragma unroll
                for (int m = 0; m < 4; ++m) { bf16_t* rowp = Zg + (size_t)((ai ? u.orow1 : u.orow0) + wr * 64 + m * 16 + fr) * 8192 + col0;
#pragma unroll
                    for (int bj = 0; bj < 2; ++bj) { f32x4 v0 = acc[ai][bj][m][0] + bv[bj][0], v1 = acc[ai][bj][m][1] + bv[bj][1];
#pragma unroll
                        for (int e = 0; e < 4; ++e) { v0[e] = sigmoidf_(v0[e]); v1[e] = sigmoidf_(v1[e]); }
                        *(u32x4*)(rowp + bj * 128) = pack8(v0, v1); } }
        } else {
            const bool gel = (pn >= 6 && pn < 10);
#pragma unroll
            for (int ai = 0; ai < 2; ++ai)
#pragma unroll
                for (int m = 0; m < 4; ++m) { bf16_t* rowp = Zm + (size_t)((ai ? u.orow1 : u.orow0) + wr * 64 + m * 16 + fr) * 4096 + u.ocol + cb;
#pragma unroll
                    for (int bj = 0; bj < 2; ++bj) { f32x4 v0 = acc[ai][bj][m][0], v1 = acc[ai][bj][m][1];
                        if (gel) {
#pragma unroll
                            for (int e = 0; e < 4; ++e) { v0[e] = gelu_tanh(v0[e]); v1[e] = gelu_tanh(v1[e]); } }
                        *(u32x4*)(rowp + bj * 128) = pack8(v0, v1); } }
        }
    }
};
struct EpiHid {
    static constexpr bool MID = false;
    bf16_t* O;
    __device__ __forceinline__ void operator()(const f32x4 (&acc)[2][2][4][2], const Unit& u, int wr, int wc, int fr, int fq) const {
        asm volatile("" : "+v"(fr), "+v"(fq));
#pragma unroll
        for (int ai = 0; ai < 2; ++ai)
#pragma unroll
            for (int m = 0; m < 4; ++m) { bf16_t* rowp = O + (size_t)((ai ? u.orow1 : u.orow0) + wr * 64 + m * 16 + fr) * DFF + u.ocol + wc * 32 + 8 * fq;
#pragma unroll
                for (int bj = 0; bj < 2; ++bj) { f32x4 v0 = acc[ai][bj][m][0], v1 = acc[ai][bj][m][1];
#pragma unroll
                    for (int e = 0; e < 4; ++e) { const float a = fmaxf(v0[e], 0.f), b = fmaxf(v1[e], 0.f); v0[e] = a * a; v1[e] = b * b; }
                    *(u32x4*)(rowp + bj * 128) = pack8(v0, v1); } }
    }
};
__device__ __forceinline__ void ho_send(const f32x4 (&acc)[2][2][4][2], unsigned long long* sb, unsigned* flag, int tidp) {
#pragma unroll
    for (int m = 0; m < 4; ++m)
#pragma unroll
        for (int bj = 0; bj < 2; ++bj)
#pragma unroll
            for (int n = 0; n < 2; ++n) { const f32x4 v = acc[1][bj][m][n]; unsigned long long* p = sb + (size_t)(((m * 2 + bj) * 2 + n) * 1024);
                __hip_atomic_store(p, ((unsigned long long)__float_as_uint(v[1]) << 32) | __float_as_uint(v[0]), __ATOMIC_RELAXED, __HIP_MEMORY_SCOPE_AGENT);
                __hip_atomic_store(p + 1, ((unsigned long long)__float_as_uint(v[3]) << 32) | __float_as_uint(v[2]), __ATOMIC_RELAXED, __HIP_MEMORY_SCOPE_AGENT); }
    asm volatile("s_waitcnt vmcnt(0)" ::: "memory");
    __syncthreads();
    if (tidp == 0) __hip_atomic_store(flag, 1u, __ATOMIC_RELEASE, __HIP_MEMORY_SCOPE_AGENT);
}
__device__ __forceinline__ void ho_wait(unsigned* flag, int tidp) {
    if (tidp == 0) { unsigned spin = 0; while (__hip_atomic_load(flag, __ATOMIC_ACQUIRE, __HIP_MEMORY_SCOPE_AGENT) == 0u) { __builtin_amdgcn_s_sleep(2); if (++spin > (1u << 24)) break; } }
    __syncthreads();
}
__device__ __forceinline__ f32x4 ho_get(unsigned long long* sb, int m, int bj, int n) {
    unsigned long long* p = sb + (size_t)(((m * 2 + bj) * 2 + n) * 1024);
    const unsigned long long a0 = __hip_atomic_load(p, __ATOMIC_RELAXED, __HIP_MEMORY_SCOPE_AGENT), a1 = __hip_atomic_load(p + 1, __ATOMIC_RELAXED, __HIP_MEMORY_SCOPE_AGENT);
    return (f32x4){__uint_as_float((unsigned)a0), __uint_as_float((unsigned)(a0 >> 32)), __uint_as_float((unsigned)a1), __uint_as_float((unsigned)(a1 >> 32))};
}
struct EpiRes {
    static constexpr bool MID = false;
    const float* xp; const float* xs; float* out; const float* mod; int gsel;
    float* S; unsigned* flags;
    __device__ __forceinline__ void operator()(const f32x4 (&acc)[2][2][4][2], const Unit& u, int wr, int wc, int fr, int fq) const {
        asm volatile("" : "+v"(fr), "+v"(fq));
        const int sp = u.aux & 2, jt = u.aux >> 2;
        const int tidp = (wr * 4 + wc) * 64 + fq * 16 + fr;
        const int kh = u.aux & 1;
        unsigned long long* sbs = (unsigned long long*)(S + (size_t)jt * 65536 + kh * 32768) + (size_t)tidp * 2;
        unsigned long long* sb = (unsigned long long*)(S + (size_t)jt * 65536 + (1 - kh) * 32768) + (size_t)tidp * 2;
        if (sp) { ho_send(acc, sbs, flags + jt * 16 + kh * 8, tidp); ho_wait(flags + jt * 16 + (1 - kh) * 8, tidp); }
        const int pm = u.orow0 >> 8; const int cond = pm < 16 ? 0 : 1 + ((pm - 16) >> 2);
        const int col0 = u.ocol + wc * 32 + 8 * fq;
        const float* gp = mod + ((size_t)cond * 6 + gsel) * 2048 + col0;
        f32x4 gv[2][2];
#pragma unroll
        for (int bj = 0; bj < 2; ++bj)
#pragma unroll
            for (int n = 0; n < 2; ++n) gv[bj][n] = *(const f32x4*)(gp + bj * 128 + 4 * n);
        const float* src = pm < 16 ? xp : xs - (size_t)NCTXT * DM;
#pragma unroll
        for (int ai = 0; ai < 2; ++ai) {
            if (ai == 1 && sp) break;
#pragma unroll
            for (int m = 0; m < 4; ++m) { const size_t off = (size_t)((ai ? u.orow1 : u.orow0) + wr * 64 + m * 16 + fr) * DM + col0;
#pragma unroll
                for (int bj = 0; bj < 2; ++bj)
#pragma unroll
                    for (int n = 0; n < 2; ++n) { const f32x4 xv = *(const f32x4*)(src + off + bj * 128 + 4 * n);
                        f32x4 v = acc[ai][bj][m][n];
                        if (ai == 0 && sp) v += ho_get(sb, m, bj, n);
                        *(f32x4*)(out + off + bj * 128 + 4 * n) = xv + gv[bj][n] * v; }
                if (m & 1) asm volatile("" ::: "memory"); } }
    }
};
struct EpiBR {
    static constexpr bool MID = true;
    const bf16_t* Zg; bf16_t* merged; float* S; unsigned* flags;
    __device__ __forceinline__ void scale(f32x4 (&acc)[2][2][4][2], const Unit& u, int b, bool ratio, int wr, int wc, int fr, int fq) const {
        const int col0 = u.ocol + wc * 32 + 8 * fq;
#pragma unroll
        for (int ai = 0; ai < 2; ++ai) {
            u32x4 gw[4][2], nw[4][2];
#pragma unroll
            for (int m = 0; m < 4; ++m)
#pragma unroll
                for (int bj = 0; bj < 2; ++bj) { const bf16_t* gp = Zg + (size_t)((ai ? u.orow1 : u.orow0) + wr * 64 + m * 16 + fr) * 8192 + b * 2048 + col0 + bj * 128;
                    gw[m][bj] = *(const u32x4*)gp; if (ratio) nw[m][bj] = *(const u32x4*)(gp + 2048); }
#pragma unroll
            for (int m = 0; m < 4; ++m)
#pragma unroll
                for (int bj = 0; bj < 2; ++bj) { const u32x4 g4 = gw[m][bj];
                    float g[8] = {bflo(g4.x), bfhi(g4.x), bflo(g4.y), bfhi(g4.y), bflo(g4.z), bfhi(g4.z), bflo(g4.w), bfhi(g4.w)};
#pragma unroll
                    for (int e = 0; e < 8; ++e) g[e] = fmaxf(g[e], 1e-6f);
                    if (ratio) { const u32x4 n4 = nw[m][bj];
                        const float gn[8] = {bflo(n4.x), bfhi(n4.x), bflo(n4.y), bfhi(n4.y), bflo(n4.z), bfhi(n4.z), bflo(n4.w), bfhi(n4.w)};
#pragma unroll
                        for (int e = 0; e < 8; ++e) g[e] *= __builtin_amdgcn_rcpf(fmaxf(gn[e], 1e-6f)); }
                    f32x4 v0 = acc[ai][bj][m][0], v1 = acc[ai][bj][m][1];
                    v0[0] *= g[0]; v0[1] *= g[1]; v0[2] *= g[2]; v0[3] *= g[3]; v1[0] *= g[4]; v1[1] *= g[5]; v1[2] *= g[6]; v1[3] *= g[7];
                    acc[ai][bj][m][0] = v0; acc[ai][bj][m][1] = v1; }
            asm volatile("" ::: "memory"); }
    }
    __device__ __forceinline__ void mid(f32x4 (&acc)[2][2][4][2], const Unit& u, int seg, int wr, int wc, int fr, int fq) const {
        asm volatile("" : "+v"(fr), "+v"(fq));
        const int base = (u.aux & 2) ? (u.aux & 1) * 2 : 0;
        scale(acc, u, base + seg - 1, true, wr, wc, fr, fq);
    }
    __device__ __forceinline__ void operator()(f32x4 (&acc)[2][2][4][2], const Unit& u, int wr, int wc, int fr, int fq) const {
        asm volatile("" : "+v"(fr), "+v"(fq));
        const int sp = u.aux & 2, kh = u.aux & 1, jt = u.aux >> 2;
        const int tidp = (wr * 4 + wc) * 64 + fq * 16 + fr;
        unsigned long long* sbs = (unsigned long long*)(S + (size_t)jt * 65536 + kh * 32768) + (size_t)tidp * 2;
        unsigned long long* sb = (unsigned long long*)(S + (size_t)jt * 65536 + (1 - kh) * 32768) + (size_t)tidp * 2;
        scale(acc, u, sp ? kh * 2 + 1 : 3, false, wr, wc, fr, fq);
        if (sp) { ho_send(acc, sbs, flags + jt * 16 + kh * 8, tidp); ho_wait(flags + jt * 16 + (1 - kh) * 8, tidp); }
        const int col0 = u.ocol + wc * 32 + 8 * fq;
#pragma unroll
        for (int ai = 0; ai < 2; ++ai) {
            if (ai == 1 && sp) break;
#pragma unroll
            for (int m = 0; m < 4; ++m) { const size_t row = (size_t)((ai ? u.orow1 : u.orow0) + wr * 64 + m * 16 + fr);
#pragma unroll
                for (int bj = 0; bj < 2; ++bj) { f32x4 v0 = acc[ai][bj][m][0], v1 = acc[ai][bj][m][1];
                    if (ai == 0 && sp) { v0 += ho_get(sb, m, bj, 0); v1 += ho_get(sb, m, bj, 1); }
                    *(u32x4*)(merged + row * DM + col0 + bj * 128) = pack8(v0, v1); }
                asm volatile("" ::: "memory"); } }
    }
};
}

__device__ __forceinline__ void transpose_item(const float* W, int N, int k0, int n0, bf16_t* D, int ldo, int dn0, int dk0, LAS float* scr, int lane) {
#pragma unroll 8
    for (int i = 0; i < 32; ++i) { const int kk = 2 * i + (lane >> 5); scr[kk * 33 + (lane & 31)] = W[(size_t)(k0 + kk) * N + n0 + (lane & 31)]; }
    LDS_WAIT(); asm volatile("" ::: "memory");
    const int c = lane & 7;
#pragma unroll
    for (int j = 0; j < 4; ++j) { const int n = (lane >> 3) + 8 * j; const LAS float* s = scr + (8 * c) * 33 + n;
        u32x4 o; o.x = cvt_pk_bf16(s[0 * 33], s[1 * 33]); o.y = cvt_pk_bf16(s[2 * 33], s[3 * 33]); o.z = cvt_pk_bf16(s[4 * 33], s[5 * 33]); o.w = cvt_pk_bf16(s[6 * 33], s[7 * 33]);
        *(u32x4*)(D + (size_t)(dn0 + n) * ldo + dk0 + 8 * c) = o; }
    LDS_WAIT(); asm volatile("" ::: "memory");
}

__device__ __forceinline__ void phase_p0(const Args& a, LAS unsigned char* lds, int tid, int lane, int wave, int G, int bid) {
    unsigned char* ws = a.ws;
    LAS float* scr = (LAS float*)(lds + wave * 16384);
    const int gw = bid * 8 + wave, NGW = G * 8;
    if (bid == 0 && tid < 16) ((unsigned*)(ws + O_CTL))[64 * tid] = 0u;
    if (bid == 0 && tid < 32) ((unsigned*)(ws + O_CTL))[1024 + 64 * tid] = 0u;
    constexpr int IT_WIN = 32 * 368, IT_WBR = 32 * 64, IT_WOUT = 32 * 64, IT_W1 = 32 * 256, IT_W2 = 128 * 64, IT_L = IT_WIN + IT_WBR + IT_WOUT + IT_W1 + IT_W2;
    constexpr int IT_CV = 128 * 16;
    for (int it = gw; it < 2 * IT_L + IT_CV; it += NGW) {
        if (it >= 2 * IT_L) {
            const int r = it - 2 * IT_L, mtx = r >> 4, kb = (r >> 1) & 7, nb = r & 1;
            transpose_item(a.in[I_CV] + (size_t)mtx * 512 * 64, 64, kb * 64, nb * 32, (bf16_t*)(ws + O_VTC) + (size_t)mtx * 64 * 512, 512, nb * 32, kb * 64, scr, lane);
            continue;
        }
        const int l = it / IT_L; int r = it % IT_L;
        if (r < IT_WIN) {
            const int kb = r / 368, nb = r % 368, k0 = kb * 64, n0 = nb * 32;
            const float* W = a.in[I_WIN] + (size_t)l * DM * INC;
            if (n0 >= 2560 && n0 < 3072) {
                const int g = (n0 - 2560) >> 7, c0 = (n0 - 2560) & 127;
                bf16_t* D = (bf16_t*)(ws + O_WFN) + ((size_t)(l * 4 + g) * 2048) * 128;
#pragma unroll 8
                for (int i = 0; i < 32; ++i) { const int kk = 2 * i + (lane >> 5); D[(size_t)(k0 + kk) * 128 + c0 + (lane & 31)] = f2bf(W[(size_t)(k0 + kk) * INC + n0 + (lane & 31)]); }
            } else {
                const int dn0 = n0 < 2560 ? n0 : n0 + 512;
                transpose_item(W, INC, k0, n0, (bf16_t*)(ws + O_WINT) + (size_t)l * 12288 * 2048, 2048, dn0, k0, scr, lane);
            }
            continue;
        } r -= IT_WIN;
        if (r < IT_WBR) {
            const int kb = r / 64, nb = r % 64, k0 = kb * 64, n0 = nb * 32;
            const float* W = a.in[I_WBR] + (size_t)l * DM * DM;
            if (k0 < 1536) transpose_item(W, DM, k0, n0, (bf16_t*)(ws + O_WBT) + (size_t)l * DM * DM, 2048, n0, k0, scr, lane);
            else transpose_item(W, DM, k0, n0, (bf16_t*)(ws + O_WBD) + (size_t)l * DM * 512, 512, n0, k0 - 1536, scr, lane);
            continue;
        } r -= IT_WBR;
        if (r < IT_WOUT) { const int kb = r / 64, nb = r % 64; transpose_item(a.in[I_WOUT] + (size_t)l * DM * DM, DM, kb * 64, nb * 32, (bf16_t*)(ws + O_WOT) + (size_t)l * DM * DM, 2048, nb * 32, kb * 64, scr, lane); continue; } r -= IT_WOUT;
        if (r < IT_W1) { const int kb = r / 256, nb = r % 256; transpose_item(a.in[I_W1] + (size_t)l * DM * DFF, DFF, kb * 64, nb * 32, (bf16_t*)(ws + O_W1T) + (size_t)l * DFF * DM, 2048, nb * 32, kb * 64, scr, lane); continue; } r -= IT_W1;
        { const int kb = r / 64, nb = r % 64; transpose_item(a.in[I_W2] + (size_t)l * DFF * DM, DM, kb * 64, nb * 32, (bf16_t*)(ws + O_W2T) + (size_t)l * DM * DFF, 8192, nb * 32, kb * 64, scr, lane); }
    }
    const int gt = bid * 512 + tid, NGT = G * 512;
    for (int i = gt; i < 2 * 512 * 512; i += NGT) {
        const int l = i >> 18, c = (i >> 9) & 511, d = i & 511; float v = 0.f;
        if ((c >> 7) == (d >> 7)) v = a.in[I_WPOOL][(((size_t)l * 4 + (c >> 7)) * 128 + (c & 127)) * 128 + (d & 127)] * a.in[I_PSC][l * 512 + d];
        ((bf16_t*)(ws + O_BDP))[i] = f2bf(v);
    }
    for (int i = gt; i < 256 * 256; i += NGT) {
        const int r = i >> 8, c = i & 255, cp = r & 127; const float t = (float)((cp * c) & 127) * (2.0f / 128.0f);
        ((bf16_t*)(ws + O_CS))[i] = f2bf(c < 128 ? (r < 128 ? cospif(t) : sinpif(t)) * 0.08838834764831845f : 0.f);
    }
    for (int i = gt; i < 256 * 512; i += NGT) {
        const int k = i >> 9, c = i & 511, n = c & 255; const float t = (float)((k * n) & 255) * (2.0f / 256.0f);
        ((bf16_t*)(ws + O_DFT256))[i] = f2bf((c < 256 ? cospif(t) : -sinpif(t)) * 0.0625f);
    }
    for (int i = gt; i < 1024 * 2048; i += NGT) {
        const int k = i >> 11, c = i & 2047, n = c & 1023; const float t = (float)((k * n) & 1023) * (2.0f / 1024.0f);
        ((bf16_t*)(ws + O_DFT1024))[i] = f2bf((c < 1024 ? cospif(t) : -sinpif(t)) * 0.03125f);
    }
    for (int i = gt; i < 2 * 4 * 128 * 128; i += NGT) ((bf16_t*)(ws + O_WSB))[i] = f2bf(a.in[I_WSP][i]);
    for (int i = gt; i < 8 * 2 * 8 * 512 * 64 / 4; i += NGT) { const f32x4 v = ((const f32x4*)a.in[I_CK])[i]; u32x2 w; w.x = cvt_pk_bf16(v[0], v[1]); w.y = cvt_pk_bf16(v[2], v[3]); ((u32x2*)(ws + O_CK))[i] = w; }
    __syncthreads();
    for (int it = gw; it < 2 * 16 * 48; it += NGW) {
        const int l = it / 768, rem = it % 768, dch = rem / 48, cb = rem % 48, j0 = cb * 256 + lane * 4, d0 = dch * 128;
        for (int i = lane; i < NCOND * 128; i += 64) { const int cond = i >> 7, d = i & 127; const float x = cond == 0 ? a.in[I_CCTX][d0 + d] : a.in[I_C][(size_t)(cond - 1) * DM + d0 + d]; scr[i] = x * sigmoidf_(x); }
        LDS_WAIT(); asm volatile("" ::: "memory");
        f32x4 acc[NCOND];
#pragma unroll
        for (int c = 0; c < NCOND; ++c) acc[c] = (f32x4){0.f, 0.f, 0.f, 0.f};
        const float* wp = a.in[I_WADA] + ((size_t)l * DM + d0) * 12288 + j0;
#pragma unroll 4
        for (int d = 0; d < 128; ++d) { const f32x4 w = *(const f32x4*)(wp + (size_t)d * 12288);
#pragma unroll
            for (int c = 0; c < NCOND; ++c) acc[c] += w * scr[c * 128 + d]; }
#pragma unroll
        for (int c = 0; c < NCOND; ++c) *(f32x4*)((float*)(ws + O_MODP) + ((size_t)(dch * 2 + l) * NCOND + c) * 12288 + j0) = acc[c];
        LDS_WAIT(); asm volatile("" ::: "memory");
    }
}

__device__ __forceinline__ void phase_p1_modreduce(const Args& a, int tid, int G, int bid) {
    const int gt = bid * 512 + tid, NGT = G * 512;
    const float* P = (const float*)(a.ws + O_MODP); float* M = (float*)(a.ws + O_MOD);
    for (int i = gt; i < 2 * NCOND * 2048; i += NGT) {
        const int l = i / (NCOND * 2048), cond = (i / 2048) % NCOND, col = i & 2047;
        float m[6];
#pragma unroll
        for (int s = 0; s < 6; ++s) { float v = a.in[I_BADA][l * 12288 + s * 2048 + col];
            for (int dch = 0; dch < 16; ++dch) v += P[((size_t)(dch * 2 + l) * NCOND + cond) * 12288 + s * 2048 + col];
            m[s] = v; }
        float* o = M + ((size_t)(l * NCOND + cond) * 6) * 2048 + col;
        o[0] = a.in[I_N1G][l * 2048 + col] * (1.f + m[1]); o[2048] = m[0]; o[2 * 2048] = m[2];
        o[3 * 2048] = a.in[I_N2G][l * 2048 + col] * (1.f + m[4]); o[4 * 2048] = m[3]; o[5 * 2048] = m[5];
    }
}

__device__ __forceinline__ void phase_norm(const Args& a, int l, int which, bool from_input, int lane, int wave, int G, int bid) {
    const int gw = bid * 8 + wave, NGW = G * 8;
    bf16_t* H = (bf16_t*)(a.ws + O_H);
    const int chunk = (NTOK + NGW - 1) / NGW;
    int row = gw * chunk; const int rend = (row + chunk) < NTOK ? (row + chunk) : NTOK;
    if (row >= rend) return;
#define NORM_XPTR(r) (from_input ? ((r) < NCTXT ? a.in[I_XP] + (size_t)(r) * DM : a.in[I_XS] + (size_t)((r) - NCTXT) * DM) : a.out + (size_t)(r) * DM)
    f32x4 v[8], av[8], sv[8]; int ccond = -1;
    { const float* xr = NORM_XPTR(row);
#pragma unroll
      for (int j = 0; j < 8; ++j) v[j] = *(const f32x4*)(xr + j * 256 + lane * 4); }
    for (; row < rend; ++row) {
        f32x4 vn[8];
        if (row + 1 < rend) { const float* xr = NORM_XPTR(row + 1);
#pragma unroll
            for (int j = 0; j < 8; ++j) vn[j] = *(const f32x4*)(xr + j * 256 + lane * 4); }
        const int cond = row < NCTXT ? 0 : 1 + ((row - NCTXT) >> 10);
        if (cond != ccond) { ccond = cond; const float* ap = (const float*)(a.ws + O_MOD) + ((size_t)(l * NCOND + cond) * 6 + which) * 2048;
#pragma unroll
            for (int j = 0; j < 8; ++j) { av[j] = *(const f32x4*)(ap + j * 256 + lane * 4); sv[j] = *(const f32x4*)(ap + 2048 + j * 256 + lane * 4); } }
        float s = 0.f;
#pragma unroll
        for (int j = 0; j < 8; ++j) s += (v[j][0] * v[j][0] + v[j][1] * v[j][1]) + (v[j][2] * v[j][2] + v[j][3] * v[j][3]);
        const float r = rsqrtf(wave_sum(s) * (1.0f / DM) + 1e-6f);
#pragma unroll
        for (int j = 0; j < 8; ++j) { const f32x4 o = v[j] * r * av[j] + sv[j]; u32x2 w; w.x = cvt_pk_bf16(o[0], o[1]); w.y = cvt_pk_bf16(o[2], o[3]);
            *(u32x2*)(H + (size_t)row * DM + j * 256 + lane * 4) = w; }
#pragma unroll
        for (int j = 0; j < 8; ++j) v[j] = vn[j];
    }
#undef NORM_XPTR
}

template <bool SCALE>
__device__ __forceinline__ void transpose128(const bf16_t* src, int ld_src, bf16_t* dst, int ld_dst, LAS unsigned char* lds, int tid, const LAS float* rtab, const float* gvec) {
    LAS bf16_t* T = (LAS bf16_t*)lds;
#pragma unroll
    for (int j = 0; j < 4; ++j) { const int ch = tid + j * 512, row = ch >> 4, cc = ch & 15;
        u32x4 v = *(const u32x4*)(src + (size_t)row * ld_src + cc * 8);
        if (SCALE) { const float r = rtab[row]; const f32x4 g0 = *(const f32x4*)(gvec + cc * 8), g1 = *(const f32x4*)(gvec + cc * 8 + 4);
            v.x = cvt_pk_bf16(bflo(v.x) * r * g0[0], bfhi(v.x) * r * g0[1]); v.y = cvt_pk_bf16(bflo(v.y) * r * g0[2], bfhi(v.y) * r * g0[3]);
            v.z = cvt_pk_bf16(bflo(v.z) * r * g1[0], bfhi(v.z) * r * g1[1]); v.w = cvt_pk_bf16(bflo(v.w) * r * g1[2], bfhi(v.w) * r * g1[3]); }
        *(LAS u32x4*)(T + row * 136 + cc * 8) = v; }
    __syncthreads();
#pragma unroll
    for (int j = 0; j < 4; ++j) { const int ch = tid + j * 512, c = ch & 127, qc = ch >> 7;
        unsigned short e[8];
#pragma unroll
        for (int k = 0; k < 8; ++k) e[k] = T[(qc * 8 + k) * 136 + c];
        u32x4 o; o.x = e[0] | ((unsigned)e[1] << 16); o.y = e[2] | ((unsigned)e[3] << 16); o.z = e[4] | ((unsigned)e[5] << 16); o.w = e[6] | ((unsigned)e[7] << 16);
        *(u32x4*)(dst + (size_t)c * ld_dst + qc * 8) = o; }
    __syncthreads();
}

template <int W>
__device__ __forceinline__ void pool_rows(const bf16_t* base, bf16_t* outp, int pos0, int npos, int tl0, int tsub) {
#pragma unroll 2
    for (int it = 0; it < 16; ++it) {
        const int tl = tl0 + it * 4 + tsub, pos = pos0 + tl;
        int lo = pos - (W >> 1); if (lo < 0) lo = 0; int hi = pos + (W >> 1) - 1; if (hi > npos - 1) hi = npos - 1;
        u32x4 x[W];
#pragma unroll
        for (int j = 0; j < W; ++j) { int p = pos - (W >> 1) + j; p = p < lo ? lo : (p > hi ? hi : p); x[j] = *(const u32x4*)(base + (size_t)p * 4096); }
        float s[8] = {0.f, 0.f, 0.f, 0.f, 0.f, 0.f, 0.f, 0.f};
#pragma unroll
        for (int j = 0; j < W; ++j) { const int p = pos - (W >> 1) + j; const float wgt = (p >= lo && p <= hi) ? 1.f : 0.f;
            s[0] += wgt * bflo(x[j].x); s[1] += wgt * bfhi(x[j].x); s[2] += wgt * bflo(x[j].y); s[3] += wgt * bfhi(x[j].y);
            s[4] += wgt * bflo(x[j].z); s[5] += wgt * bfhi(x[j].z); s[6] += wgt * bflo(x[j].w); s[7] += wgt * bfhi(x[j].w); }
        const u32x4 xc = x[W >> 1]; const float inv = 1.0f / (float)(hi - lo + 1);
        u32x4 o; o.x = cvt_pk_bf16(s[0] * inv - bflo(xc.x), s[1] * inv - bfhi(xc.x)); o.y = cvt_pk_bf16(s[2] * inv - bflo(xc.y), s[3] * inv - bfhi(xc.y));
        o.z = cvt_pk_bf16(s[4] * inv - bflo(xc.z), s[5] * inv - bfhi(xc.z)); o.w = cvt_pk_bf16(s[6] * inv - bflo(xc.w), s[7] * inv - bfhi(xc.w));
        *(u32x4*)(outp + (size_t)tl * 2048) = o;
    }
}

__device__ __forceinline__ void phase_prep(const Args& a, int l, LAS unsigned char* lds, int tid, int lane, int wave, int G, int bid) {
    unsigned char* ws = a.ws;
    const bf16_t* Zm = (const bf16_t*)(ws + O_ZM);
    unsigned* qctr = (unsigned*)(ws + O_CTL) + 64 * (8 + l);
    LAS int* qslot = (LAS int*)(lds + 131072 + 128);
    for (;;) {
        __syncthreads();
        if (tid == 0) *qslot = (int)atomicAdd(qctr, 1u);
        __syncthreads();
        const int qi = *qslot; if (qi >= 96 * 6) break;
        const int ord = qi / 96, tt = qi % 96; const int task = ord == 0 ? 0 : (ord == 1 ? 5 : ord - 1);
        const bool ctx = tt < 32; const int bb = ctx ? (tt >> 1) : ((tt - 32) >> 3); const int pos0 = ctx ? (tt & 1) * 128 : ((tt - 32) & 7) * 128; const int npos = ctx ? 256 : 1024;
        const int tok0 = tt * 128;
        if (task == 0) {
            const int j = lane & 7, hd = lane >> 3;
            const f32x4 gq0 = *(const f32x4*)(a.in[I_QNG] + l * 64 + j * 8), gq1 = *(const f32x4*)(a.in[I_QNG] + l * 64 + j * 8 + 4);
            const f32x4 gk0 = *(const f32x4*)(a.in[I_KNG] + l * 64 + j * 8), gk1 = *(const f32x4*)(a.in[I_KNG] + l * 64 + j * 8 + 4);
            const int ax = j >> 2; const bool isx2 = (j & 2) != 0; const int i0 = (j & 1) * 8;
            float invf[8];
#pragma unroll
            for (int e = 0; e < 8; ++e) invf[e] = __builtin_amdgcn_exp2f(-(float)(i0 + e) * (13.287712379549449f / 16.0f));
#pragma unroll 1
            for (int tb = 0; tb < 4; ++tb) {
                u32x4 qw4[4], kw4[4];
#pragma unroll
                for (int u = 0; u < 4; ++u) { const int tok = tok0 + wave * 16 + tb * 4 + u; qw4[u] = *(const u32x4*)(Zm + (size_t)tok * 4096 + lane * 8); kw4[u] = *(const u32x4*)(Zm + (size_t)tok * 4096 + 512 + lane * 8); }
#pragma unroll
                for (int u = 0; u < 4; ++u) {
                    const int tl = wave * 16 + tb * 4 + u, tok = tok0 + tl, pos = pos0 + tl;
                    const u32x4 qw = qw4[u], kw = kw4[u];
                    float q[8] = {bflo(qw.x), bfhi(qw.x), bflo(qw.y), bfhi(qw.y), bflo(qw.z), bfhi(qw.z), bflo(qw.w), bfhi(qw.w)};
                    float k[8] = {bflo(kw.x), bfhi(kw.x), bflo(kw.y), bfhi(kw.y), bflo(kw.z), bfhi(kw.z), bflo(kw.w), bfhi(kw.w)};
                    float sq = 0.f, sk = 0.f;
#pragma unroll
                    for (int e = 0; e < 8; ++e) { sq += q[e] * q[e]; sk += k[e] * k[e]; }
                    sq += __shfl_xor(sq, 1); sq += __shfl_xor(sq, 2); sq += __shfl_xor(sq, 4);
                    sk += __shfl_xor(sk, 1); sk += __shfl_xor(sk, 2); sk += __shfl_xor(sk, 4);
                    const float rq = rsqrtf(sq * (1.f / 64.f) + 1e-6f), rk = rsqrtf(sk * (1.f / 64.f) + 1e-6f);
#pragma unroll
                    for (int e = 0; e < 8; ++e) { q[e] *= rq * (e < 4 ? gq0[e & 3] : gq1[e & 3]); k[e] *= rk * (e < 4 ? gk0[e & 3] : gk1[e & 3]); }
                    { u32x4 o; o.x = cvt_pk_bf16(q[0] * 0.125f, q[1] * 0.125f); o.y = cvt_pk_bf16(q[2] * 0.125f, q[3] * 0.125f); o.z = cvt_pk_bf16(q[4] * 0.125f, q[5] * 0.125f); o.w = cvt_pk_bf16(q[6] * 0.125f, q[7] * 0.125f);
                      *(u32x4*)((bf16_t*)(ws + O_QP) + (size_t)tok * 512 + lane * 8) = o; }
                    if (ctx) {
                        u32x4 o; o.x = cvt_pk_bf16(k[0], k[1]); o.y = cvt_pk_bf16(k[2], k[3]); o.z = cvt_pk_bf16(k[4], k[5]); o.w = cvt_pk_bf16(k[6], k[7]);
                        *(u32x4*)((bf16_t*)(ws + O_KB) + (size_t)tok * 512 + lane * 8) = o;
                        float* ok = a.out + OUTK + ((((size_t)bb * 2 + l) * 8 + hd) * 256 + pos) * 64 + j * 8;
                        *(f32x4*)ok = (f32x4){k[0], k[1], k[2], k[3]}; *(f32x4*)(ok + 4) = (f32x4){k[4], k[5], k[6], k[7]};
                    } else {
                        const float p = (float)(ax == 0 ? (pos >> 6) : (pos & 63));
                        float qr[8], kr[8];
#pragma unroll
                        for (int e = 0; e < 8; ++e) {
                            const float ang = p * invf[e]; const float cs = __cosf(ang), sn = __sinf(ang);
                            const float pq = __shfl_xor(q[e], 2), pk = __shfl_xor(k[e], 2);
                            qr[e] = q[e] * cs + (isx2 ? pq : -pq) * sn; kr[e] = k[e] * cs + (isx2 ? pk : -pk) * sn;
                        }
                        u32x4 o; o.x = cvt_pk_bf16(qr[0] * 0.125f, qr[1] * 0.125f); o.y = cvt_pk_bf16(qr[2] * 0.125f, qr[3] * 0.125f); o.z = cvt_pk_bf16(qr[4] * 0.125f, qr[5] * 0.125f); o.w = cvt_pk_bf16(qr[6] * 0.125f, qr[7] * 0.125f);
                        *(u32x4*)((bf16_t*)(ws + O_QR) + (size_t)(tok - NCTXT) * 512 + lane * 8) = o;
                        u32x4 o2; o2.x = cvt_pk_bf16(kr[0], kr[1]); o2.y = cvt_pk_bf16(kr[2], kr[3]); o2.z = cvt_pk_bf16(kr[4], kr[5]); o2.w = cvt_pk_bf16(kr[6], kr[7]);
                        *(u32x4*)((bf16_t*)(ws + O_KB) + (size_t)tok * 512 + lane * 8) = o2;
                    }
                }
            }
        } else if (task == 1) {
            bf16_t* vt = (bf16_t*)(ws + O_VT) + (ctx ? (size_t)bb * 512 * 256 : (size_t)16 * 512 * 256 + (size_t)bb * 512 * 1024) + pos0;
            if (ctx) {
                const int j = lane & 7, hd = lane >> 3;
#pragma unroll 1
                for (int tb = 0; tb < 2; ++tb) {
                    u32x4 w8[8];
#pragma unroll
                    for (int u = 0; u < 8; ++u) w8[u] = *(const u32x4*)(Zm + (size_t)(tok0 + wave * 16 + tb * 8 + u) * 4096 + 1024 + lane * 8);
#pragma unroll
                    for (int u = 0; u < 8; ++u) { const int pos = pos0 + wave * 16 + tb * 8 + u; const u32x4 w = w8[u];
                        float* ov = a.out + OUTV + ((((size_t)bb * 2 + l) * 8 + hd) * 256 + pos) * 64 + j * 8;
                        *(f32x4*)ov = (f32x4){bflo(w.x), bfhi(w.x), bflo(w.y), bfhi(w.y)}; *(f32x4*)(ov + 4) = (f32x4){bflo(w.z), bfhi(w.z), bflo(w.w), bfhi(w.w)}; }
                }
            }
            for (int sub = 0; sub < 4; ++sub)
                transpose128<false>(Zm + (size_t)tok0 * 4096 + 1024 + sub * 128, 4096, vt + (size_t)sub * 128 * npos, npos, lds, tid, nullptr, nullptr);
        } else if (task == 2) {
            LAS float* rtab = (LAS float*)(lds + 40960);
#pragma unroll 1
            for (int tb = 0; tb < 2; ++tb) {
                u32x4 w8[8];
#pragma unroll
                for (int u = 0; u < 8; ++u) w8[u] = *(const u32x4*)(Zm + (size_t)(tok0 + wave * 16 + tb * 8 + u) * 4096 + 2048 + lane * 8);
#pragma unroll
                for (int u = 0; u < 8; ++u) { const u32x4 w = w8[u];
                    float s = bflo(w.x) * bflo(w.x) + bfhi(w.x) * bfhi(w.x) + bflo(w.y) * bflo(w.y) + bfhi(w.y) * bfhi(w.y) + bflo(w.z) * bflo(w.z) + bfhi(w.z) * bfhi(w.z) + bflo(w.w) * bflo(w.w) + bfhi(w.w) * bfhi(w.w);
                    s = wave_sum(s); if (lane == 0) rtab[wave * 16 + tb * 8 + u] = rsqrtf(s * (1.f / 512.f) + 1e-6f); }
            }
            __syncthreads();
            for (int sub = 0; sub < 4; ++sub)
                transpose128<true>(Zm + (size_t)tok0 * 4096 + 2048 + sub * 128, 4096, (bf16_t*)(ws + O_VNT) + ((size_t)tt * 512 + sub * 128) * 128, 128, lds, tid, rtab, a.in[I_GNG] + l * 512 + sub * 128);
        } else if (task == 3 || task == 4) {
            const int part = task - 3;
            bf16_t* tb = (bf16_t*)(ws + O_TT) + (ctx ? (size_t)bb * 512 * 512 : (size_t)16 * 512 * 512 + (size_t)bb * 512 * 2048) + part * npos + pos0;
            for (int sub = 0; sub < 4; ++sub)
                transpose128<false>(Zm + (size_t)tok0 * 4096 + 2560 + part * 512 + sub * 128, 4096, tb + (size_t)sub * 128 * 2 * npos, 2 * npos, lds, tid, nullptr, nullptr);
        } else {
            const int gi = wave & 3, half = wave >> 2, tsub = lane >> 4, c8 = gi * 16 + (lane & 15);
            const bf16_t* base = Zm + (size_t)(tok0 - pos0) * 4096 + 3584 + c8 * 8;
            bf16_t* outp = (bf16_t*)(ws + O_BR) + (size_t)tok0 * 2048 + 1536 + c8 * 8;
            if (gi == 0) pool_rows<2>(base, outp, pos0, npos, half * 64, tsub);
            else if (gi == 1) pool_rows<4>(base, outp, pos0, npos, half * 64, tsub);
            else if (gi == 2) pool_rows<8>(base, outp, pos0, npos, half * 64, tsub);
            else pool_rows<16>(base, outp, pos0, npos, half * 64, tsub);
        }
    }
}

#define MFMA16(a, b, c) __builtin_amdgcn_mfma_f32_16x16x32_bf16(a, b, c, 0, 0, 0)
struct KVF { bf16x8 k[4]; bf16x8 v[4]; };
struct KVOff { unsigned k0, k1, v[4]; };
__device__ __forceinline__ KVOff kv_off(int ldk, int ldv, int lane) {
    const int i = lane & 15, g = lane >> 4; const int ko0 = 8 * (i >> 2) + (i & 3);
    KVOff o; o.k0 = (unsigned)(ko0 * ldk + 8 * g) * 2u; o.k1 = o.k0 + (unsigned)(4 * ldk) * 2u;
#pragma unroll
    for (int dt = 0; dt < 4; ++dt) o.v[dt] = (unsigned)((16 * dt + i) * ldv + 8 * g) * 2u;
    return o;
}
__device__ __forceinline__ void kv_load(KVF& f, const bf16_t* kp, const bf16_t* vp, const KVOff& o) {
    const char* kc = (const char*)kp; const char* vc = (const char*)vp;
    f.k[0] = *(const bf16x8*)(kc + o.k0); f.k[1] = *(const bf16x8*)(kc + o.k0 + 64); f.k[2] = *(const bf16x8*)(kc + o.k1); f.k[3] = *(const bf16x8*)(kc + o.k1 + 64);
#pragma unroll
    for (int dt = 0; dt < 4; ++dt) f.v[dt] = *(const bf16x8*)(vc + o.v[dt]);
}
struct QSt { f32x4 o[4]; float m, lsum; };
__device__ __forceinline__ void attn_step(const KVF& f, const bf16x8 (&qf)[2], const float (&sb)[8], bool use_sb, QSt& st) {
    f32x4 s0 = {0.f, 0.f, 0.f, 0.f}, s1 = {0.f, 0.f, 0.f, 0.f};
    s0 = MFMA16(f.k[0], qf[0], s0); s0 = MFMA16(f.k[1], qf[1], s0);
    s1 = MFMA16(f.k[2], qf[0], s1); s1 = MFMA16(f.k[3], qf[1], s1);
    float s[8] = {s0[0], s0[1], s0[2], s0[3], s1[0], s1[1], s1[2], s1[3]};
    if (use_sb) {
#pragma unroll
        for (int e = 0; e < 8; ++e) s[e] = sb[e] < -1e29f ? -3e30f : s[e] + sb[e];
    }
    float mx = fmaxf(fmaxf(fmaxf(s[0], s[1]), fmaxf(s[2], s[3])), fmaxf(fmaxf(s[4], s[5]), fmaxf(s[6], s[7])));
    mx = fmaxf(mx, __shfl_xor(mx, 16)); mx = fmaxf(mx, __shfl_xor(mx, 32));
    const float mn = fmaxf(st.m, mx); const float alpha = fast_exp(st.m - mn); st.m = mn;
    float ps = 0.f;
#pragma unroll
    for (int e = 0; e < 8; ++e) { s[e] = fast_exp(s[e] - mn); ps += s[e]; }
    st.lsum = st.lsum * alpha + ps;
#pragma unroll
    for (int dt = 0; dt < 4; ++dt) st.o[dt] *= alpha;
    u32x4 pw; pw.x = cvt_pk_bf16(s[0], s[1]); pw.y = cvt_pk_bf16(s[2], s[3]); pw.z = cvt_pk_bf16(s[4], s[5]); pw.w = cvt_pk_bf16(s[6], s[7]);
    const bf16x8 pf = __builtin_bit_cast(bf16x8, pw);
#pragma unroll
    for (int dt = 0; dt < 4; ++dt) st.o[dt] = MFMA16(f.v[dt], pf, st.o[dt]);
}
__device__ __forceinline__ void attn_step2(const KVF& f0, const KVF& f1, const bf16x8 (&qf)[2], QSt& st) {
    f32x4 s0 = {0.f, 0.f, 0.f, 0.f}, s1 = {0.f, 0.f, 0.f, 0.f}, s2 = {0.f, 0.f, 0.f, 0.f}, s3 = {0.f, 0.f, 0.f, 0.f};
    s0 = MFMA16(f0.k[0], qf[0], s0); s1 = MFMA16(f0.k[2], qf[0], s1); s2 = MFMA16(f1.k[0], qf[0], s2); s3 = MFMA16(f1.k[2], qf[0], s3);
    s0 = MFMA16(f0.k[1], qf[1], s0); s1 = MFMA16(f0.k[3], qf[1], s1); s2 = MFMA16(f1.k[1], qf[1], s2); s3 = MFMA16(f1.k[3], qf[1], s3);
    float s[16] = {s0[0], s0[1], s0[2], s0[3], s1[0], s1[1], s1[2], s1[3], s2[0], s2[1], s2[2], s2[3], s3[0], s3[1], s3[2], s3[3]};
    float mx = fmaxf(fmaxf(fmaxf(s[0], s[1]), fmaxf(s[2], s[3])), fmaxf(fmaxf(s[4], s[5]), fmaxf(s[6], s[7])));
    mx = fmaxf(mx, fmaxf(fmaxf(fmaxf(s[8], s[9]), fmaxf(s[10], s[11])), fmaxf(fmaxf(s[12], s[13]), fmaxf(s[14], s[15]))));
    mx = fmaxf(mx, __shfl_xor(mx, 16)); mx = fmaxf(mx, __shfl_xor(mx, 32));
    const float mn = fmaxf(st.m, mx); const float alpha = fast_exp(st.m - mn); st.m = mn;
    float ps = 0.f;
#pragma unroll
    for (int e = 0; e < 16; ++e) { s[e] = fast_exp(s[e] - mn); ps += s[e]; }
    st.lsum = st.lsum * alpha + ps;
#pragma unroll
    for (int dt = 0; dt < 4; ++dt) st.o[dt] *= alpha;
    u32x4 pw0, pw1; pw0.x = cvt_pk_bf16(s[0], s[1]); pw0.y = cvt_pk_bf16(s[2], s[3]); pw0.z = cvt_pk_bf16(s[4], s[5]); pw0.w = cvt_pk_bf16(s[6], s[7]);
    pw1.x = cvt_pk_bf16(s[8], s[9]); pw1.y = cvt_pk_bf16(s[10], s[11]); pw1.z = cvt_pk_bf16(s[12], s[13]); pw1.w = cvt_pk_bf16(s[14], s[15]);
    const bf16x8 pf0 = __builtin_bit_cast(bf16x8, pw0), pf1 = __builtin_bit_cast(bf16x8, pw1);
#pragma unroll
    for (int dt = 0; dt < 4; ++dt) { st.o[dt] = MFMA16(f0.v[dt], pf0, st.o[dt]); st.o[dt] = MFMA16(f1.v[dt], pf1, st.o[dt]); }
}
__device__ __forceinline__ void attn_store(const QSt& st0, bf16_t* op) {
    QSt st = st0; st.lsum += __shfl_xor(st.lsum, 16); st.lsum += __shfl_xor(st.lsum, 32);
    const float inv = 1.0f / st.lsum;
#pragma unroll
    for (int dt = 0; dt < 4; ++dt) { u32x2 w2; w2.x = cvt_pk_bf16(st.o[dt][0] * inv, st.o[dt][1] * inv); w2.y = cvt_pk_bf16(st.o[dt][2] * inv, st.o[dt][3] * inv); *(u32x2*)(op + 16 * dt) = w2; }
}
__device__ __forceinline__ void local_bias(float (&sb)[8], const float* rpb, int dr, int kc0, int g, int cq, int cs) {
    asm volatile("" : "+v"(g));
#pragma unroll
    for (int e = 0; e < 8; ++e) { const int kc = kc0 + 8 * g + e; const bool vis = (kc >= cs) && (kc < cs + 16);
        const int idx = vis ? (kc - cq + 15) : 15; const float bv = rpb[dr * 31 + idx]; sb[e] = vis ? bv : -1e30f; }
}

__device__ __forceinline__ void attn_item(const Args& a, int l, int item, int lane) {
    unsigned char* ws = a.ws;
    const int q = lane & 15, g = lane >> 4;
    QSt sA, sB;
#pragma unroll
    for (int dt = 0; dt < 4; ++dt) { sA.o[dt] = (f32x4){0.f, 0.f, 0.f, 0.f}; sB.o[dt] = (f32x4){0.f, 0.f, 0.f, 0.f}; }
    sA.m = -1e30f; sA.lsum = 0.f; sB.m = -1e30f; sB.lsum = 0.f;
    float nb0[8];
    int tokq, h;
    if (item < 2048) {
        const int bb = item >> 8; h = (item >> 5) & 7; const int r = (item >> 1) & 15, p = item & 1;
        tokq = NCTXT + bb * 1024 + r * 64 + 32 * p + q;
        bf16x8 qA[2], qB[2];
        { const bf16_t* pp = (const bf16_t*)(ws + O_QP) + (size_t)tokq * 512 + h * 64 + 8 * g; qA[0] = *(const bf16x8*)pp; qA[1] = *(const bf16x8*)(pp + 32); qB[0] = *(const bf16x8*)(pp + 16 * 512); qB[1] = *(const bf16x8*)(pp + 16 * 512 + 32); }
        const bf16_t* ck = (const bf16_t*)(ws + O_CK) + (((size_t)bb * 2 + l) * 8 + h) * 512 * 64;
        const bf16_t* cv = (const bf16_t*)(ws + O_VTC) + (((size_t)bb * 2 + l) * 8 + h) * 64 * 512;
        int rs = r - 4; if (rs < 0) rs = 0; if (rs > 8) rs = 8;
        const int cqA = 32 * p + q, cqB = cqA + 16; int csA = cqA - 8; if (csA < 0) csA = 0; if (csA > 48) csA = 48; int csB = cqB - 8; if (csB < 0) csB = 0; if (csB > 48) csB = 48;
        const float* rpb = a.in[I_RPB] + (size_t)(l * 8 + h) * 15 * 31;
        const bf16_t* kl = (const bf16_t*)(ws + O_KB) + (size_t)(NCTXT + bb * 1024) * 512 + h * 64;
        const bf16_t* vl = (const bf16_t*)(ws + O_VT) + (size_t)16 * 512 * 256 + ((size_t)bb * 512 + h * 64) * 1024;
        KVF f0, f1; KVOff oc = kv_off(64, 512, lane);
#pragma unroll 1
        for (int kb = 0; kb < 16; kb += 2) {
            kv_load(f0, ck + (size_t)kb * 32 * 64, cv + kb * 32, oc);
            kv_load(f1, ck + (size_t)(kb + 1) * 32 * 64, cv + (kb + 1) * 32, oc);
            attn_step2(f0, f1, qA, sA); attn_step2(f0, f1, qB, sB);
        }
        { const bf16_t* p2 = (const bf16_t*)(ws + O_QR) + (size_t)(tokq - NCTXT) * 512 + h * 64 + 8 * g; qA[0] = *(const bf16x8*)p2; qA[1] = *(const bf16x8*)(p2 + 32); qB[0] = *(const bf16x8*)(p2 + 16 * 512); qB[1] = *(const bf16x8*)(p2 + 16 * 512 + 32); }
        oc = kv_off(512, 1024, lane);
        const int kcA = (32 * p - 8) < 0 ? 0 : (32 * p - 8), kcB = (32 * p + 8) > 32 ? 32 : (32 * p + 8);
#pragma unroll 1
        for (int wi = 0; wi < 8; ++wi) {
            const int dr = rs + wi - r + 7; const int key0 = (rs + wi) * 64;
            kv_load(f0, kl + (size_t)(key0 + kcA) * 512, vl + key0 + kcA, oc);
            kv_load(f1, kl + (size_t)(key0 + kcB) * 512, vl + key0 + kcB, oc);
            local_bias(nb0, rpb, dr, kcA, g, cqA, csA); attn_step(f0, qA, nb0, true, sA);
            local_bias(nb0, rpb, dr, kcB, g, cqB, csB); attn_step(f1, qB, nb0, true, sB);
        }
    } else {
        const int it = item - 2048; const int bb = it >> 6; h = (it >> 3) & 7; const int qb = it & 7;
        tokq = bb * 256 + qb * 32 + q;
        bf16x8 qpA[2], qpB[2];
        { const bf16_t* pp = (const bf16_t*)(ws + O_QP) + (size_t)tokq * 512 + h * 64 + 8 * g; qpA[0] = *(const bf16x8*)pp; qpA[1] = *(const bf16x8*)(pp + 32); qpB[0] = *(const bf16x8*)(pp + 16 * 512); qpB[1] = *(const bf16x8*)(pp + 16 * 512 + 32); }
        const bf16_t* kl = (const bf16_t*)(ws + O_KB) + (size_t)(bb * 256) * 512 + h * 64;
        const bf16_t* vl = (const bf16_t*)(ws + O_VT) + ((size_t)bb * 512 + h * 64) * 256;
        KVF f0, f1; const KVOff oc = kv_off(512, 256, lane);
#pragma unroll 1
        for (int kb = 0; kb < 8; kb += 2) {
            kv_load(f0, kl + (size_t)kb * 32 * 512, vl + kb * 32, oc);
            kv_load(f1, kl + (size_t)(kb + 1) * 32 * 512, vl + (kb + 1) * 32, oc);
            attn_step2(f0, f1, qpA, sA); attn_step2(f0, f1, qpB, sB);
        }
    }
    bf16_t* op = (bf16_t*)(ws + O_BR) + (size_t)tokq * 2048 + h * 64 + 4 * g;
    attn_store(sA, op); attn_store(sB, op + (size_t)16 * 2048);
}

__device__ __forceinline__ void gmlp_item(const Args& a, int l, int item, int lane) {
    unsigned char* ws = a.ws;
    const int tt = item >> 4, gg = (item >> 2) & 3, pb = item & 3;
    const int i = lane & 15, g = lane >> 4;
    const bf16_t* A = (const bf16_t*)(ws + O_VNT) + ((size_t)tt * 512 + gg * 128) * 128;
    const bf16_t* B = (const bf16_t*)(ws + O_WSB) + ((size_t)(l * 4 + gg) * 128 + pb * 32) * 128;
    f32x4 acc[8][2];
#pragma unroll
    for (int mi = 0; mi < 8; ++mi) { acc[mi][0] = (f32x4){0.f, 0.f, 0.f, 0.f}; acc[mi][1] = (f32x4){0.f, 0.f, 0.f, 0.f}; }
#pragma unroll
    for (int ks = 0; ks < 4; ++ks) {
        const bf16x8 b0 = *(const bf16x8*)(B + (size_t)i * 128 + 32 * ks + 8 * g), b1 = *(const bf16x8*)(B + (size_t)(16 + i) * 128 + 32 * ks + 8 * g);
#pragma unroll
        for (int mi = 0; mi < 8; ++mi) { const bf16x8 af = *(const bf16x8*)(A + (size_t)(16 * mi + i) * 128 + 32 * ks + 8 * g);
            acc[mi][0] = MFMA16(af, b0, acc[mi][0]); acc[mi][1] = MFMA16(af, b1, acc[mi][1]); }
    }
    const bf16_t* Zm = (const bf16_t*)(ws + O_ZM);
#pragma unroll
    for (int nj = 0; nj < 2; ++nj) { const int p = pb * 32 + 16 * nj + i; const int tok = tt * 128 + p; const float bs = a.in[I_BSP][(l * 4 + gg) * 128 + p];
        u32x2 uw[8];
#pragma unroll
        for (int mi = 0; mi < 8; ++mi) uw[mi] = *(const u32x2*)(Zm + (size_t)tok * 4096 + 1536 + gg * 128 + 16 * mi + 4 * g);
#pragma unroll
        for (int mi = 0; mi < 8; ++mi) { const int c = gg * 128 + 16 * mi + 4 * g; const f32x4 v = acc[mi][nj];
            u32x2 ow; ow.x = cvt_pk_bf16(bflo(uw[mi].x) * (v[0] + bs), bfhi(uw[mi].x) * (v[1] + bs)); ow.y = cvt_pk_bf16(bflo(uw[mi].y) * (v[2] + bs), bfhi(uw[mi].y) * (v[3] + bs));
            *(u32x2*)((bf16_t*)(ws + O_BR) + (size_t)tok * 2048 + 512 + c) = ow; } }
}

#define XB_TMO      128
#define XB_XCNT(j)  (256  + 64 * (j))
#define XB_XSUB(j)  (1280 + 64 * (j))
#define XB_XGEN(j)  (2304 + 64 * (j))
#define XB_TOP      3328
#define XB_TOPGEN   3392
#define XCD_BAR_WORDS 3456
#define XB_SPIN_CAP (1u << 22)
constexpr int CW_BAR = 4096, CW_FLAG = 8192;
__device__ __forceinline__ unsigned xb_ld(unsigned* p)              { return __hip_atomic_load(p, __ATOMIC_RELAXED, __HIP_MEMORY_SCOPE_AGENT); }
__device__ __forceinline__ unsigned xb_add(unsigned* p, unsigned v) { return __hip_atomic_fetch_add(p, v, __ATOMIC_RELAXED, __HIP_MEMORY_SCOPE_AGENT); }
__device__ __forceinline__ unsigned xb_xcc_id() { return (unsigned)__builtin_amdgcn_s_getreg((3 << 11) | 20) & 0xFu; }
#define XB_SPIN(cond, bar) do { unsigned _sp = 0; while (cond) { __builtin_amdgcn_s_sleep(1); \
    if ((++_sp & 255u) == 0u) { if (xb_ld(&(bar)[XB_TMO])) break; if (_sp > XB_SPIN_CAP) { atomicAdd(&(bar)[XB_TMO], 1u); break; } } } } while (0)
struct XcdBarrier { unsigned* bar; unsigned x; volatile LAS unsigned* st; };
__device__ __forceinline__ XcdBarrier xcd_barrier_post(unsigned* bar, volatile LAS unsigned* st) {
    XcdBarrier b; b.bar = bar; b.x = xb_xcc_id(); b.st = st;
    if (threadIdx.x == 0) (void)xb_add(&bar[XB_XCNT(b.x)], 1u);
    return b;
}
__device__ __forceinline__ void xcd_barrier_complete(unsigned* bar, unsigned x, unsigned& nloc, unsigned& nx) {
    const unsigned G = gridDim.x * gridDim.y * gridDim.z;
    unsigned sum, cnt, mine, sp = 0u;
    for (;;) {
        sum = 0u; cnt = 0u; mine = 0u;
#pragma unroll
        for (unsigned j = 0; j < 16; ++j) { const unsigned c = xb_ld(&bar[XB_XCNT(j)]); sum += c; cnt += (c > 0u) ? 1u : 0u; mine = (j == x) ? c : mine; }
        if (sum == G) break;
        __builtin_amdgcn_s_sleep(1);
        if ((++sp & 255u) == 0u) { if (xb_ld(&bar[XB_TMO])) break; if (sp > XB_SPIN_CAP) { atomicAdd(&bar[XB_TMO], 1u); break; } }
    }
    nloc = mine > 0u ? mine : 1u; nx = cnt > 0u ? cnt : 1u;
}
__device__ __forceinline__ void xcd_barrier(const XcdBarrier& b) {
    asm volatile("s_waitcnt vmcnt(0)" ::: "memory");
    __syncthreads();
    if (threadIdx.x == 0) {
        unsigned* bar = b.bar;
        __builtin_amdgcn_s_waitcnt(0);
        unsigned nloc = b.st[0], nx = b.st[1];
        if (nloc == 0u) { xcd_barrier_complete(bar, b.x, nloc, nx); b.st[0] = nloc; b.st[1] = nx; }
        const unsigned old = xb_add(&bar[XB_XSUB(b.x)], 1u);
        const unsigned gen = old / nloc;
        if (old + 1u == (gen + 1u) * nloc) {
            __builtin_amdgcn_fence(__ATOMIC_RELEASE, "agent");
            asm volatile("s_waitcnt vmcnt(0)" ::: "memory");
            const unsigned og = xb_add(&bar[XB_TOP], 1u);
            const unsigned tg = og / nx;
            if (og + 1u == (tg + 1u) * nx) xb_add(&bar[XB_TOPGEN], 1u);
            else XB_SPIN(xb_ld(&bar[XB_TOPGEN]) == tg, bar);
            __builtin_amdgcn_fence(__ATOMIC_ACQUIRE, "agent");
            xb_add(&bar[XB_XGEN(b.x)], 1u);
            asm volatile("s_waitcnt vmcnt(0)" ::: "memory");
        } else {
            XB_SPIN(xb_ld(&bar[XB_XGEN(b.x)]) == gen, bar);
            __builtin_amdgcn_fence(__ATOMIC_ACQUIRE, "agent");
            asm volatile("s_waitcnt vmcnt(0)" ::: "memory");
        }
    }
    __syncthreads();
}

__global__ void __launch_bounds__(512, 2) fwd(Args a) {
    extern __shared__ __attribute__((aligned(16))) unsigned char lds_raw[];
    LAS unsigned char* lds = (LAS unsigned char*)lds_raw;
    cg::grid_group grid = cg::this_grid();
    int tid0 = threadIdx.x; const int wave = __builtin_amdgcn_readfirstlane(tid0 >> 6), G = gridDim.x, bid = blockIdx.x;
#define OPQ int tid = tid0; asm volatile("" : "+v"(tid)); const int lane = tid & 63; (void)lane;
    unsigned char* ws = a.ws;
    const int lo = a.ph_lo, hi = a.ph_hi;
    int ph = 0;
#ifndef EN
#define EN 0xFFFF
#endif
#define RUN(k) ((k) >= lo && (k) < hi)
#define ENB(t) if constexpr ((EN >> (t)) & 1)
#ifndef DUP
#define DUP 0
#endif
#define REP(t) _Pragma("nounroll") for (int rep = 0; rep < ((((DUP) >> (t)) & 1) ? 2 : 1); ++rep)
#define REPSYNC(t) do { if (((((DUP) >> (t)) & 1)) && rep == 0) xcd_barrier(xbar); } while (0)
#define SEAM(k) do { if ((k) + 1 < hi) xcd_barrier(xbar); } while (0)

    const bool ksplit = (G == 256) && (hi - lo > 1);
    XcdBarrier xbar; xbar.bar = (unsigned*)(ws + O_CTL) + CW_BAR; xbar.x = 0; xbar.st = (volatile LAS unsigned*)(lds + 131072 + 64);
    if (hi - lo > 1) {
        if (tid0 < 2) xbar.st[tid0] = 0u;
        if (bid == 0) { for (int i = tid0; i < XCD_BAR_WORDS; i += 512) xbar.bar[i] = 0u; if (tid0 < 16) ((unsigned*)(ws + O_CTL))[64 * tid0] = 0u; if (tid0 < 32) ((unsigned*)(ws + O_CTL))[1024 + 64 * tid0] = 0u;
            for (int i = tid0; i < 12288; i += 512) ((unsigned*)(ws + O_CTL))[CW_FLAG + i] = 0u; }
        grid.sync();
        xbar = xcd_barrier_post(xbar.bar, xbar.st);
    }
    if (RUN(0)) { REP(0) { ENB(0) { OPQ phase_p0(a, lds, tid, lane, wave, G, bid); } REPSYNC(0); } SEAM(0); }
    if (RUN(1)) { ENB(1) {
#pragma nounroll
        for (int pass = 0; pass < 2; ++pass) {
            pg8::SchedFold S{(const char*)(ws + (pass ? O_WBD : O_CS)), (const char*)(ws + (pass ? O_BDP : O_WFN)), pass, pass ? bid - 64 : bid};
            pg8::EpiStore E{(bf16_t*)(ws + (pass ? O_WBT : O_WINT)), 2048};
            pg8::gemm_phase(lds, pass ? 512 : 256, pass ? 512 : 128, pass ? 512 : 256, S, E); }
        { OPQ phase_p1_modreduce(a, tid, G, bid); } }
        SEAM(1);
    }
    for (int l = 0; l < 2; ++l) {
        const int p0 = 2 + 9 * l;
        const float* mod_l = (const float*)(ws + O_MOD) + (size_t)l * NCOND * 6 * 2048;
        if (RUN(p0 + 0)) {
#ifdef EXP_NANFILL
            { OPQ for (int i = bid * 512 + tid; i < 12288 * 1024; i += G * 512) ((u32x4*)(ws + O_ZG))[i] = (u32x4){0x7fc07fc0u, 0x7fc07fc0u, 0x7fc07fc0u, 0x7fc07fc0u}; }
#endif
            REP(2) { ENB(2) { OPQ phase_norm(a, l, 0, l == 0, lane, wave, G, bid); } REPSYNC(2); } SEAM(p0 + 0); }
        if (RUN(p0 + 1)) { REP(3) { ENB(3) {
            pg8::SchedMN S{(const char*)(ws + O_H), (const char*)(ws + O_WINT) + (size_t)l * 12288 * 2048 * 2, 2048, 2048, 48, 48, G, bid, 0, 48 * 48, 0, 0, 0, 0};
            pg8::EpiZ E{(bf16_t*)(ws + O_ZM), (bf16_t*)(ws + O_ZG), a.in[I_BGATE] + (size_t)l * 8192};
            pg8::gemm_phase(lds, 2048, 2048, 2048, S, E); } REPSYNC(3); }
            SEAM(p0 + 1);
        }
        if (RUN(p0 + 2)) { REP(4) { ENB(4) { OPQ phase_prep(a, l, lds, tid, lane, wave, G, bid); } REPSYNC(4); } SEAM(p0 + 2); }
        if (RUN(p0 + 3)) { REP(5) { ENB(5) {
#pragma nounroll
            for (int pass = 0; pass < 2; ++pass) { const int lat = 1 - pass, Kd = lat ? 2048 : 512;
              pg8::SchedDFT S{(const char*)(ws + (lat ? O_DFT1024 : O_DFT256)), (const char*)(ws + O_TT) + (lat ? (size_t)16 * 512 * 512 * 2 : 0), lat, lat ? bid : bid - 64}; pg8::EpiStore E{(bf16_t*)(ws + O_BR), 2048};
              pg8::gemm_phase(lds, Kd, Kd, Kd, S, E); }
            } ENB(10) { OPQ
            unsigned* cbase = (unsigned*)(ws + O_CTL) + 1024 + (l + 2 * rep) * 8 * 64;
            const int myx = (int)(xb_xcc_id() & 7u);
            constexpr int CPX = (3072 + 1536) / 8;
#pragma unroll 1
            for (int k = 0; k < 8; ++k) {
                const int x = (myx + k) & 7; unsigned* ctr = cbase + x * 64;
                for (;;) {
                    int c = CPX;
                    if (lane == 0) { if (__hip_atomic_load(ctr, __ATOMIC_RELAXED, __HIP_MEMORY_SCOPE_AGENT) < (unsigned)CPX) c = (int)atomicAdd(ctr, 1u); }
                    c = __builtin_amdgcn_readfirstlane(c);
                    if (c >= CPX) break;
                    const int idx = c * 8 + x;
                    if (idx < 3072) attn_item(a, l, idx, lane); else gmlp_item(a, l, idx - 3072, lane);
                }
            } } REPSYNC(5); }
            SEAM(p0 + 3);
        }
        if (RUN(p0 + 4)) { REP(6) { ENB(6) {
            const int nps = ksplit ? 2 : 1;
#pragma nounroll
            for (int pass = 0; pass < nps; ++pass) {
                pg8::SchedMN S{(const char*)(ws + O_BR), (const char*)(ws + O_WBT) + (size_t)l * DM * DM * 2, 2048, 2048, 48, 8, G, bid, 0, ksplit ? 256 : 384, pass, 256, 128, 1024 * 2};
                pg8::EpiBR E{(const bf16_t*)(ws + O_ZG), (bf16_t*)(ws + O_H), (float*)(ws + O_ZM), (unsigned*)(ws + O_CTL) + CW_FLAG + (4 + l) * 128 * 16};
                pg8::gemm_phase(lds, 2048, 2048, pass ? 1024 : 2048, S, E); } } REPSYNC(6); }
            SEAM(p0 + 4);
        }
        if (RUN(p0 + 5)) { ENB(7) {
            const int nps = ksplit ? 2 : 1;
#pragma nounroll
            for (int pass = 0; pass < nps; ++pass) {
                pg8::SchedMN S{(const char*)(ws + O_H), (const char*)(ws + O_WOT) + (size_t)l * DM * DM * 2, 2048, 2048, 48, 8, G, bid, 0, ksplit ? 256 : 384, pass, 256, 128, 1024 * 2};
                pg8::EpiRes E{l == 0 ? a.in[I_XP] : a.out, l == 0 ? a.in[I_XS] : a.out + (size_t)NCTXT * DM, a.out, mod_l, 2, (float*)(ws + O_ZM), (unsigned*)(ws + O_CTL) + CW_FLAG + (l * 2 + 0) * 128 * 16};
                pg8::gemm_phase(lds, 2048, 2048, pass ? 1024 : 2048, S, E); } }
            SEAM(p0 + 5);
        }
        if (RUN(p0 + 6)) { ENB(2) { OPQ phase_norm(a, l, 3, false, lane, wave, G, bid); } SEAM(p0 + 6); }
        if (RUN(p0 + 7)) { REP(8) { ENB(8) {
            pg8::SchedMN S{(const char*)(ws + O_H), (const char*)(ws + O_W1T) + (size_t)l * DFF * DM * 2, 2048, 2048, 48, 32, G, bid, 0, 48 * 32, 0, 0, 0, 0};
            pg8::EpiHid E{(bf16_t*)(ws + O_ZG)};
            pg8::gemm_phase(lds, 2048, 2048, 2048, S, E); } REPSYNC(8); }
            SEAM(p0 + 7);
        }
        if (RUN(p0 + 8)) { ENB(9) {
            const int nps = ksplit ? 2 : 1;
#pragma nounroll
            for (int pass = 0; pass < nps; ++pass) {
                pg8::SchedMN S{(const char*)(ws + O_ZG), (const char*)(ws + O_W2T) + (size_t)l * DM * DFF * 2, 8192, 8192, 48, 8, G, bid, 0, ksplit ? 256 : 384, pass, 256, 128, 4096 * 2};
                pg8::EpiRes E{a.out, a.out + (size_t)NCTXT * DM, a.out, mod_l, 5, (float*)(ws + O_ZM), (unsigned*)(ws + O_CTL) + CW_FLAG + (l * 2 + 1) * 128 * 16};
                pg8::gemm_phase(lds, 8192, 8192, pass ? 4096 : 8192, S, E); } }
            SEAM(p0 + 8);
        }
    }
    (void)ph;
}

extern "C" void kernel_launch(void* const* d_in, const int* in_sizes, int n_in, void* d_out, int out_size, void* d_ws, size_t ws_size, hipStream_t stream) {
    static int grid = 0;
    if (grid == 0) {
        if (n_in != 24 || ws_size < WS_NEED) { fprintf(stderr, "kernel_launch: need 24 inputs and %zu B of workspace (got %d, %zu)\n", (size_t)WS_NEED, n_in, ws_size); grid = -1; return; }
        int dev = 0, cus = 0, per_cu = 0;
        hipGetDevice(&dev); hipDeviceGetAttribute(&cus, hipDeviceAttributeMultiprocessorCount, dev);
        if (hipFuncSetAttribute((const void*)fwd, hipFuncAttributeMaxDynamicSharedMemorySize, LDS_BYTES) != hipSuccess) { fprintf(stderr, "kernel_launch: hipFuncSetAttribute failed\n"); grid = -1; return; }
        if (hipOccupancyMaxActiveBlocksPerMultiprocessor(&per_cu, (const void*)fwd, 512, LDS_BYTES) != hipSuccess || per_cu < 1) { fprintf(stderr, "kernel_launch: occupancy query says %d\n", per_cu); per_cu = 1; }
        (void)hipGetLastError();
        grid = cus;
    }
    if (grid < 0) return;
    Args a{};
    for (int i = 0; i < 24; ++i) a.in[i] = (const float*)d_in[i];
    a.out = (float*)d_out; a.ws = (unsigned char*)d_ws;
#if N_LAUNCH_MODE == 1
    a.ph_lo = 0; a.ph_hi = NPHASE;
    void* args[] = {&a};
    hipError_t e = hipLaunchCooperativeKernel((const void*)fwd, dim3(grid), dim3(512), args, LDS_BYTES, stream);
    if (e != hipSuccess) fprintf(stderr, "kernel_launch: cooperative launch failed: %s (grid %d)\n", hipGetErrorString(e), grid);
#else
    for (int p = 0; p < NPHASE; ++p) { a.ph_lo = p; a.ph_hi = p + 1; hipLaunchKernelGGL(fwd, dim3(grid), dim3(512), LDS_BYTES, stream, a); }
#endif
}
```

```cpp
#include <hip/hip_runtime.h>
#include <hip/hip_cooperative_groups.h>
#include <cstdio>
#include <cstdint>
namespace cg = cooperative_groups;


#ifndef N_LAUNCH_MODE
#define N_LAUNCH_MODE 1
#endif

#define LAS __attribute__((address_space(3)))
typedef unsigned short bf16_t;
typedef short bf16x8 __attribute__((ext_vector_type(8)));
typedef float f32x4 __attribute__((ext_vector_type(4)));
typedef float f32x2 __attribute__((ext_vector_type(2)));
typedef unsigned u32x4 __attribute__((ext_vector_type(4)));
typedef unsigned u32x2 __attribute__((ext_vector_type(2)));

constexpr int DM = 2048, NTOK = 12288, NCTXT = 4096, DFF = 8192, INC = 11776;
constexpr int NCOND = 9;
constexpr size_t MiB = 1u << 20;
constexpr size_t O_CTL = 0, O_WINT = 1 * MiB, O_WBT = 97 * MiB, O_WOT = 113 * MiB, O_W1T = 129 * MiB, O_W2T = 193 * MiB,
                 O_WFN = 257 * MiB, O_WBD = 261 * MiB, O_BDP = 265 * MiB, O_CS = 266 * MiB, O_DFT256 = 267 * MiB, O_DFT1024 = 268 * MiB,
                 O_WSB = 272 * MiB, O_MODP = 273 * MiB, O_MOD = 287 * MiB, O_CK = 288 * MiB, O_VTC = 296 * MiB, O_H = 304 * MiB,
                 O_ZM = 352 * MiB, O_ZG = 448 * MiB, O_QP = 640 * MiB, O_QR = 652 * MiB, O_KB = 660 * MiB, O_VT = 672 * MiB,
                 O_VNT = 684 * MiB, O_TT = 696 * MiB, O_BR = 720 * MiB, WS_NEED = 768 * MiB;
constexpr size_t OUTK = (size_t)NTOK * DM, OUTV = OUTK + (size_t)16 * 2 * 8 * 256 * 64;
constexpr int LDS_BYTES = 147456;
constexpr int NPHASE = 2 + 9 * 2;

struct Args { const float* in[24]; float* out; unsigned char* ws; int ph_lo, ph_hi; };
enum { I_XP = 0, I_XS, I_CK, I_CV, I_C, I_CCTX, I_N1G, I_WIN, I_BGATE, I_QNG, I_KNG, I_RPB, I_GNG, I_WSP, I_BSP, I_WPOOL, I_PSC, I_WBR, I_WOUT, I_N2G, I_W1, I_W2, I_WADA, I_BADA };

typedef __bf16 bf16x2_t __attribute__((ext_vector_type(2)));
__device__ __forceinline__ unsigned cvt_pk_bf16(float lo, float hi) { const f32x2 v = {lo, hi}; const bf16x2_t b = __builtin_convertvector(v, bf16x2_t); return __builtin_bit_cast(unsigned, b); }
__device__ __forceinline__ float bf2f(unsigned short u) { return __uint_as_float(((unsigned)u) << 16); }
__device__ __forceinline__ float bflo(unsigned u) { return __uint_as_float(u << 16); }
__device__ __forceinline__ float bfhi(unsigned u) { return __uint_as_float(u & 0xffff0000u); }
__device__ __forceinline__ bf16_t f2bf(float f) { return (bf16_t)(cvt_pk_bf16(f, 0.f) & 0xffffu); }
__device__ __forceinline__ float wave_sum(float v) {
#pragma unroll
    for (int o = 1; o < 64; o <<= 1) v += __shfl_xor(v, o);
    return v;
}
__device__ __forceinline__ float fast_exp(float x) { return __builtin_amdgcn_exp2f(x * 1.44269504089f); }
__device__ __forceinline__ float sigmoidf_(float x) { return __builtin_amdgcn_rcpf(1.0f + fast_exp(-x)); }
__device__ __forceinline__ float gelu_tanh(float x) { const float u = 0.7978845608f * (x + 0.044715f * x * x * x); return x * sigmoidf_(2.0f * u); }
#define LDS_WAIT() asm volatile("s_waitcnt lgkmcnt(0)" ::: "memory")
#define VM_WAIT() asm volatile("s_waitcnt vmcnt(0)" ::: "memory")

namespace pg8 {
constexpr int BM = 256, BK = 64, HALF = 128, HTB = HALF * BK * 2, STAGE_BYTES = 8 * HTB;
__device__ __forceinline__ int lds_byte(int r, int c) { const int st = (r >> 4) * 2 + (c >> 5), rr = r & 15, cc = c & 31, ob = rr * 64 + cc * 2; return st * 1024 + (ob ^ (((ob >> 9) & 1) << 5)); }
__device__ __forceinline__ void stage_rc(int b, int& R, int& C) { const int st = b / 1024, sb = b % 1024, swz = sb ^ (((sb >> 9) & 1) << 5); R = (st >> 1) * 16 + swz / 64; C = (st & 1) * 32 + (swz % 64) / 2; }
__device__ __forceinline__ int perm32(int rho) { const int n = rho >> 4, i = rho & 15; return 8 * (i >> 2) + 4 * n + (i & 3); }

struct Unit { const char* A; const char* B; long hA; int orow0, orow1, ocol, aux; };
__device__ __forceinline__ void tile_map(int L, int nM, int nN, int& pm, int& pn) {
    const int nwg = nM * nN; int wgid = L;
    { const int q = nwg / 8, r = nwg % 8, xcd = wgid % 8, off = wgid / 8; wgid = (xcd < r ? xcd * (q + 1) : r * (q + 1) + (xcd - r) * q) + off; }
    const int nig = 8 * nN, gid = wgid / nig, fm = gid * 8, gsz = (nM - fm) < 8 ? (nM - fm) : 8;
    pm = fm + ((wgid % nig) % gsz); pn = (wgid % nig) / gsz;
}
template <class Epi, class Sched>
__device__ __forceinline__ void gemm_phase(LAS unsigned char* lds, const int lda, const int ldb, const int K, const Sched& S, const Epi& E) {
    int tid = threadIdx.x; asm volatile("" : "+v"(tid));
    const int wid = __builtin_amdgcn_readfirstlane(tid >> 6), lane = tid & 63, wr = wid >> 2, wc = wid & 3, fr = lane & 15, fq = lane >> 4;
    const int nt = K / BK;
    unsigned voffA[2], voffB[2];
#pragma unroll
    for (int i = 0; i < 2; ++i) { int R, C; stage_rc(tid * 16 + i * 8192, R, C); const int Rb = (R & ~31) + perm32(R & 31);
        voffA[i] = (unsigned)(R * lda + C) * 2u; voffB[i] = (unsigned)(Rb * ldb + C) * 2u; }
    const size_t kstep = (size_t)(BK * 2);
    const size_t hstepB = (size_t)HALF * ldb * 2;
    const unsigned ldsw = (unsigned)wid * 1024u;
    const int aoff = lds_byte(wr * 64 + fr, fq * 8), boff = lds_byte(wc * 32 + fr, fq * 8);
#define PG8_SA(b, h) (((b) * 2 + (h)) * HTB)
#define PG8_SB(b, h) ((4 + (b) * 2 + (h)) * HTB)
#define PG8_STAGE(bufoff, gbase, voff) do { _Pragma("unroll") for (int _i = 0; _i < 2; ++_i) \
        __builtin_amdgcn_global_load_lds((const unsigned*)((const char*)(gbase) + (voff)[_i]), (LAS unsigned*)(lds + (bufoff) + ldsw + _i * 8192), 16, 0, 0); } while (0)
#define PG8_LDA(dst, b, h) do { _Pragma("unroll") for (int m = 0; m < 4; ++m) _Pragma("unroll") for (int k = 0; k < 2; ++k) dst[m][k] = *(const LAS bf16x8*)(lds + PG8_SA(b, h) + aoff + m * 2048 + k * 1024); } while (0)
#define PG8_LDB(dst, b, h) do { _Pragma("unroll") for (int n = 0; n < 2; ++n) _Pragma("unroll") for (int k = 0; k < 2; ++k) dst[n][k] = *(const LAS bf16x8*)(lds + PG8_SB(b, h) + boff + n * 2048 + k * 1024); } while (0)
#define PG8_MMA(ai, bj, At, Bt) do { __builtin_amdgcn_s_setprio(1); _Pragma("unroll") for (int m = 0; m < 4; ++m) _Pragma("unroll") for (int n = 0; n < 2; ++n) _Pragma("unroll") for (int k = 0; k < 2; ++k) \
        acc[ai][bj][m][n] = __builtin_amdgcn_mfma_f32_16x16x32_bf16(Bt[n][k], At[m][k], acc[ai][bj][m][n], 0, 0, 0); __builtin_amdgcn_s_setprio(0); } while (0)
#define PG8_WAIT_V(n) asm volatile("s_waitcnt vmcnt(" #n ")" ::: "memory")
#define PG8_WAIT_L(n) asm volatile("s_waitcnt lgkmcnt(" #n ")" ::: "memory")
#define PG8_BAR __builtin_amdgcn_s_barrier()
#define PG8_SCHED __builtin_amdgcn_sched_barrier(0)
    Unit cur, nxt; int ui = 0;
    if (!S.next(0, cur)) return;
    f32x4 acc[2][2][4][2];
#pragma unroll
    for (int a = 0; a < 2; ++a)
#pragma unroll
        for (int b = 0; b < 2; ++b)
#pragma unroll
            for (int m = 0; m < 4; ++m)
#pragma unroll
                for (int n = 0; n < 2; ++n) acc[a][b][m][n] = (f32x4){0.f, 0.f, 0.f, 0.f};
    bf16x8 At[4][2], B0[2][2], B1[2][2];
    const char* cA = cur.A; const char* cB = cur.B; long chA = cur.hA;
    PG8_STAGE(PG8_SB(0, 0), cB, voffB); PG8_STAGE(PG8_SB(0, 1), cB + hstepB, voffB); PG8_STAGE(PG8_SA(0, 0), cA, voffA); PG8_STAGE(PG8_SA(0, 1), cA + chA, voffA);
    if (wr == 1) PG8_BAR;
    PG8_WAIT_V(2); PG8_BAR;
    PG8_STAGE(PG8_SB(1, 0), cB + kstep, voffB); PG8_STAGE(PG8_SA(1, 0), cA + kstep, voffA); PG8_STAGE(PG8_SB(1, 1), cB + hstepB + kstep, voffB);
    PG8_WAIT_V(6); PG8_BAR;
    for (;;) {
        const bool has_next = S.next(ui + 1, nxt);
        const char* nA = has_next ? nxt.A : cA; const char* nB = has_next ? nxt.B : cB; const long nhA = has_next ? nxt.hA : chA;
        for (int t = 0; t < nt; t += 2) {
            const bool last = (t == nt - 2);
            const char* a1 = cA + (size_t)(t + 1) * kstep;
            const char* a2 = last ? nA : cA + (size_t)(t + 2) * kstep; const char* b2 = last ? nB : cB + (size_t)(t + 2) * kstep;
            const char* a3 = a2 + kstep; const char* b3 = b2 + kstep; const long h2 = last ? nhA : chA;
            PG8_LDB(B0, 0, 0); PG8_LDB(B1, 0, 1); PG8_SCHED; PG8_LDA(At, 0, 0); PG8_STAGE(PG8_SA(1, 1), a1 + chA, voffA);
            PG8_WAIT_V(8); PG8_WAIT_L(0); PG8_BAR; PG8_MMA(0, 0, At, B0); PG8_MMA(0, 1, At, B1); PG8_BAR; PG8_SCHED;
            PG8_LDA(At, 0, 1); PG8_STAGE(PG8_SB(0, 0), b2, voffB); PG8_STAGE(PG8_SB(0, 1), b2 + hstepB, voffB); PG8_STAGE(PG8_SA(0, 0), a2, voffA);
            PG8_WAIT_V(8); PG8_WAIT_L(0); PG8_BAR; PG8_MMA(1, 0, At, B0); PG8_MMA(1, 1, At, B1); PG8_BAR; PG8_SCHED;
            PG8_LDB(B0, 1, 0); PG8_LDB(B1, 1, 1); PG8_SCHED; PG8_LDA(At, 1, 0); PG8_STAGE(PG8_SA(0, 1), a2 + h2, voffA);
            PG8_WAIT_V(8); PG8_WAIT_L(0); PG8_BAR; PG8_MMA(0, 0, At, B0); PG8_MMA(0, 1, At, B1); PG8_BAR; PG8_SCHED;
            PG8_LDA(At, 1, 1); PG8_STAGE(PG8_SB(1, 0), b3, voffB); PG8_STAGE(PG8_SB(1, 1), b3 + hstepB, voffB); PG8_STAGE(PG8_SA(1, 0), a3, voffA);
            PG8_WAIT_V(8); PG8_WAIT_L(0); PG8_BAR; PG8_MMA(1, 0, At, B0); PG8_MMA(1, 1, At, B1); PG8_BAR; PG8_SCHED;
            if constexpr (Epi::MID) { if (((t + 2) & 7) == 0 && t + 2 < nt) E.mid(acc, cur, (t + 2) >> 3, wr, wc, fr, fq); }
        }
        if (wr == 0) PG8_BAR;
        E(acc, cur, wr, wc, fr, fq);
        if (!has_next) break;
#pragma unroll
        for (int a = 0; a < 2; ++a)
#pragma unroll
            for (int b = 0; b < 2; ++b)
#pragma unroll
                for (int m = 0; m < 4; ++m)
#pragma unroll
                    for (int n = 0; n < 2; ++n) acc[a][b][m][n] = (f32x4){0.f, 0.f, 0.f, 0.f};
        cur = nxt; cA = nA; cB = nB; chA = nhA; ++ui;
        if (wr == 1) PG8_BAR;
    }
    PG8_WAIT_V(0);
    PG8_BAR;
#undef PG8_SA
#undef PG8_SB
#undef PG8_STAGE
#undef PG8_LDA
#undef PG8_LDB
#undef PG8_MMA
#undef PG8_WAIT_V
#undef PG8_WAIT_L
#undef PG8_BAR
#undef PG8_SCHED
}

struct SchedMN {
    const char* A; const char* B; int lda, ldb, nM, nN, G, c, ocol_off, lim, split, L0, nsplit, khalf_bytes;
    __device__ __forceinline__ bool next(int i, Unit& u) const {
        int L, kh = 0, aux = 0;
        if (!split) { L = i * G + c; if (c < 0 || L >= lim) return false; }
        else { if (i > 0 || c >= 2 * nsplit) return false; const int j = c >> 1; kh = c & 1; L = L0 + j; aux = (j << 2) | 2 | kh; }
        int pm, pn; tile_map(L, nM, nN, pm, pn);
        const long h = (long)128 * lda * 2;
        u.A = A + (size_t)pm * 256 * lda * 2 + (size_t)kh * khalf_bytes + (kh ? h : 0); u.B = B + (size_t)pn * 256 * ldb * 2 + (size_t)kh * khalf_bytes;
        u.hA = kh ? -h : h;
        u.orow0 = pm * 256 + (kh ? 128 : 0); u.orow1 = pm * 256 + (kh ? 0 : 128); u.ocol = pn * 256 + ocol_off; u.aux = aux; return true;
    }
};
struct SchedBR {
    const char* A; const char* B; int G, c;
    __device__ __forceinline__ bool next(int i, Unit& u) const {
#ifdef EXP_B3
        const int L = i * G + c; if (L >= 48 * 8) return false;
        const int b = 3; int pm, pn; tile_map(L, 48, 8, pm, pn);
#else
        const int L = (i >> 2) * G + c; if (L >= 48 * 8) return false;
        const int b = i & 3; int pm, pn; tile_map(L, 48, 8, pm, pn);
#endif
        u.A = A + (size_t)pm * 256 * 2048 * 2 + b * 1024; u.B = B + (size_t)pn * 256 * 2048 * 2 + b * 1024; u.hA = (long)128 * 2048 * 2; u.orow0 = pm * 256; u.orow1 = pm * 256 + 128; u.ocol = pn * 256; u.aux = b; return true;
    }
};
struct SchedFold {
    const char* A0; const char* B0; int mode, c;
    __device__ __forceinline__ bool next(int i, Unit& u) const {
        if (i > 0 || c < 0) return false;
        if (mode == 0) { if (c >= 64) return false; const int l = c >> 5, g = (c >> 3) & 3, pn = c & 7;
            u.A = A0; u.hA = (long)128 * 256 * 2; u.B = B0 + ((size_t)(l * 4 + g) * 2048 + pn * 256) * 128 * 2; u.orow0 = l * 12288 + 2560 + g * 128; u.orow1 = l * 12288 + 3072 + g * 128; u.ocol = pn * 256; u.aux = g; }
        else { if (c >= 32) return false; const int l = c >> 4, pm = (c & 15) >> 1, pn = c & 1;
            u.A = A0 + ((size_t)l * 2048 + pm * 256) * 512 * 2; u.hA = (long)128 * 512 * 2; u.B = B0 + ((size_t)l * 512 + pn * 256) * 512 * 2; u.orow0 = l * 2048 + pm * 256; u.orow1 = u.orow0 + 128; u.ocol = 1536 + pn * 256; u.aux = 0; }
        return true;
    }
};
struct SchedDFT {
    const char* Amat; const char* TT; int latent, c;
    __device__ __forceinline__ bool next(int i, Unit& u) const {
        if (i > 0 || c < 0) return false;
        if (latent) { if (c >= 64) return false; const int bb = c >> 3, pm = (c & 7) >> 1, pn = c & 1;
            u.A = Amat + (size_t)pm * 256 * 2048 * 2; u.hA = (long)128 * 2048 * 2; u.B = TT + ((size_t)bb * 512 + pn * 256) * 2048 * 2; u.orow0 = NCTXT + bb * 1024 + pm * 256; u.orow1 = u.orow0 + 128; u.ocol = 1024 + pn * 256; }
        else { if (c >= 32) return false; const int bb = c >> 1, pn = c & 1;
            u.A = Amat; u.hA = (long)128 * 512 * 2; u.B = TT + ((size_t)bb * 512 + pn * 256) * 512 * 2; u.orow0 = bb * 256; u.orow1 = u.orow0 + 128; u.ocol = 1024 + pn * 256; }
        u.aux = 0; return true;
    }
};

__device__ __forceinline__ u32x4 pack8(const f32x4 v0, const f32x4 v1) { u32x4 w; w.x = cvt_pk_bf16(v0[0], v0[1]); w.y = cvt_pk_bf16(v0[2], v0[3]); w.z = cvt_pk_bf16(v1[0], v1[1]); w.w = cvt_pk_bf16(v1[2], v1[3]); return w; }
struct EpiStore {
    static constexpr bool MID = false;
    bf16_t* O; int ldc;
    __device__ __forceinline__ void operator()(const f32x4 (&acc)[2][2][4][2], const Unit& u, int wr, int wc, int fr, int fq) const {
        asm volatile("" : "+v"(fr), "+v"(fq));
#pragma unroll
        for (int ai = 0; ai < 2; ++ai)
#pragma unroll
            for (int m = 0; m < 4; ++m) { bf16_t* rowp = O + (size_t)((ai ? u.orow1 : u.orow0) + wr * 64 + m * 16 + fr) * ldc + u.ocol + wc * 32 + 8 * fq;
#pragma unroll
                for (int bj = 0; bj < 2; ++bj) *(u32x4*)(rowp + bj * 128) = pack8(acc[ai][bj][m][0], acc[ai][bj][m][1]); }
    }
};
struct EpiZ {
    static constexpr bool MID = false;
    bf16_t* Zm; bf16_t* Zg; const float* bgate;
    __device__ __forceinline__ void operator()(const f32x4 (&acc)[2][2][4][2], const Unit& u, int wr, int wc, int fr, int fq) const {
        asm volatile("" : "+v"(fr), "+v"(fq));
        const int pn = u.ocol >> 8; const int cb = wc * 32 + 8 * fq;
        if (pn >= 16) {
            const int col0 = u.ocol - 4096 + cb;
            f32x4 bv[2][2];
#pragma unroll
            for (int bj = 0; bj < 2; ++bj)
#pragma unroll
                for (int n = 0; n < 2; ++n) bv[bj][n] = *(const f32x4*)(bgate + col0 + bj * 128 + 4 * n);
#pragma unroll
            for (int ai = 0; ai < 2; ++ai)
#pragma unroll
                for (int m = 0; m < 4; ++m) { bf16_t* rowp = Zg + (size_t)((ai ? u.orow1 : u.orow0) + wr * 64 + m * 16 + fr) * 8192 + col0;
#pragma unroll
                    for (int bj = 0; bj < 2; ++bj) { f32x4 v0 = acc[ai][bj][m][0] + bv[bj][0], v1 = acc[ai][bj][m][1] + bv[bj][1];
#pragma unroll
                        for (int e = 0; e < 4; ++e) { v0[e] = sigmoidf_(v0[e]); v1[e] = sigmoidf_(v1[e]); }
                        *(u32x4*)(rowp + bj * 128) = pack8(v0, v1); } }
        } else {
            const bool gel = (pn >= 6 && pn < 10);
#pragma unroll
            for (int ai = 0; ai < 2; ++ai)
#pragma unroll
                for (int m = 0; m < 4; ++m) { bf16_t* rowp = Zm + (size_t)((ai ? u.orow1 : u.orow0) + wr * 64 + m * 16 + fr) * 4096 + u.ocol + cb;
#pragma unroll
                    for (int bj = 0; bj < 2; ++bj) { f32x4 v0 = acc[ai][bj][m][0], v1 = acc[ai][bj][m][1];
                        if (gel) {
#pragma unroll
                            for (int e = 0; e < 4; ++e) { v0[e] = gelu_tanh(v0[e]); v1[e] = gelu_tanh(v1[e]); } }
                        *(u32x4*)(rowp + bj * 128) = pack8(v0, v1); } }
        }
    }
};
struct EpiHid {
    static constexpr bool MID = false;
    bf16_t* O;
    __device__ __forceinline__ void operator()(const f32x4 (&acc)[2][2][4][2], const Unit& u, int wr, int wc, int fr, int fq) const {
        asm volatile("" : "+v"(fr), "+v"(fq));
#pragma unroll
        for (int ai = 0; ai < 2; ++ai)
#pragma unroll
            for (int m = 0; m < 4; ++m) { bf16_t* rowp = O + (size_t)((ai ? u.orow1 : u.orow0) + wr * 64 + m * 16 + fr) * DFF + u.ocol + wc * 32 + 8 * fq;
#pragma unroll
                for (int bj = 0; bj < 2; ++bj) { f32x4 v0 = acc[ai][bj][m][0], v1 = acc[ai][bj][m][1];
#pragma unroll
                    for (int e = 0; e < 4; ++e) { const float a = fmaxf(v0[e], 0.f), b = fmaxf(v1[e], 0.f); v0[e] = a * a; v1[e] = b * b; }
                    *(u32x4*)(rowp + bj * 128) = pack8(v0, v1); } }
    }
};
__device__ __forceinline__ void ho_send(const f32x4 (&acc)[2][2][4][2], unsigned long long* sb, unsigned* flag, int tidp) {
#pragma unroll
    for (int m = 0; m < 4; ++m)
#pragma unroll
        for (int bj = 0; bj < 2; ++bj)
#pragma unroll
            for (int n = 0; n < 2; ++n) { const f32x4 v = acc[1][bj][m][n]; unsigned long long* p = sb + (size_t)(((m * 2 + bj) * 2 + n) * 1024);
                __hip_atomic_store(p, ((unsigned long long)__float_as_uint(v[1]) << 32) | __float_as_uint(v[0]), __ATOMIC_RELAXED, __HIP_MEMORY_SCOPE_AGENT);
                __hip_atomic_store(p + 1, ((unsigned long long)__float_as_uint(v[3]) << 32) | __float_as_uint(v[2]), __ATOMIC_RELAXED, __HIP_MEMORY_SCOPE_AGENT); }
    asm volatile("s_waitcnt vmcnt(0)" ::: "memory");
    __syncthreads();
    if (tidp == 0) __hip_atomic_store(flag, 1u, __ATOMIC_RELEASE, __HIP_MEMORY_SCOPE_AGENT);
}
__device__ __forceinline__ void ho_wait(unsigned* flag, int tidp) {
    if (tidp == 0) { unsigned spin = 0; while (__hip_atomic_load(flag, __ATOMIC_ACQUIRE, __HIP_MEMORY_SCOPE_AGENT) == 0u) { __builtin_amdgcn_s_sleep(2); if (++spin > (1u << 24)) break; } }
    __syncthreads();
}
__device__ __forceinline__ f32x4 ho_get(unsigned long long* sb, int m, int bj, int n) {
    unsigned long long* p = sb + (size_t)(((m * 2 + bj) * 2 + n) * 1024);
    const unsigned long long a0 = __hip_atomic_load(p, __ATOMIC_RELAXED, __HIP_MEMORY_SCOPE_AGENT), a1 = __hip_atomic_load(p + 1, __ATOMIC_RELAXED, __HIP_MEMORY_SCOPE_AGENT);
    return (f32x4){__uint_as_float((unsigned)a0), __uint_as_float((unsigned)(a0 >> 32)), __uint_as_float((unsigned)a1), __uint_as_float((unsigned)(a1 >> 32))};
}
struct EpiRes {
    static constexpr bool MID = false;
    const float* xp; const float* xs; float* out; const float* mod; int gsel;
    float* S; unsigned* flags;
    __device__ __forceinline__ void operator()(const f32x4 (&acc)[2][2][4][2], const Unit& u, int wr, int wc, int fr, int fq) const {
        asm volatile("" : "+v"(fr), "+v"(fq));
        const int sp = u.aux & 2, jt = u.aux >> 2;
        const int tidp = (wr * 4 + wc) * 64 + fq * 16 + fr;
        const int kh = u.aux & 1;
        unsigned long long* sbs = (unsigned long long*)(S + (size_t)jt * 65536 + kh * 32768) + (size_t)tidp * 2;
        unsigned long long* sb = (unsigned long long*)(S + (size_t)jt * 65536 + (1 - kh) * 32768) + (size_t)tidp * 2;
        if (sp) { ho_send(acc, sbs, flags + jt * 16 + kh * 8, tidp); ho_wait(flags + jt * 16 + (1 - kh) * 8, tidp); }
        const int pm = u.orow0 >> 8; const int cond = pm < 16 ? 0 : 1 + ((pm - 16) >> 2);
        const int col0 = u.ocol + wc * 32 + 8 * fq;
        const float* gp = mod + ((size_t)cond * 6 + gsel) * 2048 + col0;
        f32x4 gv[2][2];
#pragma unroll
        for (int bj = 0; bj < 2; ++bj)
#pragma unroll
            for (int n = 0; n < 2; ++n) gv[bj][n] = *(const f32x4*)(gp + bj * 128 + 4 * n);
        const float* src = pm < 16 ? xp : xs - (size_t)NCTXT * DM;
#pragma unroll
        for (int ai = 0; ai < 2; ++ai) {
            if (ai == 1 && sp) break;
#pragma unroll
            for (int m = 0; m < 4; ++m) { const size_t off = (size_t)((ai ? u.orow1 : u.orow0) + wr * 64 + m * 16 + fr) * DM + col0;
#pragma unroll
                for (int bj = 0; bj < 2; ++bj)
#pragma unroll
                    for (int n = 0; n < 2; ++n) { const f32x4 xv = *(const f32x4*)(src + off + bj * 128 + 4 * n);
                        f32x4 v = acc[ai][bj][m][n];
                        if (ai == 0 && sp) v += ho_get(sb, m, bj, n);
                        *(f32x4*)(out + off + bj * 128 + 4 * n) = xv + gv[bj][n] * v; }
                if (m & 1) asm volatile("" ::: "memory"); } }
    }
};
struct EpiBR {
    static constexpr bool MID = true;
    const bf16_t* Zg; bf16_t* merged; float* S; unsigned* flags;
    __device__ __forceinline__ void scale(f32x4 (&acc)[2][2][4][2], const Unit& u, int b, bool ratio, int wr, int wc, int fr, int fq) const {
        const int col0 = u.ocol + wc * 32 + 8 * fq;
#pragma unroll
        for (int ai = 0; ai < 2; ++ai) {
            u32x4 gw[4][2], nw[4][2];
#pragma unroll
            for (int m = 0; m < 4; ++m)
#pragma unroll
                for (int bj = 0; bj < 2; ++bj) { const bf16_t* gp = Zg + (size_t)((ai ? u.orow1 : u.orow0) + wr * 64 + m * 16 + fr) * 8192 + b * 2048 + col0 + bj * 128;
                    gw[m][bj] = *(const u32x4*)gp; if (ratio) nw[m][bj] = *(const u32x4*)(gp + 2048); }
#pragma unroll
            for (int m = 0; m < 4; ++m)
#pragma unroll
                for (int bj = 0; bj < 2; ++bj) { const u32x4 g4 = gw[m][bj];
                    float g[8] = {bflo(g4.x), bfhi(g4.x), bflo(g4.y), bfhi(g4.y), bflo(g4.z), bfhi(g4.z), bflo(g4.w), bfhi(g4.w)};
#pragma unroll
                    for (int e = 0; e < 8; ++e) g[e] = fmaxf(g[e], 1e-6f);
                    if (ratio) { const u32x4 n4 = nw[m][bj];
                        const float gn[8] = {bflo(n4.x), bfhi(n4.x), bflo(n4.y), bfhi(n4.y), bflo(n4.z), bfhi(n4.z), bflo(n4.w), bfhi(n4.w)};
#pragma unroll
                        for (int e = 0; e < 8; ++e) g[e] *= __builtin_amdgcn_rcpf(fmaxf(gn[e], 1e-6f)); }
                    f32x4 v0 = acc[ai][bj][m][0], v1 = acc[ai][bj][m][1];
                    v0[0] *= g[0]; v0[1] *= g[1]; v0[2] *= g[2]; v0[3] *= g[3]; v1[0] *= g[4]; v1[1] *= g[5]; v1[2] *= g[6]; v1[3] *= g[7];
                    acc[ai][bj][m][0] = v0; acc[ai][bj][m][1] = v1; }
            asm volatile("" ::: "memory"); }
    }
    __device__ __forceinline__ void mid(f32x4 (&acc)[2][2][4][2], const Unit& u, int seg, int wr, int wc, int fr, int fq) const {
        asm volatile("" : "+v"(fr), "+v"(fq));
        const int base = (u.aux & 2) ? (u.aux & 1) * 2 : 0;
        scale(acc, u, base + seg - 1, true, wr, wc, fr, fq);
    }
    __device__ __forceinline__ void operator()(f32x4 (&acc)[2][2][4][2], const Unit& u, int wr, int wc, int fr, int fq) const {
        asm volatile("" : "+v"(fr), "+v"(fq));
        const int sp = u.aux & 2, kh = u.aux & 1, jt = u.aux >> 2;
        const int tidp = (wr * 4 + wc) * 64 + fq * 16 + fr;
        unsigned long long* sbs = (unsigned long long*)(S + (size_t)jt * 65536 + kh * 32768) + (size_t)tidp * 2;
        unsigned long long* sb = (unsigned long long*)(S + (size_t)jt * 65536 + (1 - kh) * 32768) + (size_t)tidp * 2;
        scale(acc, u, sp ? kh * 2 + 1 : 3, false, wr, wc, fr, fq);
        if (sp) { ho_send(acc, sbs, flags + jt * 16 + kh * 8, tidp); ho_wait(flags + jt * 16 + (1 - kh) * 8, tidp); }
        const int col0 = u.ocol + wc * 32 + 8 * fq;
#pragma unroll
        for (int ai = 0; ai < 2; ++ai) {
            if (ai == 1 && sp) break;
#pragma unroll
            for (int m = 0; m < 4; ++m) { const size_t row = (size_t)((ai ? u.orow1 : u.orow0) + wr * 64 + m * 16 + fr);
#pragma unroll
                for (int bj = 0; bj < 2; ++bj) { f32x4 v0 = acc[ai][bj][m][0], v1 = acc[ai][bj][m][1];
                    if (ai == 0 && sp) { v0 += ho_get(sb, m, bj, 0); v1 += ho_get(sb, m, bj, 1); }
                    *(u32x4*)(merged + row * DM + col0 + bj * 128) = pack8(v0, v1); }
                asm volatile("" ::: "memory"); } }
    }
};
}

__device__ __forceinline__ void transpose_item(const float* W, int N, int k0, int n0, bf16_t* D, int ldo, int dn0, int dk0, LAS float* scr, int lane) {
#pragma unroll 8
    for (int i = 0; i < 32; ++i) { const int kk = 2 * i + (lane >> 5); scr[kk * 33 + (lane & 31)] = W[(size_t)(k0 + kk) * N + n0 + (lane & 31)]; }
    LDS_WAIT(); asm volatile("" ::: "memory");
    const int c = lane & 7;
#pragma unroll
    for (int j = 0; j < 4; ++j) { const int n = (lane >> 3) + 8 * j; const LAS float* s = scr + (8 * c) * 33 + n;
        u32x4 o; o.x = cvt_pk_bf16(s[0 * 33], s[1 * 33]); o.y = cvt_pk_bf16(s[2 * 33], s[3 * 33]); o.z = cvt_pk_bf16(s[4 * 33], s[5 * 33]); o.w = cvt_pk_bf16(s[6 * 33], s[7 * 33]);
        *(u32x4*)(D + (size_t)(dn0 + n) * ldo + dk0 + 8 * c) = o; }
    LDS_WAIT(); asm volatile("" ::: "memory");
}

__device__ __forceinline__ void phase_p0(const Args& a, LAS unsigned char* lds, int tid, int lane, int wave, int G, int bid) {
    unsigned char* ws = a.ws;
    LAS float* scr = (LAS float*)(lds + wave * 16384);
    const int gw = bid * 8 + wave, NGW = G * 8;
    if (bid == 0 && tid < 16) ((unsigned*)(ws + O_CTL))[64 * tid] = 0u;
    if (bid == 0 && tid < 32) ((unsigned*)(ws + O_CTL))[1024 + 64 * tid] = 0u;
    constexpr int IT_WIN = 32 * 368, IT_WBR = 32 * 64, IT_WOUT = 32 * 64, IT_W1 = 32 * 256, IT_W2 = 128 * 64, IT_L = IT_WIN + IT_WBR + IT_WOUT + IT_W1 + IT_W2;
    constexpr int IT_CV = 128 * 16;
    for (int it = gw; it < 2 * IT_L + IT_CV; it += NGW) {
        if (it >= 2 * IT_L) {
            const int r = it - 2 * IT_L, mtx = r >> 4, kb = (r >> 1) & 7, nb = r & 1;
            transpose_item(a.in[I_CV] + (size_t)mtx * 512 * 64, 64, kb * 64, nb * 32, (bf16_t*)(ws + O_VTC) + (size_t)mtx * 64 * 512, 512, nb * 32, kb * 64, scr, lane);
            continue;
        }
        const int l = it / IT_L; int r = it % IT_L;
        if (r < IT_WIN) {
            const int kb = r / 368, nb = r % 368, k0 = kb * 64, n0 = nb * 32;
            const float* W = a.in[I_WIN] + (size_t)l * DM * INC;
            if (n0 >= 2560 && n0 < 3072) {
                const int g = (n0 - 2560) >> 7, c0 = (n0 - 2560) & 127;
                bf16_t* D = (bf16_t*)(ws + O_WFN) + ((size_t)(l * 4 + g) * 2048) * 128;
#pragma unroll 8
                for (int i = 0; i < 32; ++i) { const int kk = 2 * i + (lane >> 5); D[(size_t)(k0 + kk) * 128 + c0 + (lane & 31)] = f2bf(W[(size_t)(k0 + kk) * INC + n0 + (lane & 31)]); }
            } else {
                const int dn0 = n0 < 2560 ? n0 : n0 + 512;
                transpose_item(W, INC, k0, n0, (bf16_t*)(ws + O_WINT) + (size_t)l * 12288 * 2048, 2048, dn0, k0, scr, lane);
            }
            continue;
        } r -= IT_WIN;
        if (r < IT_WBR) {
            const int kb = r / 64, nb = r % 64, k0 = kb * 64, n0 = nb * 32;
            const float* W = a.in[I_WBR] + (size_t)l * DM * DM;
            if (k0 < 1536) transpose_item(W, DM, k0, n0, (bf16_t*)(ws + O_WBT) + (size_t)l * DM * DM, 2048, n0, k0, scr, lane);
            else transpose_item(W, DM, k0, n0, (bf16_t*)(ws + O_WBD) + (size_t)l * DM * 512, 512, n0, k0 - 1536, scr, lane);
            continue;
        } r -= IT_WBR;
        if (r < IT_WOUT) { const int kb = r / 64, nb = r % 64; transpose_item(a.in[I_WOUT] + (size_t)l * DM * DM, DM, kb * 64, nb * 32, (bf16_t*)(ws + O_WOT) + (size_t)l * DM * DM, 2048, nb * 32, kb * 64, scr, lane); continue; } r -= IT_WOUT;
        if (r < IT_W1) { const int kb = r / 256, nb = r % 256; transpose_item(a.in[I_W1] + (size_t)l * DM * DFF, DFF, kb * 64, nb * 32, (bf16_t*)(ws + O_W1T) + (size_t)l * DFF * DM, 2048, nb * 32, kb * 64, scr, lane); continue; } r -= IT_W1;
        { const int kb = r / 64, nb = r % 64; transpose_item(a.in[I_W2] + (size_t)l * DFF * DM, DM, kb * 64, nb * 32, (bf16_t*)(ws + O_W2T) + (size_t)l * DM * DFF, 8192, nb * 32, kb * 64, scr, lane); }
    }
    const int gt = bid * 512 + tid, NGT = G * 512;
    for (int i = gt; i < 2 * 512 * 512; i += NGT) {
        const int l = i >> 18, c = (i >> 9) & 511, d = i & 511; float v = 0.f;
        if ((c >> 7) == (d >> 7)) v = a.in[I_WPOOL][(((size_t)l * 4 + (c >> 7)) * 128 + (c & 127)) * 128 + (d & 127)] * a.in[I_PSC][l * 512 + d];
        ((bf16_t*)(ws + O_BDP))[i] = f2bf(v);
    }
    for (int i = gt; i < 256 * 256; i += NGT) {
        const int r = i >> 8, c = i & 255, cp = r & 127; const float t = (float)((cp * c) & 127) * (2.0f / 128.0f);
        ((bf16_t*)(ws + O_CS))[i] = f2bf(c < 128 ? (r < 128 ? cospif(t) : sinpif(t)) * 0.08838834764831845f : 0.f);
    }
    for (int i = gt; i < 256 * 512; i += NGT) {
        const int k = i >> 9, c = i & 511, n = c & 255; const float t = (float)((k * n) & 255) * (2.0f / 256.0f);
        ((bf16_t*)(ws + O_DFT256))[i] = f2bf((c < 256 ? cospif(t) : -sinpif(t)) * 0.0625f);
    }
    for (int i = gt; i < 1024 * 2048; i += NGT) {
        const int k = i >> 11, c = i & 2047, n = c & 1023; const float t = (float)((k * n) & 1023) * (2.0f / 1024.0f);
        ((bf16_t*)(ws + O_DFT1024))[i] = f2bf((c < 1024 ? cospif(t) : -sinpif(t)) * 0.03125f);
    }
    for (int i = gt; i < 2 * 4 * 128 * 128; i += NGT) ((bf16_t*)(ws + O_WSB))[i] = f2bf(a.in[I_WSP][i]);
    for (int i = gt; i < 8 * 2 * 8 * 512 * 64 / 4; i += NGT) { const f32x4 v = ((const f32x4*)a.in[I_CK])[i]; u32x2 w; w.x = cvt_pk_bf16(v[0], v[1]); w.y = cvt_pk_bf16(v[2], v[3]); ((u32x2*)(ws + O_CK))[i] = w; }
    __syncthreads();
    for (int it = gw; it < 2 * 16 * 48; it += NGW) {
        const int l = it / 768, rem = it % 768, dch = rem / 48, cb = rem % 48, j0 = cb * 256 + lane * 4, d0 = dch * 128;
        for (int i = lane; i < NCOND * 128; i += 64) { const int cond = i >> 7, d = i & 127; const float x = cond == 0 ? a.in[I_CCTX][d0 + d] : a.in[I_C][(size_t)(cond - 1) * DM + d0 + d]; scr[i] = x * sigmoidf_(x); }
        LDS_WAIT(); asm volatile("" ::: "memory");
        f32x4 acc[NCOND];
#pragma unroll
        for (int c = 0; c < NCOND; ++c) acc[c] = (f32x4){0.f, 0.f, 0.f, 0.f};
        const float* wp = a.in[I_WADA] + ((size_t)l * DM + d0) * 12288 + j0;
#pragma unroll 4
        for (int d = 0; d < 128; ++d) { const f32x4 w = *(const f32x4*)(wp + (size_t)d * 12288);
#pragma unroll
            for (int c = 0; c < NCOND; ++c) acc[c] += w * scr[c * 128 + d]; }
#pragma unroll
        for (int c = 0; c < NCOND; ++c) *(f32x4*)((float*)(ws + O_MODP) + ((size_t)(dch * 2 + l) * NCOND + c) * 12288 + j0) = acc[c];
        LDS_WAIT(); asm volatile("" ::: "memory");
    }
}

__device__ __forceinline__ void phase_p1_modreduce(const Args& a, int tid, int G, int bid) {
    const int gt = bid * 512 + tid, NGT = G * 512;
    const float* P = (const float*)(a.ws + O_MODP); float* M = (float*)(a.ws + O_MOD);
    for (int i = gt; i < 2 * NCOND * 2048; i += NGT) {
        const int l = i / (NCOND * 2048), cond = (i / 2048) % NCOND, col = i & 2047;
        float m[6];
#pragma unroll
        for (int s = 0; s < 6; ++s) { float v = a.in[I_BADA][l * 12288 + s * 2048 + col];
            for (int dch = 0; dch < 16; ++dch) v += P[((size_t)(dch * 2 + l) * NCOND + cond) * 12288 + s * 2048 + col];
            m[s] = v; }
        float* o = M + ((size_t)(l * NCOND + cond) * 6) * 2048 + col;
        o[0] = a.in[I_N1G][l * 2048 + col] * (1.f + m[1]); o[2048] = m[0]; o[2 * 2048] = m[2];
        o[3 * 2048] = a.in[I_N2G][l * 2048 + col] * (1.f + m[4]); o[4 * 2048] = m[3]; o[5 * 2048] = m[5];
    }
}

__device__ __forceinline__ void phase_norm(const Args& a, int l, int which, bool from_input, int lane, int wave, int G, int bid) {
    const int gw = bid * 8 + wave, NGW = G * 8;
    bf16_t* H = (bf16_t*)(a.ws + O_H);
    const int chunk = (NTOK + NGW - 1) / NGW;
    int row = gw * chunk; const int rend = (row + chunk) < NTOK ? (row + chunk) : NTOK;
    if (row >= rend) return;
#define NORM_XPTR(r) (from_input ? ((r) < NCTXT ? a.in[I_XP] + (size_t)(r) * DM : a.in[I_XS] + (size_t)((r) - NCTXT) * DM) : a.out + (size_t)(r) * DM)
    f32x4 v[8], av[8], sv[8]; int ccond = -1;
    { const float* xr = NORM_XPTR(row);
#pragma unroll
      for (int j = 0; j < 8; ++j) v[j] = *(const f32x4*)(xr + j * 256 + lane * 4); }
    for (; row < rend; ++row) {
        f32x4 vn[8];
        if (row + 1 < rend) { const float* xr = NORM_XPTR(row + 1);
#pragma unroll
            for (int j = 0; j < 8; ++j) vn[j] = *(const f32x4*)(xr + j * 256 + lane * 4); }
        const int cond = row < NCTXT ? 0 : 1 + ((row - NCTXT) >> 10);
        if (cond != ccond) { ccond = cond; const float* ap = (const float*)(a.ws + O_MOD) + ((size_t)(l * NCOND + cond) * 6 + which) * 2048;
#pragma unroll
            for (int j = 0; j < 8; ++j) { av[j] = *(const f32x4*)(ap + j * 256 + lane * 4); sv[j] = *(const f32x4*)(ap + 2048 + j * 256 + lane * 4); } }
        float s = 0.f;
#pragma unroll
        for (int j = 0; j < 8; ++j) s += (v[j][0] * v[j][0] + v[j][1] * v[j][1]) + (v[j][2] * v[j][2] + v[j][3] * v[j][3]);
        const float r = rsqrtf(wave_sum(s) * (1.0f / DM) + 1e-6f);
#pragma unroll
        for (int j = 0; j < 8; ++j) { const f32x4 o = v[j] * r * av[j] + sv[j]; u32x2 w; w.x = cvt_pk_bf16(o[0], o[1]); w.y = cvt_pk_bf16(o[2], o[3]);
            *(u32x2*)(H + (size_t)row * DM + j * 256 + lane * 4) = w; }
#pragma unroll
        for (int j = 0; j < 8; ++j) v[j] = vn[j];
    }
#undef NORM_XPTR
}

template <bool SCALE>
__device__ __forceinline__ void transpose128(const bf16_t* src, int ld_src, bf16_t* dst, int ld_dst, LAS unsigned char* lds, int tid, const LAS float* rtab, const float* gvec) {
    LAS bf16_t* T = (LAS bf16_t*)lds;
#pragma unroll
    for (int j = 0; j < 4; ++j) { const int ch = tid + j * 512, row = ch >> 4, cc = ch & 15;
        u32x4 v = *(const u32x4*)(src + (size_t)row * ld_src + cc * 8);
        if (SCALE) { const float r = rtab[row]; const f32x4 g0 = *(const f32x4*)(gvec + cc * 8), g1 = *(const f32x4*)(gvec + cc * 8 + 4);
            v.x = cvt_pk_bf16(bflo(v.x) * r * g0[0], bfhi(v.x) * r * g0[1]); v.y = cvt_pk_bf16(bflo(v.y) * r * g0[2], bfhi(v.y) * r * g0[3]);
            v.z = cvt_pk_bf16(bflo(v.z) * r * g1[0], bfhi(v.z) * r * g1[1]); v.w = cvt_pk_bf16(bflo(v.w) * r * g1[2], bfhi(v.w) * r * g1[3]); }
        *(LAS u32x4*)(T + row * 136 + cc * 8) = v; }
    __syncthreads();
#pragma unroll
    for (int j = 0; j < 4; ++j) { const int ch = tid + j * 512, c = ch & 127, qc = ch >> 7;
        unsigned short e[8];
#pragma unroll
        for (int k = 0; k < 8; ++k) e[k] = T[(qc * 8 + k) * 136 + c];
        u32x4 o; o.x = e[0] | ((unsigned)e[1] << 16); o.y = e[2] | ((unsigned)e[3] << 16); o.z = e[4] | ((unsigned)e[5] << 16); o.w = e[6] | ((unsigned)e[7] << 16);
        *(u32x4*)(dst + (size_t)c * ld_dst + qc * 8) = o; }
    __syncthreads();
}

template <int W>
__device__ __forceinline__ void pool_rows(const bf16_t* base, bf16_t* outp, int pos0, int npos, int tl0, int tsub) {
#pragma unroll 2
    for (int it = 0; it < 16; ++it) {
        const int tl = tl0 + it * 4 + tsub, pos = pos0 + tl;
        int lo = pos - (W >> 1); if (lo < 0) lo = 0; int hi = pos + (W >> 1) - 1; if (hi > npos - 1) hi = npos - 1;
        u32x4 x[W];
#pragma unroll
        for (int j = 0; j < W; ++j) { int p = pos - (W >> 1) + j; p = p < lo ? lo : (p > hi ? hi : p); x[j] = *(const u32x4*)(base + (size_t)p * 4096); }
        float s[8] = {0.f, 0.f, 0.f, 0.f, 0.f, 0.f, 0.f, 0.f};
#pragma unroll
        for (int j = 0; j < W; ++j) { const int p = pos - (W >> 1) + j; const float wgt = (p >= lo && p <= hi) ? 1.f : 0.f;
            s[0] += wgt * bflo(x[j].x); s[1] += wgt * bfhi(x[j].x); s[2] += wgt * bflo(x[j].y); s[3] += wgt * bfhi(x[j].y);
            s[4] += wgt * bflo(x[j].z); s[5] += wgt * bfhi(x[j].z); s[6] += wgt * bflo(x[j].w); s[7] += wgt * bfhi(x[j].w); }
        const u32x4 xc = x[W >> 1]; const float inv = 1.0f / (float)(hi - lo + 1);
        u32x4 o; o.x = cvt_pk_bf16(s[0] * inv - bflo(xc.x), s[1] * inv - bfhi(xc.x)); o.y = cvt_pk_bf16(s[2] * inv - bflo(xc.y), s[3] * inv - bfhi(xc.y));
        o.z = cvt_pk_bf16(s[4] * inv - bflo(xc.z), s[5] * inv - bfhi(xc.z)); o.w = cvt_pk_bf16(s[6] * inv - bflo(xc.w), s[7] * inv - bfhi(xc.w));
        *(u32x4*)(outp + (size_t)tl * 2048) = o;
    }
}

__device__ __forceinline__ void phase_prep(const Args& a, int l, LAS unsigned char* lds, int tid, int lane, int wave, int G, int bid) {
    unsigned char* ws = a.ws;
    const bf16_t* Zm = (const bf16_t*)(ws + O_ZM);
    unsigned* qctr = (unsigned*)(ws + O_CTL) + 64 * (8 + l);
    LAS int* qslot = (LAS int*)(lds + 131072 + 128);
    for (;;) {
        __syncthreads();
        if (tid == 0) *qslot = (int)atomicAdd(qctr, 1u);
        __syncthreads();
        const int qi = *qslot; if (qi >= 96 * 6) break;
        const int ord = qi / 96, tt = qi % 96; const int task = ord == 0 ? 0 : (ord == 1 ? 5 : ord - 1);
        const bool ctx = tt < 32; const int bb = ctx ? (tt >> 1) : ((tt - 32) >> 3); const int pos0 = ctx ? (tt & 1) * 128 : ((tt - 32) & 7) * 128; const int npos = ctx ? 256 : 1024;
        const int tok0 = tt * 128;
        if (task == 0) {
            const int j = lane & 7, hd = lane >> 3;
            const f32x4 gq0 = *(const f32x4*)(a.in[I_QNG] + l * 64 + j * 8), gq1 = *(const f32x4*)(a.in[I_QNG] + l * 64 + j * 8 + 4);
            const f32x4 gk0 = *(const f32x4*)(a.in[I_KNG] + l * 64 + j * 8), gk1 = *(const f32x4*)(a.in[I_KNG] + l * 64 + j * 8 + 4);
            const int ax = j >> 2; const bool isx2 = (j & 2) != 0; const int i0 = (j & 1) * 8;
            float invf[8];
#pragma unroll
            for (int e = 0; e < 8; ++e) invf[e] = __builtin_amdgcn_exp2f(-(float)(i0 + e) * (13.287712379549449f / 16.0f));
#pragma unroll 1
            for (int tb = 0; tb < 4; ++tb) {
                u32x4 qw4[4], kw4[4];
#pragma unroll
                for (int u = 0; u < 4; ++u) { const int tok = tok0 + wave * 16 + tb * 4 + u; qw4[u] = *(const u32x4*)(Zm + (size_t)tok * 4096 + lane * 8); kw4[u] = *(const u32x4*)(Zm + (size_t)tok * 4096 + 512 + lane * 8); }
#pragma unroll
                for (int u = 0; u < 4; ++u) {
                    const int tl = wave * 16 + tb * 4 + u, tok = tok0 + tl, pos = pos0 + tl;
                    const u32x4 qw = qw4[u], kw = kw4[u];
                    float q[8] = {bflo(qw.x), bfhi(qw.x), bflo(qw.y), bfhi(qw.y), bflo(qw.z), bfhi(qw.z), bflo(qw.w), bfhi(qw.w)};
                    float k[8] = {bflo(kw.x), bfhi(kw.x), bflo(kw.y), bfhi(kw.y), bflo(kw.z), bfhi(kw.z), bflo(kw.w), bfhi(kw.w)};
                    float sq = 0.f, sk = 0.f;
#pragma unroll
                    for (int e = 0; e < 8; ++e) { sq += q[e] * q[e]; sk += k[e] * k[e]; }
                    sq += __shfl_xor(sq, 1); sq += __shfl_xor(sq, 2); sq += __shfl_xor(sq, 4);
                    sk += __shfl_xor(sk, 1); sk += __shfl_xor(sk, 2); sk += __shfl_xor(sk, 4);
                    const float rq = rsqrtf(sq * (1.f / 64.f) + 1e-6f), rk = rsqrtf(sk * (1.f / 64.f) + 1e-6f);
#pragma unroll
                    for (int e = 0; e < 8; ++e) { q[e] *= rq * (e < 4 ? gq0[e & 3] : gq1[e & 3]); k[e] *= rk * (e < 4 ? gk0[e & 3] : gk1[e & 3]); }
                    { u32x4 o; o.x = cvt_pk_bf16(q[0] * 0.125f, q[1] * 0.125f); o.y = cvt_pk_bf16(q[2] * 0.125f, q[3] * 0.125f); o.z = cvt_pk_bf16(q[4] * 0.125f, q[5] * 0.125f); o.w = cvt_pk_bf16(q[6] * 0.125f, q[7] * 0.125f);
                      *(u32x4*)((bf16_t*)(ws + O_QP) + (size_t)tok * 512 + lane * 8) = o; }
                    if (ctx) {
                        u32x4 o; o.x = cvt_pk_bf16(k[0], k[1]); o.y = cvt_pk_bf16(k[2], k[3]); o.z = cvt_pk_bf16(k[4], k[5]); o.w = cvt_pk_bf16(k[6], k[7]);
                        *(u32x4*)((bf16_t*)(ws + O_KB) + (size_t)tok * 512 + lane * 8) = o;
                        float* ok = a.out + OUTK + ((((size_t)bb * 2 + l) * 8 + hd) * 256 + pos) * 64 + j * 8;
                        *(f32x4*)ok = (f32x4){k[0], k[1], k[2], k[3]}; *(f32x4*)(ok + 4) = (f32x4){k[4], k[5], k[6], k[7]};
                    } else {
                        const float p = (float)(ax == 0 ? (pos >> 6) : (pos & 63));
                        float qr[8], kr[8];
#pragma unroll
                        for (int e = 0; e < 8; ++e) {
                            const float ang = p * invf[e]; const float cs = __cosf(ang), sn = __sinf(ang);
                            const float pq = __shfl_xor(q[e], 2), pk = __shfl_xor(k[e], 2);
                            qr[e] = q[e] * cs + (isx2 ? pq : -pq) * sn; kr[e] = k[e] * cs + (isx2 ? pk : -pk) * sn;
                        }
                        u32x4 o; o.x = cvt_pk_bf16(qr[0] * 0.125f, qr[1] * 0.125f); o.y = cvt_pk_bf16(qr[2] * 0.125f, qr[3] * 0.125f); o.z = cvt_pk_bf16(qr[4] * 0.125f, qr[5] * 0.125f); o.w = cvt_pk_bf16(qr[6] * 0.125f, qr[7] * 0.125f);
                        *(u32x4*)((bf16_t*)(ws + O_QR) + (size_t)(tok - NCTXT) * 512 + lane * 8) = o;
                        u32x4 o2; o2.x = cvt_pk_bf16(kr[0], kr[1]); o2.y = cvt_pk_bf16(kr[2], kr[3]); o2.z = cvt_pk_bf16(kr[4], kr[5]); o2.w = cvt_pk_bf16(kr[6], kr[7]);
                        *(u32x4*)((bf16_t*)(ws + O_KB) + (size_t)tok * 512 + lane * 8) = o2;
                    }
                }
            }
        } else if (task == 1) {
            bf16_t* vt = (bf16_t*)(ws + O_VT) + (ctx ? (size_t)bb * 512 * 256 : (size_t)16 * 512 * 256 + (size_t)bb * 512 * 1024) + pos0;
            if (ctx) {
                const int j = lane & 7, hd = lane >> 3;
#pragma unroll 1
                for (int tb = 0; tb < 2; ++tb) {
                    u32x4 w8[8];
#pragma unroll
                    for (int u = 0; u < 8; ++u) w8[u] = *(const u32x4*)(Zm + (size_t)(tok0 + wave * 16 + tb * 8 + u) * 4096 + 1024 + lane * 8);
#pragma unroll
                    for (int u = 0; u < 8; ++u) { const int pos = pos0 + wave * 16 + tb * 8 + u; const u32x4 w = w8[u];
                        float* ov = a.out + OUTV + ((((size_t)bb * 2 + l) * 8 + hd) * 256 + pos) * 64 + j * 8;
                        *(f32x4*)ov = (f32x4){bflo(w.x), bfhi(w.x), bflo(w.y), bfhi(w.y)}; *(f32x4*)(ov + 4) = (f32x4){bflo(w.z), bfhi(w.z), bflo(w.w), bfhi(w.w)}; }
                }
            }
            for (int sub = 0; sub < 4; ++sub)
                transpose128<false>(Zm + (size_t)tok0 * 4096 + 1024 + sub * 128, 4096, vt + (size_t)sub * 128 * npos, npos, lds, tid, nullptr, nullptr);
        } else if (task == 2) {
            LAS float* rtab = (LAS float*)(lds + 40960);
#pragma unroll 1
            for (int tb = 0; tb < 2; ++tb) {
                u32x4 w8[8];
#pragma unroll
                for (int u = 0; u < 8; ++u) w8[u] = *(const u32x4*)(Zm + (size_t)(tok0 + wave * 16 + tb * 8 + u) * 4096 + 2048 + lane * 8);
#pragma unroll
                for (int u = 0; u < 8; ++u) { const u32x4 w = w8[u];
                    float s = bflo(w.x) * bflo(w.x) + bfhi(w.x) * bfhi(w.x) + bflo(w.y) * bflo(w.y) + bfhi(w.y) * bfhi(w.y) + bflo(w.z) * bflo(w.z) + bfhi(w.z) * bfhi(w.z) + bflo(w.w) * bflo(w.w) + bfhi(w.w) * bfhi(w.w);
                    s = wave_sum(s); if (lane == 0) rtab[wave * 16 + tb * 8 + u] = rsqrtf(s * (1.f / 512.f) + 1e-6f); }
            }
            __syncthreads();
            for (int sub = 0; sub < 4; ++sub)
                transpose128<true>(Zm + (size_t)tok0 * 4096 + 2048 + sub * 128, 4096, (bf16_t*)(ws + O_VNT) + ((size_t)tt * 512 + sub * 128) * 128, 128, lds, tid, rtab, a.in[I_GNG] + l * 512 + sub * 128);
        } else if (task == 3 || task == 4) {
            const int part = task - 3;
            bf16_t* tb = (bf16_t*)(ws + O_TT) + (ctx ? (size_t)bb * 512 * 512 : (size_t)16 * 512 * 512 + (size_t)bb * 512 * 2048) + part * npos + pos0;
            for (int sub = 0; sub < 4; ++sub)
                transpose128<false>(Zm + (size_t)tok0 * 4096 + 2560 + part * 512 + sub * 128, 4096, tb + (size_t)sub * 128 * 2 * npos, 2 * npos, lds, tid, nullptr, nullptr);
        } else {
            const int gi = wave & 3, half = wave >> 2, tsub = lane >> 4, c8 = gi * 16 + (lane & 15);
            const bf16_t* base = Zm + (size_t)(tok0 - pos0) * 4096 + 3584 + c8 * 8;
            bf16_t* outp = (bf16_t*)(ws + O_BR) + (size_t)tok0 * 2048 + 1536 + c8 * 8;
            if (gi == 0) pool_rows<2>(base, outp, pos0, npos, half * 64, tsub);
            else if (gi == 1) pool_rows<4>(base, outp, pos0, npos, half * 64, tsub);
            else if (gi == 2) pool_rows<8>(base, outp, pos0, npos, half * 64, tsub);
            else pool_rows<16>(base, outp, pos0, npos, half * 64, tsub);
        }
    }
}

#define MFMA16(a, b, c) __builtin_amdgcn_mfma_f32_16x16x32_bf16(a, b, c, 0, 0, 0)
struct KVF { bf16x8 k[4]; bf16x8 v[4]; };
struct KVOff { unsigned k0, k1, v[4]; };
__device__ __forceinline__ KVOff kv_off(int ldk, int ldv, int lane) {
    const int i = lane & 15, g = lane >> 4; const int ko0 = 8 * (i >> 2) + (i & 3);
    KVOff o; o.k0 = (unsigned)(ko0 * ldk + 8 * g) * 2u; o.k1 = o.k0 + (unsigned)(4 * ldk) * 2u;
#pragma unroll
    for (int dt = 0; dt < 4; ++dt) o.v[dt] = (unsigned)((16 * dt + i) * ldv + 8 * g) * 2u;
    return o;
}
__device__ __forceinline__ void kv_load(KVF& f, const bf16_t* kp, const bf16_t* vp, const KVOff& o) {
    const char* kc = (const char*)kp; const char* vc = (const char*)vp;
    f.k[0] = *(const bf16x8*)(kc + o.k0); f.k[1] = *(const bf16x8*)(kc + o.k0 + 64); f.k[2] = *(const bf16x8*)(kc + o.k1); f.k[3] = *(const bf16x8*)(kc + o.k1 + 64);
#pragma unroll
    for (int dt = 0; dt < 4; ++dt) f.v[dt] = *(const bf16x8*)(vc + o.v[dt]);
}
struct QSt { f32x4 o[4]; float m, lsum; };
__device__ __forceinline__ void attn_step(const KVF& f, const bf16x8 (&qf)[2], const float (&sb)[8], bool use_sb, QSt& st) {
    f32x4 s0 = {0.f, 0.f, 0.f, 0.f}, s1 = {0.f, 0.f, 0.f, 0.f};
    s0 = MFMA16(f.k[0], qf[0], s0); s0 = MFMA16(f.k[1], qf[1], s0);
    s1 = MFMA16(f.k[2], qf[0], s1); s1 = MFMA16(f.k[3], qf[1], s1);
    float s[8] = {s0[0], s0[1], s0[2], s0[3], s1[0], s1[1], s1[2], s1[3]};
    if (use_sb) {
#pragma unroll
        for (int e = 0; e < 8; ++e) s[e] = sb[e] < -1e29f ? -3e30f : s[e] + sb[e];
    }
    float mx = fmaxf(fmaxf(fmaxf(s[0], s[1]), fmaxf(s[2], s[3])), fmaxf(fmaxf(s[4], s[5]), fmaxf(s[6], s[7])));
    mx = fmaxf(mx, __shfl_xor(mx, 16)); mx = fmaxf(mx, __shfl_xor(mx, 32));
    const float mn = fmaxf(st.m, mx); const float alpha = fast_exp(st.m - mn); st.m = mn;
    float ps = 0.f;
#pragma unroll
    for (int e = 0; e < 8; ++e) { s[e] = fast_exp(s[e] - mn); ps += s[e]; }
    st.lsum = st.lsum * alpha + ps;
#pragma unroll
    for (int dt = 0; dt < 4; ++dt) st.o[dt] *= alpha;
    u32x4 pw; pw.x = cvt_pk_bf16(s[0], s[1]); pw.y = cvt_pk_bf16(s[2], s[3]); pw.z = cvt_pk_bf16(s[4], s[5]); pw.w = cvt_pk_bf16(s[6], s[7]);
    const bf16x8 pf = __builtin_bit_cast(bf16x8, pw);
#pragma unroll
    for (int dt = 0; dt < 4; ++dt) st.o[dt] = MFMA16(f.v[dt], pf, st.o[dt]);
}
__device__ __forceinline__ void attn_step2(const KVF& f0, const KVF& f1, const bf16x8 (&qf)[2], QSt& st) {
    f32x4 s0 = {0.f, 0.f, 0.f, 0.f}, s1 = {0.f, 0.f, 0.f, 0.f}, s2 = {0.f, 0.f, 0.f, 0.f}, s3 = {0.f, 0.f, 0.f, 0.f};
    s0 = MFMA16(f0.k[0], qf[0], s0); s1 = MFMA16(f0.k[2], qf[0], s1); s2 = MFMA16(f1.k[0], qf[0], s2); s3 = MFMA16(f1.k[2], qf[0], s3);
    s0 = MFMA16(f0.k[1], qf[1], s0); s1 = MFMA16(f0.k[3], qf[1], s1); s2 = MFMA16(f1.k[1], qf[1], s2); s3 = MFMA16(f1.k[3], qf[1], s3);
    float s[16] = {s0[0], s0[1], s0[2], s0[3], s1[0], s1[1], s1[2], s1[3], s2[0], s2[1], s2[2], s2[3], s3[0], s3[1], s3[2], s3[3]};
    float mx = fmaxf(fmaxf(fmaxf(s[0], s[1]), fmaxf(s[2], s[3])), fmaxf(fmaxf(s[4], s[5]), fmaxf(s[6], s[7])));
    mx = fmaxf(mx, fmaxf(fmaxf(fmaxf(s[8], s[9]), fmaxf(s[10], s[11])), fmaxf(fmaxf(s[12], s[13]), fmaxf(s[14], s[15]))));
    mx = fmaxf(mx, __shfl_xor(mx, 16)); mx = fmaxf(mx, __shfl_xor(mx, 32));
    const float mn = fmaxf(st.m, mx); const float alpha = fast_exp(st.m - mn); st.m = mn;
    float ps = 0.f;
#pragma unroll
    for (int e = 0; e < 16; ++e) { s[e] = fast_exp(s[e] - mn); ps += s[e]; }
    st.lsum = st.lsum * alpha + ps;
#pragma unroll
    for (int dt = 0; dt < 4; ++dt) st.o[dt] *= alpha;
    u32x4 pw0, pw1; pw0.x = cvt_pk_bf16(s[0], s[1]); pw0.y = cvt_pk_bf16(s[2], s[3]); pw0.z = cvt_pk_bf16(s[4], s[5]); pw0.w = cvt_pk_bf16(s[6], s[7]);
    pw1.x = cvt_pk_bf16(s[8], s[9]); pw1.y = cvt_pk_bf16(s[10], s[11]); pw1.z = cvt_pk_bf16(s[12], s[13]); pw1.w = cvt_pk_bf16(s[14], s[15]);
    const bf16x8 pf0 = __builtin_bit_cast(bf16x8, pw0), pf1 = __builtin_bit_cast(bf16x8, pw1);
#pragma unroll
    for (int dt = 0; dt < 4; ++dt) { st.o[dt] = MFMA16(f0.v[dt], pf0, st.o[dt]); st.o[dt] = MFMA16(f1.v[dt], pf1, st.o[dt]); }
}
__device__ __forceinline__ void attn_store(const QSt& st0, bf16_t* op) {
    QSt st = st0; st.lsum += __shfl_xor(st.lsum, 16); st.lsum += __shfl_xor(st.lsum, 32);
    const float inv = 1.0f / st.lsum;
#pragma unroll
    for (int dt = 0; dt < 4; ++dt) { u32x2 w2; w2.x = cvt_pk_bf16(st.o[dt][0] * inv, st.o[dt][1] * inv); w2.y = cvt_pk_bf16(st.o[dt][2] * inv, st.o[dt][3] * inv); *(u32x2*)(op + 16 * dt) = w2; }
}
__device__ __forceinline__ void local_bias(float (&sb)[8], const float* rpb, int dr, int kc0, int g, int cq, int cs) {
    asm volatile("" : "+v"(g));
#pragma unroll
    for (int e = 0; e < 8; ++e) { const int kc = kc0 + 8 * g + e; const bool vis = (kc >= cs) && (kc < cs + 16);
        const int idx = vis ? (kc - cq + 15) : 15; const float bv = rpb[dr * 31 + idx]; sb[e] = vis ? bv : -1e30f; }
}

__device__ __forceinline__ void attn_item(const Args& a, int l, int item, int lane) {
    unsigned char* ws = a.ws;
    const int q = lane & 15, g = lane >> 4;
    QSt sA, sB;
#pragma unroll
    for (int dt = 0; dt < 4; ++dt) { sA.o[dt] = (f32x4){0.f, 0.f, 0.f, 0.f}; sB.o[dt] = (f32x4){0.f, 0.f, 0.f, 0.f}; }
    sA.m = -1e30f; sA.lsum = 0.f; sB.m = -1e30f; sB.lsum = 0.f;
    float nb0[8];
    int tokq, h;
    if (item < 2048) {
        const int bb = item >> 8; h = (item >> 5) & 7; const int r = (item >> 1) & 15, p = item & 1;
        tokq = NCTXT + bb * 1024 + r * 64 + 32 * p + q;
        bf16x8 qA[2], qB[2];
        { const bf16_t* pp = (const bf16_t*)(ws + O_QP) + (size_t)tokq * 512 + h * 64 + 8 * g; qA[0] = *(const bf16x8*)pp; qA[1] = *(const bf16x8*)(pp + 32); qB[0] = *(const bf16x8*)(pp + 16 * 512); qB[1] = *(const bf16x8*)(pp + 16 * 512 + 32); }
        const bf16_t* ck = (const bf16_t*)(ws + O_CK) + (((size_t)bb * 2 + l) * 8 + h) * 512 * 64;
        const bf16_t* cv = (const bf16_t*)(ws + O_VTC) + (((size_t)bb * 2 + l) * 8 + h) * 64 * 512;
        int rs = r - 4; if (rs < 0) rs = 0; if (rs > 8) rs = 8;
        const int cqA = 32 * p + q, cqB = cqA + 16; int csA = cqA - 8; if (csA < 0) csA = 0; if (csA > 48) csA = 48; int csB = cqB - 8; if (csB < 0) csB = 0; if (csB > 48) csB = 48;
        const float* rpb = a.in[I_RPB] + (size_t)(l * 8 + h) * 15 * 31;
        const bf16_t* kl = (const bf16_t*)(ws + O_KB) + (size_t)(NCTXT + bb * 1024) * 512 + h * 64;
        const bf16_t* vl = (const bf16_t*)(ws + O_VT) + (size_t)16 * 512 * 256 + ((size_t)bb * 512 + h * 64) * 1024;
        KVF f0, f1; KVOff oc = kv_off(64, 512, lane);
#pragma unroll 1
        for (int kb = 0; kb < 16; kb += 2) {
            kv_load(f0, ck + (size_t)kb * 32 * 64, cv + kb * 32, oc);
            kv_load(f1, ck + (size_t)(kb + 1) * 32 * 64, cv + (kb + 1) * 32, oc);
            attn_step2(f0, f1, qA, sA); attn_step2(f0, f1, qB, sB);
        }
        { const bf16_t* p2 = (const bf16_t*)(ws + O_QR) + (size_t)(tokq - NCTXT) * 512 + h * 64 + 8 * g; qA[0] = *(const bf16x8*)p2; qA[1] = *(const bf16x8*)(p2 + 32); qB[0] = *(const bf16x8*)(p2 + 16 * 512); qB[1] = *(const bf16x8*)(p2 + 16 * 512 + 32); }
        oc = kv_off(512, 1024, lane);
        const int kcA = (32 * p - 8) < 0 ? 0 : (32 * p - 8), kcB = (32 * p + 8) > 32 ? 32 : (32 * p + 8);
#pragma unroll 1
        for (int wi = 0; wi < 8; ++wi) {
            const int dr = rs + wi - r + 7; const int key0 = (rs + wi) * 64;
            kv_load(f0, kl + (size_t)(key0 + kcA) * 512, vl + key0 + kcA, oc);
            kv_load(f1, kl + (size_t)(key0 + kcB) * 512, vl + key0 + kcB, oc);
            local_bias(nb0, rpb, dr, kcA, g, cqA, csA); attn_step(f0, qA, nb0, true, sA);
            local_bias(nb0, rpb, dr, kcB, g, cqB, csB); attn_step(f1, qB, nb0, true, sB);
        }
    } else {
        const int it = item - 2048; const int bb = it >> 6; h = (it >> 3) & 7; const int qb = it & 7;
        tokq = bb * 256 + qb * 32 + q;
        bf16x8 qpA[2], qpB[2];
        { const bf16_t* pp = (const bf16_t*)(ws + O_QP) + (size_t)tokq * 512 + h * 64 + 8 * g; qpA[0] = *(const bf16x8*)pp; qpA[1] = *(const bf16x8*)(pp + 32); qpB[0] = *(const bf16x8*)(pp + 16 * 512); qpB[1] = *(const bf16x8*)(pp + 16 * 512 + 32); }
        const bf16_t* kl = (const bf16_t*)(ws + O_KB) + (size_t)(bb * 256) * 512 + h * 64;
        const bf16_t* vl = (const bf16_t*)(ws + O_VT) + ((size_t)bb * 512 + h * 64) * 256;
        KVF f0, f1; const KVOff oc = kv_off(512, 256, lane);
#pragma unroll 1
        for (int kb = 0; kb < 8; kb += 2) {
            kv_load(f0, kl + (size_t)kb * 32 * 512, vl + kb * 32, oc);
            kv_load(f1, kl + (size_t)(kb + 1) * 32 * 512, vl + (kb + 1) * 32, oc);
            attn_step2(f0, f1, qpA, sA); attn_step2(f0, f1, qpB, sB);
        }
    }
    bf16_t* op = (bf16_t*)(ws + O_BR) + (size_t)tokq * 2048 + h * 64 + 4 * g;
    attn_store(sA, op); attn_store(sB, op + (size_t)16 * 2048);
}

__device__ __forceinline__ void gmlp_item(const Args& a, int l, int item, int lane) {
    unsigned char* ws = a.ws;
    const int tt = item >> 4, gg = (item >> 2) & 3, pb = item & 3;
    const int i = lane & 15, g = lane >> 4;
    const bf16_t* A = (const bf16_t*)(ws + O_VNT) + ((size_t)tt * 512 + gg * 128) * 128;
    const bf16_t* B = (const bf16_t*)(ws + O_WSB) + ((size_t)(l * 4 + gg) * 128 + pb * 32) * 128;
    f32x4 acc[8][2];
#pragma unroll
    for (int mi = 0; mi < 8; ++mi) { acc[mi][0] = (f32x4){0.f, 0.f, 0.f, 0.f}; acc[mi][1] = (f32x4){0.f, 0.f, 0.f, 0.f}; }
#pragma unroll
    for (int ks = 0; ks < 4; ++ks) {
        const bf16x8 b0 = *(const bf16x8*)(B + (size_t)i * 128 + 32 * ks + 8 * g), b1 = *(const bf16x8*)(B + (size_t)(16 + i) * 128 + 32 * ks + 8 * g);
#pragma unroll
        for (int mi = 0; mi < 8; ++mi) { const bf16x8 af = *(const bf16x8*)(A + (size_t)(16 * mi + i) * 128 + 32 * ks + 8 * g);
            acc[mi][0] = MFMA16(af, b0, acc[mi][0]); acc[mi][1] = MFMA16(af, b1, acc[mi][1]); }
    }
    const bf16_t* Zm = (const bf16_t*)(ws + O_ZM);
#pragma unroll
    for (int nj = 0; nj < 2; ++nj) { const int p = pb * 32 + 16 * nj + i; const int tok = tt * 128 + p; const float bs = a.in[I_BSP][(l * 4 + gg) * 128 + p];
        u32x2 uw[8];
#pragma unroll
        for (int mi = 0; mi < 8; ++mi) uw[mi] = *(const u32x2*)(Zm + (size_t)tok * 4096 + 1536 + gg * 128 + 16 * mi + 4 * g);
#pragma unroll
        for (int mi = 0; mi < 8; ++mi) { const int c = gg * 128 + 16 * mi + 4 * g; const f32x4 v = acc[mi][nj];
            u32x2 ow; ow.x = cvt_pk_bf16(bflo(uw[mi].x) * (v[0] + bs), bfhi(uw[mi].x) * (v[1] + bs)); ow.y = cvt_pk_bf16(bflo(uw[mi].y) * (v[2] + bs), bfhi(uw[mi].y) * (v[3] + bs));
            *(u32x2*)((bf16_t*)(ws + O_BR) + (size_t)tok * 2048 + 512 + c) = ow; } }
}

#define XB_TMO      128
#define XB_XCNT(j)  (256  + 64 * (j))
#define XB_XSUB(j)  (1280 + 64 * (j))
#define XB_XGEN(j)  (2304 + 64 * (j))
#define XB_TOP      3328
#define XB_TOPGEN   3392
#define XCD_BAR_WORDS 3456
#define XB_SPIN_CAP (1u << 22)
constexpr int CW_BAR = 4096, CW_FLAG = 8192;
__device__ __forceinline__ unsigned xb_ld(unsigned* p)              { return __hip_atomic_load(p, __ATOMIC_RELAXED, __HIP_MEMORY_SCOPE_AGENT); }
__device__ __forceinline__ unsigned xb_add(unsigned* p, unsigned v) { return __hip_atomic_fetch_add(p, v, __ATOMIC_RELAXED, __HIP_MEMORY_SCOPE_AGENT); }
__device__ __forceinline__ unsigned xb_xcc_id() { return (unsigned)__builtin_amdgcn_s_getreg((3 << 11) | 20) & 0xFu; }
#define XB_SPIN(cond, bar) do { unsigned _sp = 0; while (cond) { __builtin_amdgcn_s_sleep(1); \
    if ((++_sp & 255u) == 0u) { if (xb_ld(&(bar)[XB_TMO])) break; if (_sp > XB_SPIN_CAP) { atomicAdd(&(bar)[XB_TMO], 1u); break; } } } } while (0)
struct XcdBarrier { unsigned* bar; unsigned x; volatile LAS unsigned* st; };
__device__ __forceinline__ XcdBarrier xcd_barrier_post(unsigned* bar, volatile LAS unsigned* st) {
    XcdBarrier b; b.bar = bar; b.x = xb_xcc_id(); b.st = st;
    if (threadIdx.x == 0) (void)xb_add(&bar[XB_XCNT(b.x)], 1u);
    return b;
}
__device__ __forceinline__ void xcd_barrier_complete(unsigned* bar, unsigned x, unsigned& nloc, unsigned& nx) {
    const unsigned G = gridDim.x * gridDim.y * gridDim.z;
    unsigned sum, cnt, mine, sp = 0u;
    for (;;) {
        sum = 0u; cnt = 0u; mine = 0u;
#pragma unroll
        for (unsigned j = 0; j < 16; ++j) { const unsigned c = xb_ld(&bar[XB_XCNT(j)]); sum += c; cnt += (c > 0u) ? 1u : 0u; mine = (j == x) ? c : mine; }
        if (sum == G) break;
        __builtin_amdgcn_s_sleep(1);
        if ((++sp & 255u) == 0u) { if (xb_ld(&bar[XB_TMO])) break; if (sp > XB_SPIN_CAP) { atomicAdd(&bar[XB_TMO], 1u); break; } }
    }
    nloc = mine > 0u ? mine : 1u; nx = cnt > 0u ? cnt : 1u;
}
__device__ __forceinline__ void xcd_barrier(const XcdBarrier& b) {
    asm volatile("s_waitcnt vmcnt(0)" ::: "memory");
    __syncthreads();
    if (threadIdx.x == 0) {
        unsigned* bar = b.bar;
        __builtin_amdgcn_s_waitcnt(0);
        unsigned nloc = b.st[0], nx = b.st[1];
        if (nloc == 0u) { xcd_barrier_complete(bar, b.x, nloc, nx); b.st[0] = nloc; b.st[1] = nx; }
        const unsigned old = xb_add(&bar[XB_XSUB(b.x)], 1u);
        const unsigned gen = old / nloc;
        if (old + 1u == (gen + 1u) * nloc) {
            __builtin_amdgcn_fence(__ATOMIC_RELEASE, "agent");
            asm volatile("s_waitcnt vmcnt(0)" ::: "memory");
            const unsigned og = xb_add(&bar[XB_TOP], 1u);
            const unsigned tg = og / nx;
            if (og + 1u == (tg + 1u) * nx) xb_add(&bar[XB_TOPGEN], 1u);
            else XB_SPIN(xb_ld(&bar[XB_TOPGEN]) == tg, bar);
            __builtin_amdgcn_fence(__ATOMIC_ACQUIRE, "agent");
            xb_add(&bar[XB_XGEN(b.x)], 1u);
            asm volatile("s_waitcnt vmcnt(0)" ::: "memory");
        } else {
            XB_SPIN(xb_ld(&bar[XB_XGEN(b.x)]) == gen, bar);
            __builtin_amdgcn_fence(__ATOMIC_ACQUIRE, "agent");
            asm volatile("s_waitcnt vmcnt(0)" ::: "memory");
        }
    }
    __syncthreads();
}

__global__ void __launch_bounds__(512, 2) fwd(Args a) {
    extern __shared__ __attribute__((aligned(16))) unsigned char lds_raw[];
    LAS unsigned char* lds = (LAS unsigned char*)lds_raw;
    cg::grid_group grid = cg::this_grid();
    int tid0 = threadIdx.x; const int wave = __builtin_amdgcn_readfirstlane(tid0 >> 6), G = gridDim.x, bid = blockIdx.x;
#define OPQ int tid = tid0; asm volatile("" : "+v"(tid)); const int lane = tid & 63; (void)lane;
    unsigned char* ws = a.ws;
    const int lo = a.ph_lo, hi = a.ph_hi;
    int ph = 0;
#ifndef EN
#define EN 0xFFFF
#endif
#define RUN(k) ((k) >= lo && (k) < hi)
#define ENB(t) if constexpr ((EN >> (t)) & 1)
#ifndef DUP
#define DUP 0
#endif
#define REP(t) _Pragma("nounroll") for (int rep = 0; rep < ((((DUP) >> (t)) & 1) ? 2 : 1); ++rep)
#define REPSYNC(t) do { if (((((DUP) >> (t)) & 1)) && rep == 0) xcd_barrier(xbar); } while (0)
#define SEAM(k) do { if ((k) + 1 < hi) xcd_barrier(xbar); } while (0)

    const bool ksplit = (G == 256) && (hi - lo > 1);
    XcdBarrier xbar; xbar.bar = (unsigned*)(ws + O_CTL) + CW_BAR; xbar.x = 0; xbar.st = (volatile LAS unsigned*)(lds + 131072 + 64);
    if (hi - lo > 1) {
        if (tid0 < 2) xbar.st[tid0] = 0u;
        if (bid == 0) { for (int i = tid0; i < XCD_BAR_WORDS; i += 512) xbar.bar[i] = 0u; if (tid0 < 16) ((unsigned*)(ws + O_CTL))[64 * tid0] = 0u; if (tid0 < 32) ((unsigned*)(ws + O_CTL))[1024 + 64 * tid0] = 0u;
            for (int i = tid0; i < 12288; i += 512) ((unsigned*)(ws + O_CTL))[CW_FLAG + i] = 0u; }
        grid.sync();
        xbar = xcd_barrier_post(xbar.bar, xbar.st);
    }
    if (RUN(0)) { REP(0) { ENB(0) { OPQ phase_p0(a, lds, tid, lane, wave, G, bid); } REPSYNC(0); } SEAM(0); }
    if (RUN(1)) { ENB(1) {
#pragma nounroll
        for (int pass = 0; pass < 2; ++pass) {
            pg8::SchedFold S{(const char*)(ws + (pass ? O_WBD : O_CS)), (const char*)(ws + (pass ? O_BDP : O_WFN)), pass, pass ? bid - 64 : bid};
            pg8::EpiStore E{(bf16_t*)(ws + (pass ? O_WBT : O_WINT)), 2048};
            pg8::gemm_phase(lds, pass ? 512 : 256, pass ? 512 : 128, pass ? 512 : 256, S, E); }
        { OPQ phase_p1_modreduce(a, tid, G, bid); } }
        SEAM(1);
    }
    for (int l = 0; l < 2; ++l) {
        const int p0 = 2 + 9 * l;
        const float* mod_l = (const float*)(ws + O_MOD) + (size_t)l * NCOND * 6 * 2048;
        if (RUN(p0 + 0)) {
#ifdef EXP_NANFILL
            { OPQ for (int i = bid * 512 + tid; i < 12288 * 1024; i += G * 512) ((u32x4*)(ws + O_ZG))[i] = (u32x4){0x7fc07fc0u, 0x7fc07fc0u, 0x7fc07fc0u, 0x7fc07fc0u}; }
#endif
            REP(2) { ENB(2) { OPQ phase_norm(a, l, 0, l == 0, lane, wave, G, bid); } REPSYNC(2); } SEAM(p0 + 0); }
        if (RUN(p0 + 1)) { REP(3) { ENB(3) {
            pg8::SchedMN S{(const char*)(ws + O_H), (const char*)(ws + O_WINT) + (size_t)l * 12288 * 2048 * 2, 2048, 2048, 48, 48, G, bid, 0, 48 * 48, 0, 0, 0, 0};
            pg8::EpiZ E{(bf16_t*)(ws + O_ZM), (bf16_t*)(ws + O_ZG), a.in[I_BGATE] + (size_t)l * 8192};
            pg8::gemm_phase(lds, 2048, 2048, 2048, S, E); } REPSYNC(3); }
            SEAM(p0 + 1);
        }
        if (RUN(p0 + 2)) { REP(4) { ENB(4) { OPQ phase_prep(a, l, lds, tid, lane, wave, G, bid); } REPSYNC(4); } SEAM(p0 + 2); }
        if (RUN(p0 + 3)) { REP(5) { ENB(5) {
#pragma nounroll
            for (int pass = 0; pass < 2; ++pass) { const int lat = 1 - pass, Kd = lat ? 2048 : 512;
              pg8::SchedDFT S{(const char*)(ws + (lat ? O_DFT1024 : O_DFT256)), (const char*)(ws + O_TT) + (lat ? (size_t)16 * 512 * 512 * 2 : 0), lat, lat ? bid : bid - 64}; pg8::EpiStore E{(bf16_t*)(ws + O_BR), 2048};
              pg8::gemm_phase(lds, Kd, Kd, Kd, S, E); }
            } ENB(10) { OPQ
            unsigned* cbase = (unsigned*)(ws + O_CTL) + 1024 + (l + 2 * rep) * 8 * 64;
            const int myx = (int)(xb_xcc_id() & 7u);
            constexpr int CPX = (3072 + 1536) / 8;
#pragma unroll 1
            for (int k = 0; k < 8; ++k) {
                const int x = (myx + k) & 7; unsigned* ctr = cbase + x * 64;
                for (;;) {
                    int c = CPX;
                    if (lane == 0) { if (__hip_atomic_load(ctr, __ATOMIC_RELAXED, __HIP_MEMORY_SCOPE_AGENT) < (unsigned)CPX) c = (int)atomicAdd(ctr, 1u); }
                    c = __builtin_amdgcn_readfirstlane(c);
                    if (c >= CPX) break;
                    const int idx = (((c >> 5) * 8 + x) << 5) + (c & 31);
                    if (idx < 3072) attn_item(a, l, idx, lane); else gmlp_item(a, l, idx - 3072, lane);
                }
            } } REPSYNC(5); }
            SEAM(p0 + 3);
        }
        if (RUN(p0 + 4)) { REP(6) { ENB(6) {
            const int nps = ksplit ? 2 : 1;
#pragma nounroll
            for (int pass = 0; pass < nps; ++pass) {
                pg8::SchedMN S{(const char*)(ws + O_BR), (const char*)(ws + O_WBT) + (size_t)l * DM * DM * 2, 2048, 2048, 48, 8, G, bid, 0, ksplit ? 256 : 384, pass, 256, 128, 1024 * 2};
                pg8::EpiBR E{(const bf16_t*)(ws + O_ZG), (bf16_t*)(ws + O_H), (float*)(ws + O_ZM), (unsigned*)(ws + O_CTL) + CW_FLAG + (4 + l) * 128 * 16};
                pg8::gemm_phase(lds, 2048, 2048, pass ? 1024 : 2048, S, E); } } REPSYNC(6); }
            SEAM(p0 + 4);
        }
        if (RUN(p0 + 5)) { ENB(7) {
            const int nps = ksplit ? 2 : 1;
#pragma nounroll
            for (int pass = 0; pass < nps; ++pass) {
                pg8::SchedMN S{(const char*)(ws + O_H), (const char*)(ws + O_WOT) + (size_t)l * DM * DM * 2, 2048, 2048, 48, 8, G, bid, 0, ksplit ? 256 : 384, pass, 256, 128, 1024 * 2};
                pg8::EpiRes E{l == 0 ? a.in[I_XP] : a.out, l == 0 ? a.in[I_XS] : a.out + (size_t)NCTXT * DM, a.out, mod_l, 2, (float*)(ws + O_ZM), (unsigned*)(ws + O_CTL) + CW_FLAG + (l * 2 + 0) * 128 * 16};
                pg8::gemm_phase(lds, 2048, 2048, pass ? 1024 : 2048, S, E); } }
            SEAM(p0 + 5);
        }
        if (RUN(p0 + 6)) { ENB(2) { OPQ phase_norm(a, l, 3, false, lane, wave, G, bid); } SEAM(p0 + 6); }
        if (RUN(p0 + 7)) { REP(8) { ENB(8) {
            pg8::SchedMN S{(const char*)(ws + O_H), (const char*)(ws + O_W1T) + (size_t)l * DFF * DM * 2, 2048, 2048, 48, 32, G, bid, 0, 48 * 32, 0, 0, 0, 0};
            pg8::EpiHid E{(bf16_t*)(ws + O_ZG)};
            pg8::gemm_phase(lds, 2048, 2048, 2048, S, E); } REPSYNC(8); }
            SEAM(p0 + 7);
        }
        if (RUN(p0 + 8)) { ENB(9) {
            const int nps = ksplit ? 2 : 1;
#pragma nounroll
            for (int pass = 0; pass < nps; ++pass) {
                pg8::SchedMN S{(const char*)(ws + O_ZG), (const char*)(ws + O_W2T) + (size_t)l * DM * DFF * 2, 8192, 8192, 48, 8, G, bid, 0, ksplit ? 256 : 384, pass, 256, 128, 4096 * 2};
                pg8::EpiRes E{a.out, a.out + (size_t)NCTXT * DM, a.out, mod_l, 5, (float*)(ws + O_ZM), (unsigned*)(ws + O_CTL) + CW_FLAG + (l * 2 + 1) * 128 * 16};
                pg8::gemm_phase(lds, 8192, 8192, pass ? 4096 : 8192, S, E); } }
            SEAM(p0 + 8);
        }
    }
    (void)ph;
}

extern "C" void kernel_launch(void* const* d_in, const int* in_sizes, int n_in, void* d_out, int out_size, void* d_ws, size_t ws_size, hipStream_t stream) {
    static int grid = 0;
    if (grid == 0) {
        if (n_in != 24 || ws_size < WS_NEED) { fprintf(stderr, "kernel_launch: need 24 inputs and %zu B of workspace (got %d, %zu)\n", (size_t)WS_NEED, n_in, ws_size); grid = -1; return; }
        int dev = 0, cus = 0, per_cu = 0;
        hipGetDevice(&dev); hipDeviceGetAttribute(&cus, hipDeviceAttributeMultiprocessorCount, dev);
        if (hipFuncSetAttribute((const void*)fwd, hipFuncAttributeMaxDynamicSharedMemorySize, LDS_BYTES) != hipSuccess) { fprintf(stderr, "kernel_launch: hipFuncSetAttribute failed\n"); grid = -1; return; }
        if (hipOccupancyMaxActiveBlocksPerMultiprocessor(&per_cu, (const void*)fwd, 512, LDS_BYTES) != hipSuccess || per_cu < 1) { fprintf(stderr, "kernel_launch: occupancy query says %d\n", per_cu); per_cu = 1; }
        (void)hipGetLastError();
        grid = cus;
    }
    if (grid < 0) return;
    Args a{};
    for (int i = 0; i < 24; ++i) a.in[i] = (const float*)d_in[i];
    a.out = (float*)d_out; a.ws = (unsigned char*)d_ws;
#if N_LAUNCH_MODE == 1
    a.ph_lo = 0; a.ph_hi = NPHASE;
    void* args[] = {&a};
    hipError_t e = hipLaunchCooperativeKernel((const void*)fwd, dim3(grid), dim3(512), args, LDS_BYTES, stream);
    if (e != hipSuccess) fprintf(stderr, "kernel_launch: cooperative launch failed: %s (grid %d)\n", hipGetErrorString(e), grid);
#else
    for (int p = 0; p < NPHASE; ++p) { a.ph_lo = p; a.ph_hi = p + 1; hipLaunchKernelGGL(fwd, dim3(grid), dim3(512), LDS_BYTES, stream, a); }
#endif
}
```

```cpp
#include <hip/hip_runtime.h>
#include <hip/hip_cooperative_groups.h>
#include <cstdio>
#include <cstdint>
namespace cg = cooperative_groups;


#ifndef N_LAUNCH_MODE
#define N_LAUNCH_MODE 1
#endif

#define LAS __attribute__((address_space(3)))
typedef unsigned short bf16_t;
typedef short bf16x8 __attribute__((ext_vector_type(8)));
typedef float f32x4 __attribute__((ext_vector_type(4)));
typedef float f32x2 __attribute__((ext_vector_type(2)));
typedef unsigned u32x4 __attribute__((ext_vector_type(4)));
typedef unsigned u32x2 __attribute__((ext_vector_type(2)));

constexpr int DM = 2048, NTOK = 12288, NCTXT = 4096, DFF = 8192, INC = 11776;
constexpr int NCOND = 9;
constexpr size_t MiB = 1u << 20;
constexpr size_t O_CTL = 0, O_WINT = 1 * MiB, O_WBT = 97 * MiB, O_WOT = 113 * MiB, O_W1T = 129 * MiB, O_W2T = 193 * MiB,
                 O_WFN = 257 * MiB, O_WBD = 261 * MiB, O_BDP = 265 * MiB, O_CS = 266 * MiB, O_DFT256 = 267 * MiB, O_DFT1024 = 268 * MiB,
                 O_WSB = 272 * MiB, O_MODP = 273 * MiB, O_MOD = 287 * MiB, O_CK = 288 * MiB, O_VTC = 296 * MiB, O_H = 304 * MiB,
                 O_ZM = 352 * MiB, O_ZG = 448 * MiB, O_QP = 640 * MiB, O_QR = 652 * MiB, O_KB = 660 * MiB, O_VT = 672 * MiB,
                 O_VNT = 684 * MiB, O_TT = 696 * MiB, O_BR = 720 * MiB, WS_NEED = 768 * MiB;
constexpr size_t OUTK = (size_t)NTOK * DM, OUTV = OUTK + (size_t)16 * 2 * 8 * 256 * 64;
constexpr int LDS_BYTES = 147456;
constexpr int NPHASE = 2 + 9 * 2;

struct Args { const float* in[24]; float* out; unsigned char* ws; int ph_lo, ph_hi; };
enum { I_XP = 0, I_XS, I_CK, I_CV, I_C, I_CCTX, I_N1G, I_WIN, I_BGATE, I_QNG, I_KNG, I_RPB, I_GNG, I_WSP, I_BSP, I_WPOOL, I_PSC, I_WBR, I_WOUT, I_N2G, I_W1, I_W2, I_WADA, I_BADA };

typedef __bf16 bf16x2_t __attribute__((ext_vector_type(2)));
__device__ __forceinline__ unsigned cvt_pk_bf16(float lo, float hi) { const f32x2 v = {lo, hi}; const bf16x2_t b = __builtin_convertvector(v, bf16x2_t); return __builtin_bit_cast(unsigned, b); }
__device__ __forceinline__ float bf2f(unsigned short u) { return __uint_as_float(((unsigned)u) << 16); }
__device__ __forceinline__ float bflo(unsigned u) { return __uint_as_float(u << 16); }
__device__ __forceinline__ float bfhi(unsigned u) { return __uint_as_float(u & 0xffff0000u); }
__device__ __forceinline__ bf16_t f2bf(float f) { return (bf16_t)(cvt_pk_bf16(f, 0.f) & 0xffffu); }
__device__ __forceinline__ float wave_sum(float v) {
#pragma unroll
    for (int o = 1; o < 64; o <<= 1) v += __shfl_xor(v, o);
    return v;
}
__device__ __forceinline__ float fast_exp(float x) { return __builtin_amdgcn_exp2f(x * 1.44269504089f); }
__device__ __forceinline__ float sigmoidf_(float x) { return __builtin_amdgcn_rcpf(1.0f + fast_exp(-x)); }
__device__ __forceinline__ float gelu_tanh(float x) { const float u = 0.7978845608f * (x + 0.044715f * x * x * x); return x * sigmoidf_(2.0f * u); }
#define LDS_WAIT() asm volatile("s_waitcnt lgkmcnt(0)" ::: "memory")
#define VM_WAIT() asm volatile("s_waitcnt vmcnt(0)" ::: "memory")

namespace pg8 {
constexpr int BM = 256, BK = 64, HALF = 128, HTB = HALF * BK * 2, STAGE_BYTES = 8 * HTB;
__device__ __forceinline__ int lds_byte(int r, int c) { const int st = (r >> 4) * 2 + (c >> 5), rr = r & 15, cc = c & 31, ob = rr * 64 + cc * 2; return st * 1024 + (ob ^ (((ob >> 9) & 1) << 5)); }
__device__ __forceinline__ void stage_rc(int b, int& R, int& C) { const int st = b / 1024, sb = b % 1024, swz = sb ^ (((sb >> 9) & 1) << 5); R = (st >> 1) * 16 + swz / 64; C = (st & 1) * 32 + (swz % 64) / 2; }
__device__ __forceinline__ int perm32(int rho) { const int n = rho >> 4, i = rho & 15; return 8 * (i >> 2) + 4 * n + (i & 3); }

struct Unit { const char* A; const char* B; long hA; int orow0, orow1, ocol, aux; };
__device__ __forceinline__ void tile_map(int L, int nM, int nN, int& pm, int& pn) {
    const int nwg = nM * nN; int wgid = L;
    { const int q = nwg / 8, r = nwg % 8, xcd = wgid % 8, off = wgid / 8; wgid = (xcd < r ? xcd * (q + 1) : r * (q + 1) + (xcd - r) * q) + off; }
    const int nig = 8 * nN, gid = wgid / nig, fm = gid * 8, gsz = (nM - fm) < 8 ? (nM - fm) : 8;
    pm = fm + ((wgid % nig) % gsz); pn = (wgid % nig) / gsz;
}
template <class Epi, class Sched>
__device__ __forceinline__ void gemm_phase(LAS unsigned char* lds, const int lda, const int ldb, const int K, const Sched& S, const Epi& E) {
    int tid = threadIdx.x; asm volatile("" : "+v"(tid));
    const int wid = __builtin_amdgcn_readfirstlane(tid >> 6), lane = tid & 63, wr = wid >> 2, wc = wid & 3, fr = lane & 15, fq = lane >> 4;
    const int nt = K / BK;
    unsigned voffA[2], voffB[2];
#pragma unroll
    for (int i = 0; i < 2; ++i) { int R, C; stage_rc(tid * 16 + i * 8192, R, C); const int Rb = (R & ~31) + perm32(R & 31);
        voffA[i] = (unsigned)(R * lda + C) * 2u; voffB[i] = (unsigned)(Rb * ldb + C) * 2u; }
    const size_t kstep = (size_t)(BK * 2);
    const size_t hstepB = (size_t)HALF * ldb * 2;
    const unsigned ldsw = (unsigned)wid * 1024u;
    const int aoff = lds_byte(wr * 64 + fr, fq * 8), boff = lds_byte(wc * 32 + fr, fq * 8);
#define PG8_SA(b, h) (((b) * 2 + (h)) * HTB)
#define PG8_SB(b, h) ((4 + (b) * 2 + (h)) * HTB)
#define PG8_STAGE(bufoff, gbase, voff) do { _Pragma("unroll") for (int _i = 0; _i < 2; ++_i) \
        __builtin_amdgcn_global_load_lds((const unsigned*)((const char*)(gbase) + (voff)[_i]), (LAS unsigned*)(lds + (bufoff) + ldsw + _i * 8192), 16, 0, 0); } while (0)
#define PG8_LDA(dst, b, h) do { _Pragma("unroll") for (int m = 0; m < 4; ++m) _Pragma("unroll") for (int k = 0; k < 2; ++k) dst[m][k] = *(const LAS bf16x8*)(lds + PG8_SA(b, h) + aoff + m * 2048 + k * 1024); } while (0)
#define PG8_LDB(dst, b, h) do { _Pragma("unroll") for (int n = 0; n < 2; ++n) _Pragma("unroll") for (int k = 0; k < 2; ++k) dst[n][k] = *(const LAS bf16x8*)(lds + PG8_SB(b, h) + boff + n * 2048 + k * 1024); } while (0)
#define PG8_MMA(ai, bj, At, Bt) do { __builtin_amdgcn_s_setprio(1); _Pragma("unroll") for (int m = 0; m < 4; ++m) _Pragma("unroll") for (int n = 0; n < 2; ++n) _Pragma("unroll") for (int k = 0; k < 2; ++k) \
        acc[ai][bj][m][n] = __builtin_amdgcn_mfma_f32_16x16x32_bf16(Bt[n][k], At[m][k], acc[ai][bj][m][n], 0, 0, 0); __builtin_amdgcn_s_setprio(0); } while (0)
#define PG8_WAIT_V(n) asm volatile("s_waitcnt vmcnt(" #n ")" ::: "memory")
#define PG8_WAIT_L(n) asm volatile("s_waitcnt lgkmcnt(" #n ")" ::: "memory")
#define PG8_BAR __builtin_amdgcn_s_barrier()
#define PG8_SCHED __builtin_amdgcn_sched_barrier(0)
    Unit cur, nxt; int ui = 0;
    if (!S.next(0, cur)) return;
    f32x4 acc[2][2][4][2];
#pragma unroll
    for (int a = 0; a < 2; ++a)
#pragma unroll
        for (int b = 0; b < 2; ++b)
#pragma unroll
            for (int m = 0; m < 4; ++m)
#pragma unroll
                for (int n = 0; n < 2; ++n) acc[a][b][m][n] = (f32x4){0.f, 0.f, 0.f, 0.f};
    bf16x8 At[4][2], B0[2][2], B1[2][2];
    const char* cA = cur.A; const char* cB = cur.B; long chA = cur.hA;
    PG8_STAGE(PG8_SB(0, 0), cB, voffB); PG8_STAGE(PG8_SB(0, 1), cB + hstepB, voffB); PG8_STAGE(PG8_SA(0, 0), cA, voffA); PG8_STAGE(PG8_SA(0, 1), cA + chA, voffA);
    if (wr == 1) PG8_BAR;
    PG8_WAIT_V(2); PG8_BAR;
    PG8_STAGE(PG8_SB(1, 0), cB + kstep, voffB); PG8_STAGE(PG8_SA(1, 0), cA + kstep, voffA); PG8_STAGE(PG8_SB(1, 1), cB + hstepB + kstep, voffB);
    PG8_WAIT_V(6); PG8_BAR;
    for (;;) {
        const bool has_next = S.next(ui + 1, nxt);
        const char* nA = has_next ? nxt.A : cA; const char* nB = has_next ? nxt.B : cB; const long nhA = has_next ? nxt.hA : chA;
        for (int t = 0; t < nt; t += 2) {
            const bool last = (t == nt - 2);
            const char* a1 = cA + (size_t)(t + 1) * kstep;
            const char* a2 = last ? nA : cA + (size_t)(t + 2) * kstep; const char* b2 = last ? nB : cB + (size_t)(t + 2) * kstep;
            const char* a3 = a2 + kstep; const char* b3 = b2 + kstep; const long h2 = last ? nhA : chA;
            PG8_LDB(B0, 0, 0); PG8_LDB(B1, 0, 1); PG8_SCHED; PG8_LDA(At, 0, 0); PG8_STAGE(PG8_SA(1, 1), a1 + chA, voffA);
            PG8_WAIT_V(8); PG8_WAIT_L(0); PG8_BAR; PG8_MMA(0, 0, At, B0); PG8_MMA(0, 1, At, B1); PG8_BAR; PG8_SCHED;
            PG8_LDA(At, 0, 1); PG8_STAGE(PG8_SB(0, 0), b2, voffB); PG8_STAGE(PG8_SB(0, 1), b2 + hstepB, voffB); PG8_STAGE(PG8_SA(0, 0), a2, voffA);
            PG8_WAIT_V(8); PG8_WAIT_L(0); PG8_BAR; PG8_MMA(1, 0, At, B0); PG8_MMA(1, 1, At, B1); PG8_BAR; PG8_SCHED;
            PG8_LDB(B0, 1, 0); PG8_LDB(B1, 1, 1); PG8_SCHED; PG8_LDA(At, 1, 0); PG8_STAGE(PG8_SA(0, 1), a2 + h2, voffA);
            PG8_WAIT_V(8); PG8_WAIT_L(0); PG8_BAR; PG8_MMA(0, 0, At, B0); PG8_MMA(0, 1, At, B1); PG8_BAR; PG8_SCHED;
            PG8_LDA(At, 1, 1); PG8_STAGE(PG8_SB(1, 0), b3, voffB); PG8_STAGE(PG8_SB(1, 1), b3 + hstepB, voffB); PG8_STAGE(PG8_SA(1, 0), a3, voffA);
            PG8_WAIT_V(8); PG8_WAIT_L(0); PG8_BAR; PG8_MMA(1, 0, At, B0); PG8_MMA(1, 1, At, B1); PG8_BAR; PG8_SCHED;
            if constexpr (Epi::MID) { if (((t + 2) & 7) == 0 && t + 2 < nt) E.mid(acc, cur, (t + 2) >> 3, wr, wc, fr, fq); }
        }
        if (wr == 0) PG8_BAR;
        E(acc, cur, wr, wc, fr, fq);
        if (!has_next) break;
#pragma unroll
        for (int a = 0; a < 2; ++a)
#pragma unroll
            for (int b = 0; b < 2; ++b)
#pragma unroll
                for (int m = 0; m < 4; ++m)
#pragma unroll
                    for (int n = 0; n < 2; ++n) acc[a][b][m][n] = (f32x4){0.f, 0.f, 0.f, 0.f};
        cur = nxt; cA = nA; cB = nB; chA = nhA; ++ui;
        if (wr == 1) PG8_BAR;
    }
    PG8_WAIT_V(0);
    PG8_BAR;
#undef PG8_SA
#undef PG8_SB
#undef PG8_STAGE
#undef PG8_LDA
#undef PG8_LDB
#undef PG8_MMA
#undef PG8_WAIT_V
#undef PG8_WAIT_L
#undef PG8_BAR
#undef PG8_SCHED
}

struct SchedMN {
    const char* A; const char* B; int lda, ldb, nM, nN, G, c, ocol_off, lim, split, L0, nsplit, khalf_bytes;
    __device__ __forceinline__ bool next(int i, Unit& u) const {
        int L, kh = 0, aux = 0;
        if (!split) { L = i * G + c; if (c < 0 || L >= lim) return false; }
        else { if (i > 0 || c >= 2 * nsplit) return false; const int j = c >> 1; kh = c & 1; L = L0 + j; aux = (j << 2) | 2 | kh; }
        int pm, pn; tile_map(L, nM, nN, pm, pn);
        const long h = (long)128 * lda * 2;
        u.A = A + (size_t)pm * 256 * lda * 2 + (size_t)kh * khalf_bytes + (kh ? h : 0); u.B = B + (size_t)pn * 256 * ldb * 2 + (size_t)kh * khalf_bytes;
        u.hA = kh ? -h : h;
        u.orow0 = pm * 256 + (kh ? 128 : 0); u.orow1 = pm * 256 + (kh ? 0 : 128); u.ocol = pn * 256 + ocol_off; u.aux = aux; return true;
    }
};
struct SchedBR {
    const char* A; const char* B; int G, c;
    __device__ __forceinline__ bool next(int i, Unit& u) const {
#ifdef EXP_B3
        const int L = i * G + c; if (L >= 48 * 8) return false;
        const int b = 3; int pm, pn; tile_map(L, 48, 8, pm, pn);
#else
        const int L = (i >> 2) * G + c; if (L >= 48 * 8) return false;
        const int b = i & 3; int pm, pn; tile_map(L, 48, 8, pm, pn);
#endif
        u.A = A + (size_t)pm * 256 * 2048 * 2 + b * 1024; u.B = B + (size_t)pn * 256 * 2048 * 2 + b * 1024; u.hA = (long)128 * 2048 * 2; u.orow0 = pm * 256; u.orow1 = pm * 256 + 128; u.ocol = pn * 256; u.aux = b; return true;
    }
};
struct SchedFold {
    const char* A0; const char* B0; int mode, c;
    __device__ __forceinline__ bool next(int i, Unit& u) const {
        if (i > 0 || c < 0) return false;
        if (mode == 0) { if (c >= 64) return false; const int l = c >> 5, g = (c >> 3) & 3, pn = c & 7;
            u.A = A0; u.hA = (long)128 * 256 * 2; u.B = B0 + ((size_t)(l * 4 + g) * 2048 + pn * 256) * 128 * 2; u.orow0 = l * 12288 + 2560 + g * 128; u.orow1 = l * 12288 + 3072 + g * 128; u.ocol = pn * 256; u.aux = g; }
        else { if (c >= 32) return false; const int l = c >> 4, pm = (c & 15) >> 1, pn = c & 1;
            u.A = A0 + ((size_t)l * 2048 + pm * 256) * 512 * 2; u.hA = (long)128 * 512 * 2; u.B = B0 + ((size_t)l * 512 + pn * 256) * 512 * 2; u.orow0 = l * 2048 + pm * 256; u.orow1 = u.orow0 + 128; u.ocol = 1536 + pn * 256; u.aux = 0; }
        return true;
    }
};
struct SchedDFT {
    const char* Amat; const char* TT; int latent, c;
    __device__ __forceinline__ bool next(int i, Unit& u) const {
        if (i > 0 || c < 0) return false;
        if (latent) { if (c >= 64) return false; const int bb = c >> 3, pm = (c & 7) >> 1, pn = c & 1;
            u.A = Amat + (size_t)pm * 256 * 2048 * 2; u.hA = (long)128 * 2048 * 2; u.B = TT + ((size_t)bb * 512 + pn * 256) * 2048 * 2; u.orow0 = NCTXT + bb * 1024 + pm * 256; u.orow1 = u.orow0 + 128; u.ocol = 1024 + pn * 256; }
        else { if (c >= 32) return false; const int bb = c >> 1, pn = c & 1;
            u.A = Amat; u.hA = (long)128 * 512 * 2; u.B = TT + ((size_t)bb * 512 + pn * 256) * 512 * 2; u.orow0 = bb * 256; u.orow1 = u.orow0 + 128; u.ocol = 1024 + pn * 256; }
        u.aux = 0; return true;
    }
};

__device__ __forceinline__ u32x4 pack8(const f32x4 v0, const f32x4 v1) { u32x4 w; w.x = cvt_pk_bf16(v0[0], v0[1]); w.y = cvt_pk_bf16(v0[2], v0[3]); w.z = cvt_pk_bf16(v1[0], v1[1]); w.w = cvt_pk_bf16(v1[2], v1[3]); return w; }
struct EpiStore {
    static constexpr bool MID = false;
    bf16_t* O; int ldc;
    __device__ __forceinline__ void operator()(const f32x4 (&acc)[2][2][4][2], const Unit& u, int wr, int wc, int fr, int fq) const {
        asm volatile("" : "+v"(fr), "+v"(fq));
#pragma unroll
        for (int ai = 0; ai < 2; ++ai)
#pragma unroll
            for (int m = 0; m < 4; ++m) { bf16_t* rowp = O + (size_t)((ai ? u.orow1 : u.orow0) + wr * 64 + m * 16 + fr) * ldc + u.ocol + wc * 32 + 8 * fq;
#pragma unroll
                for (int bj = 0; bj < 2; ++bj) *(u32x4*)(rowp + bj * 128) = pack8(acc[ai][bj][m][0], acc[ai][bj][m][1]); }
    }
};
struct EpiZ {
    static constexpr bool MID = false;
    bf16_t* Zm; bf16_t* Zg; const float* bgate;
    __device__ __forceinline__ void operator()(const f32x4 (&acc)[2][2][4][2], const Unit& u, int wr, int wc, int fr, int fq) const {
        asm volatile("" : "+v"(fr), "+v"(fq));
        const int pn = u.ocol >> 8; const int cb = wc * 32 + 8 * fq;
        if (pn >= 16) {
            const int col0 = u.ocol - 4096 + cb;
            f32x4 bv[2][2];
#pragma unroll
            for (int bj = 0; bj < 2; ++bj)
#pragma unroll
                for (int n = 0; n < 2; ++n) bv[bj][n] = *(const f32x4*)(bgate + col0 + bj * 128 + 4 * n);
#pragma unroll
            for (int ai = 0; ai < 2; ++ai)
#pragma unroll
                for (int m = 0; m < 4; ++m) { bf16_t* rowp = Zg + (size_t)((ai ? u.orow1 : u.orow0) + wr * 64 + m * 16 + fr) * 8192 + col0;
#pragma unroll
                    for (int bj = 0; bj < 2; ++bj) { f32x4 v0 = acc[ai][bj][m][0] + bv[bj][0], v1 = acc[ai][bj][m][1] + bv[bj][1];
#pragma unroll
                        for (int e = 0; e < 4; ++e) { v0[e] = sigmoidf_(v0[e]); v1[e] = sigmoidf_(v1[e]); }
                        *(u32x4*)(rowp + bj * 128) = pack8(v0, v1); } }
        } else {
            const bool gel = (pn >= 6 && pn < 10);
#pragma unroll
            for (int ai = 0; ai < 2; ++ai)
#pragma unroll
                for (int m = 0; m < 4; ++m) { bf16_t* rowp = Zm + (size_t)((ai ? u.orow1 : u.orow0) + wr * 64 + m * 16 + fr) * 4096 + u.ocol + cb;
#pragma unroll
                    for (int bj = 0; bj < 2; ++bj) { f32x4 v0 = acc[ai][bj][m][0], v1 = acc[ai][bj][m][1];
                        if (gel) {
#pragma unroll
                            for (int e = 0; e < 4; ++e) { v0[e] = gelu_tanh(v0[e]); v1[e] = gelu_tanh(v1[e]); } }
                        *(u32x4*)(rowp + bj * 128) = pack8(v0, v1); } }
        }
    }
};
struct EpiHid {
    static constexpr bool MID = false;
    bf16_t* O;
    __device__ __forceinline__ void operator()(const f32x4 (&acc)[2][2][4][2], const Unit& u, int wr, int wc, int fr, int fq) const {
        asm volatile("" : "+v"(fr), "+v"(fq));
#pragma unroll
        for (int ai = 0; ai < 2; ++ai)
#pragma unroll
            for (int m = 0; m < 4; ++m) { bf16_t* rowp = O + (size_t)((ai ? u.orow1 : u.orow0) + wr * 64 + m * 16 + fr) * DFF + u.ocol + wc * 32 + 8 * fq;
#pragma unroll
                for (int bj = 0; bj < 2; ++bj) { f32x4 v0 = acc[ai][bj][m][0], v1 = acc[ai][bj][m][1];
#pragma unroll
                    for (int e = 0; e < 4; ++e) { const float a = fmaxf(v0[e], 0.f), b = fmaxf(v1[e], 0.f); v0[e] = a * a; v1[e] = b * b; }
                    *(u32x4*)(rowp + bj * 128) = pack8(v0, v1); } }
    }
};
__device__ __forceinline__ void ho_send(const f32x4 (&acc)[2][2][4][2], unsigned long long* sb, unsigned* flag, int tidp) {
#pragma unroll
    for (int m = 0; m < 4; ++m)
#pragma unroll
        for (int bj = 0; bj < 2; ++bj)
#pragma unroll
            for (int n = 0; n < 2; ++n) { const f32x4 v = acc[1][bj][m][n]; unsigned long long* p = sb + (size_t)(((m * 2 + bj) * 2 + n) * 1024);
                __hip_atomic_store(p, ((unsigned long long)__float_as_uint(v[1]) << 32) | __float_as_uint(v[0]), __ATOMIC_RELAXED, __HIP_MEMORY_SCOPE_AGENT);
                __hip_atomic_store(p + 1, ((unsigned long long)__float_as_uint(v[3]) << 32) | __float_as_uint(v[2]), __ATOMIC_RELAXED, __HIP_MEMORY_SCOPE_AGENT); }
    asm volatile("s_waitcnt vmcnt(0)" ::: "memory");
    __syncthreads();
    if (tidp == 0) __hip_atomic_store(flag, 1u, __ATOMIC_RELEASE, __HIP_MEMORY_SCOPE_AGENT);
}
__device__ __forceinline__ void ho_wait(unsigned* flag, int tidp) {
    if (tidp == 0) { unsigned spin = 0; while (__hip_atomic_load(flag, __ATOMIC_ACQUIRE, __HIP_MEMORY_SCOPE_AGENT) == 0u) { __builtin_amdgcn_s_sleep(2); if (++spin > (1u << 24)) break; } }
    __syncthreads();
}
__device__ __forceinline__ f32x4 ho_get(unsigned long long* sb, int m, int bj, int n) {
    unsigned long long* p = sb + (size_t)(((m * 2 + bj) * 2 + n) * 1024);
    const unsigned long long a0 = __hip_atomic_load(p, __ATOMIC_RELAXED, __HIP_MEMORY_SCOPE_AGENT), a1 = __hip_atomic_load(p + 1, __ATOMIC_RELAXED, __HIP_MEMORY_SCOPE_AGENT);
    return (f32x4){__uint_as_float((unsigned)a0), __uint_as_float((unsigned)(a0 >> 32)), __uint_as_float((unsigned)a1), __uint_as_float((unsigned)(a1 >> 32))};
}
struct EpiRes {
    static constexpr bool MID = false;
    const float* xp; const float* xs; float* out; const float* mod; int gsel;
    float* S; unsigned* flags;
    __device__ __forceinline__ void operator()(const f32x4 (&acc)[2][2][4][2], const Unit& u, int wr, int wc, int fr, int fq) const {
        asm volatile("" : "+v"(fr), "+v"(fq));
        const int sp = u.aux & 2, jt = u.aux >> 2;
        const int tidp = (wr * 4 + wc) * 64 + fq * 16 + fr;
        const int kh = u.aux & 1;
        unsigned long long* sbs = (unsigned long long*)(S + (size_t)jt * 65536 + kh * 32768) + (size_t)tidp * 2;
        unsigned long long* sb = (unsigned long long*)(S + (size_t)jt * 65536 + (1 - kh) * 32768) + (size_t)tidp * 2;
        if (sp) { ho_send(acc, sbs, flags + jt * 16 + kh * 8, tidp); ho_wait(flags + jt * 16 + (1 - kh) * 8, tidp); }
        const int pm = u.orow0 >> 8; const int cond = pm < 16 ? 0 : 1 + ((pm - 16) >> 2);
        const int col0 = u.ocol + wc * 32 + 8 * fq;
        const float* gp = mod + ((size_t)cond * 6 + gsel) * 2048 + col0;
        f32x4 gv[2][2];
#pragma unroll
        for (int bj = 0; bj < 2; ++bj)
#pragma unroll
            for (int n = 0; n < 2; ++n) gv[bj][n] = *(const f32x4*)(gp + bj * 128 + 4 * n);
        const float* src = pm < 16 ? xp : xs - (size_t)NCTXT * DM;
#pragma unroll
        for (int ai = 0; ai < 2; ++ai) {
            if (ai == 1 && sp) break;
#pragma unroll
            for (int m = 0; m < 4; ++m) { const size_t off = (size_t)((ai ? u.orow1 : u.orow0) + wr * 64 + m * 16 + fr) * DM + col0;
#pragma unroll
                for (int bj = 0; bj < 2; ++bj)
#pragma unroll
                    for (int n = 0; n < 2; ++n) { const f32x4 xv = *(const f32x4*)(src + off + bj * 128 + 4 * n);
                        f32x4 v = acc[ai][bj][m][n];
                        if (ai == 0 && sp) v += ho_get(sb, m, bj, n);
                        *(f32x4*)(out + off + bj * 128 + 4 * n) = xv + gv[bj][n] * v; }
                if (m & 1) asm volatile("" ::: "memory"); } }
    }
};
struct EpiBR {
    static constexpr bool MID = true;
    const bf16_t* Zg; bf16_t* merged; float* S; unsigned* flags;
    __device__ __forceinline__ void scale(f32x4 (&acc)[2][2][4][2], const Unit& u, int b, bool ratio, int wr, int wc, int fr, int fq) const {
        const int col0 = u.ocol + wc * 32 + 8 * fq;
#pragma unroll
        for (int ai = 0; ai < 2; ++ai) {
            u32x4 gw[4][2], nw[4][2];
#pragma unroll
            for (int m = 0; m < 4; ++m)
#pragma unroll
                for (int bj = 0; bj < 2; ++bj) { const bf16_t* gp = Zg + (size_t)((ai ? u.orow1 : u.orow0) + wr * 64 + m * 16 + fr) * 8192 + b * 2048 + col0 + bj * 128;
                    gw[m][bj] = *(const u32x4*)gp; if (ratio) nw[m][bj] = *(const u32x4*)(gp + 2048); }
#pragma unroll
            for (int m = 0; m < 4; ++m)
#pragma unroll
                for (int bj = 0; bj < 2; ++bj) { const u32x4 g4 = gw[m][bj];
                    float g[8] = {bflo(g4.x), bfhi(g4.x), bflo(g4.y), bfhi(g4.y), bflo(g4.z), bfhi(g4.z), bflo(g4.w), bfhi(g4.w)};
#pragma unroll
                    for (int e = 0; e < 8; ++e) g[e] = fmaxf(g[e], 1e-6f);
                    if (ratio) { const u32x4 n4 = nw[m][bj];
                        const float gn[8] = {bflo(n4.x), bfhi(n4.x), bflo(n4.y), bfhi(n4.y), bflo(n4.z), bfhi(n4.z), bflo(n4.w), bfhi(n4.w)};
#pragma unroll
                        for (int e = 0; e < 8; ++e) g[e] *= __builtin_amdgcn_rcpf(fmaxf(gn[e], 1e-6f)); }
                    f32x4 v0 = acc[ai][bj][m][0], v1 = acc[ai][bj][m][1];
                    v0[0] *= g[0]; v0[1] *= g[1]; v0[2] *= g[2]; v0[3] *= g[3]; v1[0] *= g[4]; v1[1] *= g[5]; v1[2] *= g[6]; v1[3] *= g[7];
                    acc[ai][bj][m][0] = v0; acc[ai][bj][m][1] = v1; }
            asm volatile("" ::: "memory"); }
    }
    __device__ __forceinline__ void mid(f32x4 (&acc)[2][2][4][2], const Unit& u, int seg, int wr, int wc, int fr, int fq) const {
        asm volatile("" : "+v"(fr), "+v"(fq));
        const int base = (u.aux & 2) ? (u.aux & 1) * 2 : 0;
        scale(acc, u, base + seg - 1, true, wr, wc, fr, fq);
    }
    __device__ __forceinline__ void operator()(f32x4 (&acc)[2][2][4][2], const Unit& u, int wr, int wc, int fr, int fq) const {
        asm volatile("" : "+v"(fr), "+v"(fq));
        const int sp = u.aux & 2, kh = u.aux & 1, jt = u.aux >> 2;
        const int tidp = (wr * 4 + wc) * 64 + fq * 16 + fr;
        unsigned long long* sbs = (unsigned long long*)(S + (size_t)jt * 65536 + kh * 32768) + (size_t)tidp * 2;
        unsigned long long* sb = (unsigned long long*)(S + (size_t)jt * 65536 + (1 - kh) * 32768) + (size_t)tidp * 2;
        scale(acc, u, sp ? kh * 2 + 1 : 3, false, wr, wc, fr, fq);
        if (sp) { ho_send(acc, sbs, flags + jt * 16 + kh * 8, tidp); ho_wait(flags + jt * 16 + (1 - kh) * 8, tidp); }
        const int col0 = u.ocol + wc * 32 + 8 * fq;
#pragma unroll
        for (int ai = 0; ai < 2; ++ai) {
            if (ai == 1 && sp) break;
#pragma unroll
            for (int m = 0; m < 4; ++m) { const size_t row = (size_t)((ai ? u.orow1 : u.orow0) + wr * 64 + m * 16 + fr);
#pragma unroll
                for (int bj = 0; bj < 2; ++bj) { f32x4 v0 = acc[ai][bj][m][0], v1 = acc[ai][bj][m][1];
                    if (ai == 0 && sp) { v0 += ho_get(sb, m, bj, 0); v1 += ho_get(sb, m, bj, 1); }
                    *(u32x4*)(merged + row * DM + col0 + bj * 128) = pack8(v0, v1); }
                asm volatile("" ::: "memory"); } }
    }
};
}

__device__ __forceinline__ void transpose_item(const float* W, int N, int k0, int n0, bf16_t* D, int ldo, int dn0, int dk0, LAS float* scr, int lane) {
#pragma unroll 8
    for (int i = 0; i < 32; ++i) { const int kk = 2 * i + (lane >> 5); scr[kk * 33 + (lane & 31)] = W[(size_t)(k0 + kk) * N + n0 + (lane & 31)]; }
    LDS_WAIT(); asm volatile("" ::: "memory");
    const int c = lane & 7;
#pragma unroll
    for (int j = 0; j < 4; ++j) { const int n = (lane >> 3) + 8 * j; const LAS float* s = scr + (8 * c) * 33 + n;
        u32x4 o; o.x = cvt_pk_bf16(s[0 * 33], s[1 * 33]); o.y = cvt_pk_bf16(s[2 * 33], s[3 * 33]); o.z = cvt_pk_bf16(s[4 * 33], s[5 * 33]); o.w = cvt_pk_bf16(s[6 * 33], s[7 * 33]);
        *(u32x4*)(D + (size_t)(dn0 + n) * ldo + dk0 + 8 * c) = o; }
    LDS_WAIT(); asm volatile("" ::: "memory");
}

__device__ __forceinline__ void phase_p0(const Args& a, LAS unsigned char* lds, int tid, int lane, int wave, int G, int bid) {
    unsigned char* ws = a.ws;
    LAS float* scr = (LAS float*)(lds + wave * 16384);
    const int gw = bid * 8 + wave, NGW = G * 8;
    if (bid == 0 && tid < 16) ((unsigned*)(ws + O_CTL))[64 * tid] = 0u;
    if (bid == 0 && tid < 32) ((unsigned*)(ws + O_CTL))[1024 + 64 * tid] = 0u;
    constexpr int IT_WIN = 32 * 368, IT_WBR = 32 * 64, IT_WOUT = 32 * 64, IT_W1 = 32 * 256, IT_W2 = 128 * 64, IT_L = IT_WIN + IT_WBR + IT_WOUT + IT_W1 + IT_W2;
    constexpr int IT_CV = 128 * 16;
    for (int it = gw; it < 2 * IT_L + IT_CV; it += NGW) {
        if (it >= 2 * IT_L) {
            const int r = it - 2 * IT_L, mtx = r >> 4, kb = (r >> 1) & 7, nb = r & 1;
            transpose_item(a.in[I_CV] + (size_t)mtx * 512 * 64, 64, kb * 64, nb * 32, (bf16_t*)(ws + O_VTC) + (size_t)mtx * 64 * 512, 512, nb * 32, kb * 64, scr, lane);
            continue;
        }
        const int l = it / IT_L; int r = it % IT_L;
        if (r < IT_WIN) {
            const int kb = r / 368, nb = r % 368, k0 = kb * 64, n0 = nb * 32;
            const float* W = a.in[I_WIN] + (size_t)l * DM * INC;
            if (n0 >= 2560 && n0 < 3072) {
                const int g = (n0 - 2560) >> 7, c0 = (n0 - 2560) & 127;
                bf16_t* D = (bf16_t*)(ws + O_WFN) + ((size_t)(l * 4 + g) * 2048) * 128;
#pragma unroll 8
                for (int i = 0; i < 32; ++i) { const int kk = 2 * i + (lane >> 5); D[(size_t)(k0 + kk) * 128 + c0 + (lane & 31)] = f2bf(W[(size_t)(k0 + kk) * INC + n0 + (lane & 31)]); }
            } else {
                const int dn0 = n0 < 2560 ? n0 : n0 + 512;
                transpose_item(W, INC, k0, n0, (bf16_t*)(ws + O_WINT) + (size_t)l * 12288 * 2048, 2048, dn0, k0, scr, lane);
            }
            continue;
        } r -= IT_WIN;
        if (r < IT_WBR) {
            const int kb = r / 64, nb = r % 64, k0 = kb * 64, n0 = nb * 32;
            const float* W = a.in[I_WBR] + (size_t)l * DM * DM;
            if (k0 < 1536) transpose_item(W, DM, k0, n0, (bf16_t*)(ws + O_WBT) + (size_t)l * DM * DM, 2048, n0, k0, scr, lane);
            else transpose_item(W, DM, k0, n0, (bf16_t*)(ws + O_WBD) + (size_t)l * DM * 512, 512, n0, k0 - 1536, scr, lane);
            continue;
        } r -= IT_WBR;
        if (r < IT_WOUT) { const int kb = r / 64, nb = r % 64; transpose_item(a.in[I_WOUT] + (size_t)l * DM * DM, DM, kb * 64, nb * 32, (bf16_t*)(ws + O_WOT) + (size_t)l * DM * DM, 2048, nb * 32, kb * 64, scr, lane); continue; } r -= IT_WOUT;
        if (r < IT_W1) { const int kb = r / 256, nb = r % 256; transpose_item(a.in[I_W1] + (size_t)l * DM * DFF, DFF, kb * 64, nb * 32, (bf16_t*)(ws + O_W1T) + (size_t)l * DFF * DM, 2048, nb * 32, kb * 64, scr, lane); continue; } r -= IT_W1;
        { const int kb = r / 64, nb = r % 64; transpose_item(a.in[I_W2] + (size_t)l * DFF * DM, DM, kb * 64, nb * 32, (bf16_t*)(ws + O_W2T) + (size_t)l * DM * DFF, 8192, nb * 32, kb * 64, scr, lane); }
    }
    const int gt = bid * 512 + tid, NGT = G * 512;
    for (int i = gt; i < 2 * 512 * 512; i += NGT) {
        const int l = i >> 18, c = (i >> 9) & 511, d = i & 511; float v = 0.f;
        if ((c >> 7) == (d >> 7)) v = a.in[I_WPOOL][(((size_t)l * 4 + (c >> 7)) * 128 + (c & 127)) * 128 + (d & 127)] * a.in[I_PSC][l * 512 + d];
        ((bf16_t*)(ws + O_BDP))[i] = f2bf(v);
    }
    for (int i = gt; i < 256 * 256; i += NGT) {
        const int r = i >> 8, c = i & 255, cp = r & 127; const float t = (float)((cp * c) & 127) * (2.0f / 128.0f);
        ((bf16_t*)(ws + O_CS))[i] = f2bf(c < 128 ? (r < 128 ? cospif(t) : sinpif(t)) * 0.08838834764831845f : 0.f);
    }
    for (int i = gt; i < 256 * 512; i += NGT) {
        const int k = i >> 9, c = i & 511, n = c & 255; const float t = (float)((k * n) & 255) * (2.0f / 256.0f);
        ((bf16_t*)(ws + O_DFT256))[i] = f2bf((c < 256 ? cospif(t) : -sinpif(t)) * 0.0625f);
    }
    for (int i = gt; i < 1024 * 2048; i += NGT) {
        const int k = i >> 11, c = i & 2047, n = c & 1023; const float t = (float)((k * n) & 1023) * (2.0f / 1024.0f);
        ((bf16_t*)(ws + O_DFT1024))[i] = f2bf((c < 1024 ? cospif(t) : -sinpif(t)) * 0.03125f);
    }
    for (int i = gt; i < 2 * 4 * 128 * 128; i += NGT) ((bf16_t*)(ws + O_WSB))[i] = f2bf(a.in[I_WSP][i]);
    for (int i = gt; i < 8 * 2 * 8 * 512 * 64 / 4; i += NGT) { const f32x4 v = ((const f32x4*)a.in[I_CK])[i]; u32x2 w; w.x = cvt_pk_bf16(v[0], v[1]); w.y = cvt_pk_bf16(v[2], v[3]); ((u32x2*)(ws + O_CK))[i] = w; }
    __syncthreads();
    for (int it = gw; it < 2 * 16 * 48; it += NGW) {
        const int l = it / 768, rem = it % 768, dch = rem / 48, cb = rem % 48, j0 = cb * 256 + lane * 4, d0 = dch * 128;
        for (int i = lane; i < NCOND * 128; i += 64) { const int cond = i >> 7, d = i & 127; const float x = cond == 0 ? a.in[I_CCTX][d0 + d] : a.in[I_C][(size_t)(cond - 1) * DM + d0 + d]; scr[i] = x * sigmoidf_(x); }
        LDS_WAIT(); asm volatile("" ::: "memory");
        f32x4 acc[NCOND];
#pragma unroll
        for (int c = 0; c < NCOND; ++c) acc[c] = (f32x4){0.f, 0.f, 0.f, 0.f};
        const float* wp = a.in[I_WADA] + ((size_t)l * DM + d0) * 12288 + j0;
#pragma unroll 4
        for (int d = 0; d < 128; ++d) { const f32x4 w = *(const f32x4*)(wp + (size_t)d * 12288);
#pragma unroll
            for (int c = 0; c < NCOND; ++c) acc[c] += w * scr[c * 128 + d]; }
#pragma unroll
        for (int c = 0; c < NCOND; ++c) *(f32x4*)((float*)(ws + O_MODP) + ((size_t)(dch * 2 + l) * NCOND + c) * 12288 + j0) = acc[c];
        LDS_WAIT(); asm volatile("" ::: "memory");
    }
}

__device__ __forceinline__ void phase_p1_modreduce(const Args& a, int tid, int G, int bid) {
    const int gt = bid * 512 + tid, NGT = G * 512;
    const float* P = (const float*)(a.ws + O_MODP); float* M = (float*)(a.ws + O_MOD);
    for (int i = gt; i < 2 * NCOND * 2048; i += NGT) {
        const int l = i / (NCOND * 2048), cond = (i / 2048) % NCOND, col = i & 2047;
        float m[6];
#pragma unroll
        for (int s = 0; s < 6; ++s) { float v = a.in[I_BADA][l * 12288 + s * 2048 + col];
            for (int dch = 0; dch < 16; ++dch) v += P[((size_t)(dch * 2 + l) * NCOND + cond) * 12288 + s * 2048 + col];
            m[s] = v; }
        float* o = M + ((size_t)(l * NCOND + cond) * 6) * 2048 + col;
        o[0] = a.in[I_N1G][l * 2048 + col] * (1.f + m[1]); o[2048] = m[0]; o[2 * 2048] = m[2];
        o[3 * 2048] = a.in[I_N2G][l * 2048 + col] * (1.f + m[4]); o[4 * 2048] = m[3]; o[5 * 2048] = m[5];
    }
}

__device__ __forceinline__ void phase_norm(const Args& a, int l, int which, bool from_input, int lane, int wave, int G, int bid) {
    const int gw = bid * 8 + wave, NGW = G * 8;
    bf16_t* H = (bf16_t*)(a.ws + O_H);
    const int chunk = (NTOK + NGW - 1) / NGW;
    int row = gw * chunk; const int rend = (row + chunk) < NTOK ? (row + chunk) : NTOK;
    if (row >= rend) return;
#define NORM_XPTR(r) (from_input ? ((r) < NCTXT ? a.in[I_XP] + (size_t)(r) * DM : a.in[I_XS] + (size_t)((r) - NCTXT) * DM) : a.out + (size_t)(r) * DM)
    f32x4 v[8], av[8], sv[8]; int ccond = -1;
    { const float* xr = NORM_XPTR(row);
#pragma unroll
      for (int j = 0; j < 8; ++j) v[j] = *(const f32x4*)(xr + j * 256 + lane * 4); }
    for (; row < rend; ++row) {
        f32x4 vn[8];
        if (row + 1 < rend) { const float* xr = NORM_XPTR(row + 1);
#pragma unroll
            for (int j = 0; j < 8; ++j) vn[j] = *(const f32x4*)(xr + j * 256 + lane * 4); }
        const int cond = row < NCTXT ? 0 : 1 + ((row - NCTXT) >> 10);
        if (cond != ccond) { ccond = cond; const float* ap = (const float*)(a.ws + O_MOD) + ((size_t)(l * NCOND + cond) * 6 + which) * 2048;
#pragma unroll
            for (int j = 0; j < 8; ++j) { av[j] = *(const f32x4*)(ap + j * 256 + lane * 4); sv[j] = *(const f32x4*)(ap + 2048 + j * 256 + lane * 4); } }
        float s = 0.f;
#pragma unroll
        for (int j = 0; j < 8; ++j) s += (v[j][0] * v[j][0] + v[j][1] * v[j][1]) + (v[j][2] * v[j][2] + v[j][3] * v[j][3]);
        const float r = rsqrtf(wave_sum(s) * (1.0f / DM) + 1e-6f);
#pragma unroll
        for (int j = 0; j < 8; ++j) { const f32x4 o = v[j] * r * av[j] + sv[j]; u32x2 w; w.x = cvt_pk_bf16(o[0], o[1]); w.y = cvt_pk_bf16(o[2], o[3]);
            *(u32x2*)(H + (size_t)row * DM + j * 256 + lane * 4) = w; }
#pragma unroll
        for (int j = 0; j < 8; ++j) v[j] = vn[j];
    }
#undef NORM_XPTR
}

template <bool SCALE>
__device__ __forceinline__ void transpose128(const bf16_t* src, int ld_src, bf16_t* dst, int ld_dst, LAS unsigned char* lds, int tid, const LAS float* rtab, const float* gvec) {
    LAS bf16_t* T = (LAS bf16_t*)lds;
#pragma unroll
    for (int j = 0; j < 4; ++j) { const int ch = tid + j * 512, row = ch >> 4, cc = ch & 15;
        u32x4 v = *(const u32x4*)(src + (size_t)row * ld_src + cc * 8);
        if (SCALE) { const float r = rtab[row]; const f32x4 g0 = *(const f32x4*)(gvec + cc * 8), g1 = *(const f32x4*)(gvec + cc * 8 + 4);
            v.x = cvt_pk_bf16(bflo(v.x) * r * g0[0], bfhi(v.x) * r * g0[1]); v.y = cvt_pk_bf16(bflo(v.y) * r * g0[2], bfhi(v.y) * r * g0[3]);
            v.z = cvt_pk_bf16(bflo(v.z) * r * g1[0], bfhi(v.z) * r * g1[1]); v.w = cvt_pk_bf16(bflo(v.w) * r * g1[2], bfhi(v.w) * r * g1[3]); }
        *(LAS u32x4*)(T + row * 136 + cc * 8) = v; }
    __syncthreads();
#pragma unroll
    for (int j = 0; j < 4; ++j) { const int ch = tid + j * 512, c = ch & 127, qc = ch >> 7;
        unsigned short e[8];
#pragma unroll
        for (int k = 0; k < 8; ++k) e[k] = T[(qc * 8 + k) * 136 + c];
        u32x4 o; o.x = e[0] | ((unsigned)e[1] << 16); o.y = e[2] | ((unsigned)e[3] << 16); o.z = e[4] | ((unsigned)e[5] << 16); o.w = e[6] | ((unsigned)e[7] << 16);
        *(u32x4*)(dst + (size_t)c * ld_dst + qc * 8) = o; }
    __syncthreads();
}

template <int W>
__device__ __forceinline__ void pool_rows(const bf16_t* base, bf16_t* outp, int pos0, int npos, int tl0, int tsub) {
#pragma unroll 2
    for (int it = 0; it < 16; ++it) {
        const int tl = tl0 + it * 4 + tsub, pos = pos0 + tl;
        int lo = pos - (W >> 1); if (lo < 0) lo = 0; int hi = pos + (W >> 1) - 1; if (hi > npos - 1) hi = npos - 1;
        u32x4 x[W];
#pragma unroll
        for (int j = 0; j < W; ++j) { int p = pos - (W >> 1) + j; p = p < lo ? lo : (p > hi ? hi : p); x[j] = *(const u32x4*)(base + (size_t)p * 4096); }
        float s[8] = {0.f, 0.f, 0.f, 0.f, 0.f, 0.f, 0.f, 0.f};
#pragma unroll
        for (int j = 0; j < W; ++j) { const int p = pos - (W >> 1) + j; const float wgt = (p >= lo && p <= hi) ? 1.f : 0.f;
            s[0] += wgt * bflo(x[j].x); s[1] += wgt * bfhi(x[j].x); s[2] += wgt * bflo(x[j].y); s[3] += wgt * bfhi(x[j].y);
            s[4] += wgt * bflo(x[j].z); s[5] += wgt * bfhi(x[j].z); s[6] += wgt * bflo(x[j].w); s[7] += wgt * bfhi(x[j].w); }
        const u32x4 xc = x[W >> 1]; const float inv = 1.0f / (float)(hi - lo + 1);
        u32x4 o; o.x = cvt_pk_bf16(s[0] * inv - bflo(xc.x), s[1] * inv - bfhi(xc.x)); o.y = cvt_pk_bf16(s[2] * inv - bflo(xc.y), s[3] * inv - bfhi(xc.y));
        o.z = cvt_pk_bf16(s[4] * inv - bflo(xc.z), s[5] * inv - bfhi(xc.z)); o.w = cvt_pk_bf16(s[6] * inv - bflo(xc.w), s[7] * inv - bfhi(xc.w));
        *(u32x4*)(outp + (size_t)tl * 2048) = o;
    }
}

__device__ __forceinline__ void phase_prep(const Args& a, int l, LAS unsigned char* lds, int tid, int lane, int wave, int G, int bid) {
    unsigned char* ws = a.ws;
    const bf16_t* Zm = (const bf16_t*)(ws + O_ZM);
    unsigned* qctr = (unsigned*)(ws + O_CTL) + 64 * (8 + l);
    LAS int* qslot = (LAS int*)(lds + 131072 + 128);
    for (;;) {
        __syncthreads();
        if (tid == 0) *qslot = (int)atomicAdd(qctr, 1u);
        __syncthreads();
        const int qi = *qslot; if (qi >= 96 * 6) break;
        const int ord = qi / 96, tt = qi % 96; const int task = ord == 0 ? 0 : (ord == 1 ? 5 : ord - 1);
        const bool ctx = tt < 32; const int bb = ctx ? (tt >> 1) : ((tt - 32) >> 3); const int pos0 = ctx ? (tt & 1) * 128 : ((tt - 32) & 7) * 128; const int npos = ctx ? 256 : 1024;
        const int tok0 = tt * 128;
        if (task == 0) {
            const int j = lane & 7, hd = lane >> 3;
            const f32x4 gq0 = *(const f32x4*)(a.in[I_QNG] + l * 64 + j * 8), gq1 = *(const f32x4*)(a.in[I_QNG] + l * 64 + j * 8 + 4);
            const f32x4 gk0 = *(const f32x4*)(a.in[I_KNG] + l * 64 + j * 8), gk1 = *(const f32x4*)(a.in[I_KNG] + l * 64 + j * 8 + 4);
            const int ax = j >> 2; const bool isx2 = (j & 2) != 0; const int i0 = (j & 1) * 8;
            float invf[8];
#pragma unroll
            for (int e = 0; e < 8; ++e) invf[e] = __builtin_amdgcn_exp2f(-(float)(i0 + e) * (13.287712379549449f / 16.0f));
#pragma unroll 1
            for (int tb = 0; tb < 4; ++tb) {
                u32x4 qw4[4], kw4[4];
#pragma unroll
                for (int u = 0; u < 4; ++u) { const int tok = tok0 + wave * 16 + tb * 4 + u; qw4[u] = *(const u32x4*)(Zm + (size_t)tok * 4096 + lane * 8); kw4[u] = *(const u32x4*)(Zm + (size_t)tok * 4096 + 512 + lane * 8); }
#pragma unroll
                for (int u = 0; u < 4; ++u) {
                    const int tl = wave * 16 + tb * 4 + u, tok = tok0 + tl, pos = pos0 + tl;
                    const u32x4 qw = qw4[u], kw = kw4[u];
                    float q[8] = {bflo(qw.x), bfhi(qw.x), bflo(qw.y), bfhi(qw.y), bflo(qw.z), bfhi(qw.z), bflo(qw.w), bfhi(qw.w)};
                    float k[8] = {bflo(kw.x), bfhi(kw.x), bflo(kw.y), bfhi(kw.y), bflo(kw.z), bfhi(kw.z), bflo(kw.w), bfhi(kw.w)};
                    float sq = 0.f, sk = 0.f;
#pragma unroll
                    for (int e = 0; e < 8; ++e) { sq += q[e] * q[e]; sk += k[e] * k[e]; }
                    sq += __shfl_xor(sq, 1); sq += __shfl_xor(sq, 2); sq += __shfl_xor(sq, 4);
                    sk += __shfl_xor(sk, 1); sk += __shfl_xor(sk, 2); sk += __shfl_xor(sk, 4);
                    const float rq = rsqrtf(sq * (1.f / 64.f) + 1e-6f), rk = rsqrtf(sk * (1.f / 64.f) + 1e-6f);
#pragma unroll
                    for (int e = 0; e < 8; ++e) { q[e] *= rq * (e < 4 ? gq0[e & 3] : gq1[e & 3]); k[e] *= rk * (e < 4 ? gk0[e & 3] : gk1[e & 3]); }
                    { u32x4 o; o.x = cvt_pk_bf16(q[0] * 0.125f, q[1] * 0.125f); o.y = cvt_pk_bf16(q[2] * 0.125f, q[3] * 0.125f); o.z = cvt_pk_bf16(q[4] * 0.125f, q[5] * 0.125f); o.w = cvt_pk_bf16(q[6] * 0.125f, q[7] * 0.125f);
                      *(u32x4*)((bf16_t*)(ws + O_QP) + (size_t)tok * 512 + lane * 8) = o; }
                    if (ctx) {
                        u32x4 o; o.x = cvt_pk_bf16(k[0], k[1]); o.y = cvt_pk_bf16(k[2], k[3]); o.z = cvt_pk_bf16(k[4], k[5]); o.w = cvt_pk_bf16(k[6], k[7]);
                        *(u32x4*)((bf16_t*)(ws + O_KB) + (size_t)tok * 512 + lane * 8) = o;
                        float* ok = a.out + OUTK + ((((size_t)bb * 2 + l) * 8 + hd) * 256 + pos) * 64 + j * 8;
                        *(f32x4*)ok = (f32x4){k[0], k[1], k[2], k[3]}; *(f32x4*)(ok + 4) = (f32x4){k[4], k[5], k[6], k[7]};
                    } else {
                        const float p = (float)(ax == 0 ? (pos >> 6) : (pos & 63));
                        float qr[8], kr[8];
#pragma unroll
                        for (int e = 0; e < 8; ++e) {
                            const float ang = p * invf[e]; const float cs = __cosf(ang), sn = __sinf(ang);
                            const float pq = __shfl_xor(q[e], 2), pk = __shfl_xor(k[e], 2);
                            qr[e] = q[e] * cs + (isx2 ? pq : -pq) * sn; kr[e] = k[e] * cs + (isx2 ? pk : -pk) * sn;
                        }
                        u32x4 o; o.x = cvt_pk_bf16(qr[0] * 0.125f, qr[1] * 0.125f); o.y = cvt_pk_bf16(qr[2] * 0.125f, qr[3] * 0.125f); o.z = cvt_pk_bf16(qr[4] * 0.125f, qr[5] * 0.125f); o.w = cvt_pk_bf16(qr[6] * 0.125f, qr[7] * 0.125f);
                        *(u32x4*)((bf16_t*)(ws + O_QR) + (size_t)(tok - NCTXT) * 512 + lane * 8) = o;
                        u32x4 o2; o2.x = cvt_pk_bf16(kr[0], kr[1]); o2.y = cvt_pk_bf16(kr[2], kr[3]); o2.z = cvt_pk_bf16(kr[4], kr[5]); o2.w = cvt_pk_bf16(kr[6], kr[7]);
                        *(u32x4*)((bf16_t*)(ws + O_KB) + (size_t)tok * 512 + lane * 8) = o2;
                    }
                }
            }
        } else if (task == 1) {
            bf16_t* vt = (bf16_t*)(ws + O_VT) + (ctx ? (size_t)bb * 512 * 256 : (size_t)16 * 512 * 256 + (size_t)bb * 512 * 1024) + pos0;
            if (ctx) {
                const int j = lane & 7, hd = lane >> 3;
#pragma unroll 1
                for (int tb = 0; tb < 2; ++tb) {
                    u32x4 w8[8];
#pragma unroll
                    for (int u = 0; u < 8; ++u) w8[u] = *(const u32x4*)(Zm + (size_t)(tok0 + wave * 16 + tb * 8 + u) * 4096 + 1024 + lane * 8);
#pragma unroll
                    for (int u = 0; u < 8; ++u) { const int pos = pos0 + wave * 16 + tb * 8 + u; const u32x4 w = w8[u];
                        float* ov = a.out + OUTV + ((((size_t)bb * 2 + l) * 8 + hd) * 256 + pos) * 64 + j * 8;
                        *(f32x4*)ov = (f32x4){bflo(w.x), bfhi(w.x), bflo(w.y), bfhi(w.y)}; *(f32x4*)(ov + 4) = (f32x4){bflo(w.z), bfhi(w.z), bflo(w.w), bfhi(w.w)}; }
                }
            }
            for (int sub = 0; sub < 4; ++sub)
                transpose128<false>(Zm + (size_t)tok0 * 4096 + 1024 + sub * 128, 4096, vt + (size_t)sub * 128 * npos, npos, lds, tid, nullptr, nullptr);
        } else if (task == 2) {
            LAS float* rtab = (LAS float*)(lds + 40960);
#pragma unroll 1
            for (int tb = 0; tb < 2; ++tb) {
                u32x4 w8[8];
#pragma unroll
                for (int u = 0; u < 8; ++u) w8[u] = *(const u32x4*)(Zm + (size_t)(tok0 + wave * 16 + tb * 8 + u) * 4096 + 2048 + lane * 8);
#pragma unroll
                for (int u = 0; u < 8; ++u) { const u32x4 w = w8[u];
                    float s = bflo(w.x) * bflo(w.x) + bfhi(w.x) * bfhi(w.x) + bflo(w.y) * bflo(w.y) + bfhi(w.y) * bfhi(w.y) + bflo(w.z) * bflo(w.z) + bfhi(w.z) * bfhi(w.z) + bflo(w.w) * bflo(w.w) + bfhi(w.w) * bfhi(w.w);
                    s = wave_sum(s); if (lane == 0) rtab[wave * 16 + tb * 8 + u] = rsqrtf(s * (1.f / 512.f) + 1e-6f); }
            }
            __syncthreads();
            for (int sub = 0; sub < 4; ++sub)
                transpose128<true>(Zm + (size_t)tok0 * 4096 + 2048 + sub * 128, 4096, (bf16_t*)(ws + O_VNT) + ((size_t)tt * 512 + sub * 128) * 128, 128, lds, tid, rtab, a.in[I_GNG] + l * 512 + sub * 128);
        } else if (task == 3 || task == 4) {
            const int part = task - 3;
            bf16_t* tb = (bf16_t*)(ws + O_TT) + (ctx ? (size_t)bb * 512 * 512 : (size_t)16 * 512 * 512 + (size_t)bb * 512 * 2048) + part * npos + pos0;
            for (int sub = 0; sub < 4; ++sub)
                transpose128<false>(Zm + (size_t)tok0 * 4096 + 2560 + part * 512 + sub * 128, 4096, tb + (size_t)sub * 128 * 2 * npos, 2 * npos, lds, tid, nullptr, nullptr);
        } else {
            const int gi = wave & 3, half = wave >> 2, tsub = lane >> 4, c8 = gi * 16 + (lane & 15);
            const bf16_t* base = Zm + (size_t)(tok0 - pos0) * 4096 + 3584 + c8 * 8;
            bf16_t* outp = (bf16_t*)(ws + O_BR) + (size_t)tok0 * 2048 + 1536 + c8 * 8;
            if (gi == 0) pool_rows<2>(base, outp, pos0, npos, half * 64, tsub);
            else if (gi == 1) pool_rows<4>(base, outp, pos0, npos, half * 64, tsub);
            else if (gi == 2) pool_rows<8>(base, outp, pos0, npos, half * 64, tsub);
            else pool_rows<16>(base, outp, pos0, npos, half * 64, tsub);
        }
    }
}

#define MFMA16(a, b, c) __builtin_amdgcn_mfma_f32_16x16x32_bf16(a, b, c, 0, 0, 0)
struct KVF { bf16x8 k[4]; bf16x8 v[4]; };
struct KVOff { unsigned k0, k1, v[4]; };
__device__ __forceinline__ KVOff kv_off(int ldk, int ldv, int lane) {
    const int i = lane & 15, g = lane >> 4; const int ko0 = 8 * (i >> 2) + (i & 3);
    KVOff o; o.k0 = (unsigned)(ko0 * ldk + 8 * g) * 2u; o.k1 = o.k0 + (unsigned)(4 * ldk) * 2u;
#pragma unroll
    for (int dt = 0; dt < 4; ++dt) o.v[dt] = (unsigned)((16 * dt + i) * ldv + 8 * g) * 2u;
    return o;
}
__device__ __forceinline__ void kv_load(KVF& f, const bf16_t* kp, const bf16_t* vp, const KVOff& o) {
    const char* kc = (const char*)kp; const char* vc = (const char*)vp;
    f.k[0] = *(const bf16x8*)(kc + o.k0); f.k[1] = *(const bf16x8*)(kc + o.k0 + 64); f.k[2] = *(const bf16x8*)(kc + o.k1); f.k[3] = *(const bf16x8*)(kc + o.k1 + 64);
#pragma unroll
    for (int dt = 0; dt < 4; ++dt) f.v[dt] = *(const bf16x8*)(vc + o.v[dt]);
}
struct QSt { f32x4 o[4]; float m, lsum; };
__device__ __forceinline__ void attn_step(const KVF& f, const bf16x8 (&qf)[2], const float (&sb)[8], bool use_sb, QSt& st) {
    f32x4 s0 = {0.f, 0.f, 0.f, 0.f}, s1 = {0.f, 0.f, 0.f, 0.f};
    s0 = MFMA16(f.k[0], qf[0], s0); s0 = MFMA16(f.k[1], qf[1], s0);
    s1 = MFMA16(f.k[2], qf[0], s1); s1 = MFMA16(f.k[3], qf[1], s1);
    float s[8] = {s0[0], s0[1], s0[2], s0[3], s1[0], s1[1], s1[2], s1[3]};
    if (use_sb) {
#pragma unroll
        for (int e = 0; e < 8; ++e) s[e] = sb[e] < -1e29f ? -3e30f : s[e] + sb[e];
    }
    float mx = fmaxf(fmaxf(fmaxf(s[0], s[1]), fmaxf(s[2], s[3])), fmaxf(fmaxf(s[4], s[5]), fmaxf(s[6], s[7])));
    mx = fmaxf(mx, __shfl_xor(mx, 16)); mx = fmaxf(mx, __shfl_xor(mx, 32));
    const float mn = fmaxf(st.m, mx); const float alpha = fast_exp(st.m - mn); st.m = mn;
    float ps = 0.f;
#pragma unroll
    for (int e = 0; e < 8; ++e) { s[e] = fast_exp(s[e] - mn); ps += s[e]; }
    st.lsum = st.lsum * alpha + ps;
#pragma unroll
    for (int dt = 0; dt < 4; ++dt) st.o[dt] *= alpha;
    u32x4 pw; pw.x = cvt_pk_bf16(s[0], s[1]); pw.y = cvt_pk_bf16(s[2], s[3]); pw.z = cvt_pk_bf16(s[4], s[5]); pw.w = cvt_pk_bf16(s[6], s[7]);
    const bf16x8 pf = __builtin_bit_cast(bf16x8, pw);
#pragma unroll
    for (int dt = 0; dt < 4; ++dt) st.o[dt] = MFMA16(f.v[dt], pf, st.o[dt]);
}
__device__ __forceinline__ void attn_step2(const KVF& f0, const KVF& f1, const bf16x8 (&qf)[2], QSt& st) {
    f32x4 s0 = {0.f, 0.f, 0.f, 0.f}, s1 = {0.f, 0.f, 0.f, 0.f}, s2 = {0.f, 0.f, 0.f, 0.f}, s3 = {0.f, 0.f, 0.f, 0.f};
    s0 = MFMA16(f0.k[0], qf[0], s0); s1 = MFMA16(f0.k[2], qf[0], s1); s2 = MFMA16(f1.k[0], qf[0], s2); s3 = MFMA16(f1.k[2], qf[0], s3);
    s0 = MFMA16(f0.k[1], qf[1], s0); s1 = MFMA16(f0.k[3], qf[1], s1); s2 = MFMA16(f1.k[1], qf[1], s2); s3 = MFMA16(f1.k[3], qf[1], s3);
    float s[16] = {s0[0], s0[1], s0[2], s0[3], s1[0], s1[1], s1[2], s1[3], s2[0], s2[1], s2[2], s2[3], s3[0], s3[1], s3[2], s3[3]};
    float mx = fmaxf(fmaxf(fmaxf(s[0], s[1]), fmaxf(s[2], s[3])), fmaxf(fmaxf(s[4], s[5]), fmaxf(s[6], s[7])));
    mx = fmaxf(mx, fmaxf(fmaxf(fmaxf(s[8], s[9]), fmaxf(s[10], s[11])), fmaxf(fmaxf(s[12], s[13]), fmaxf(s[14], s[15]))));
    mx = fmaxf(mx, __shfl_xor(mx, 16)); mx = fmaxf(mx, __shfl_xor(mx, 32));
    const float mn = fmaxf(st.m, mx); const float alpha = fast_exp(st.m - mn); st.m = mn;
    float ps = 0.f;
#pragma unroll
    for (int e = 0; e < 16; ++e) { s[e] = fast_exp(s[e] - mn); ps += s[e]; }
    st.lsum = st.lsum * alpha + ps;
#pragma unroll
    for (int dt = 0; dt < 4; ++dt) st.o[dt] *= alpha;
    u32x4 pw0, pw1; pw0.x = cvt_pk_bf16(s[0], s[1]); pw0.y = cvt_pk_bf16(s[2], s[3]); pw0.z = cvt_pk_bf16(s[4], s[5]); pw0.w = cvt_pk_bf16(s[6], s[7]);
    pw1.x = cvt_pk_bf16(s[8], s[9]); pw1.y = cvt_pk_bf16(s[10], s[11]); pw1.z = cvt_pk_bf16(s[12], s[13]); pw1.w = cvt_pk_bf16(s[14], s[15]);
    const bf16x8 pf0 = __builtin_bit_cast(bf16x8, pw0), pf1 = __builtin_bit_cast(bf16x8, pw1);
#pragma unroll
    for (int dt = 0; dt < 4; ++dt) { st.o[dt] = MFMA16(f0.v[dt], pf0, st.o[dt]); st.o[dt] = MFMA16(f1.v[dt], pf1, st.o[dt]); }
}
__device__ __forceinline__ void attn_store(const QSt& st0, bf16_t* op) {
    QSt st = st0; st.lsum += __shfl_xor(st.lsum, 16); st.lsum += __shfl_xor(st.lsum, 32);
    const float inv = 1.0f / st.lsum;
#pragma unroll
    for (int dt = 0; dt < 4; ++dt) { u32x2 w2; w2.x = cvt_pk_bf16(st.o[dt][0] * inv, st.o[dt][1] * inv); w2.y = cvt_pk_bf16(st.o[dt][2] * inv, st.o[dt][3] * inv); *(u32x2*)(op + 16 * dt) = w2; }
}
__device__ __forceinline__ void local_bias(float (&sb)[8], const LAS float* tab, int dr, int kc0, int g, int cq, int cs) {
    asm volatile("" : "+v"(g));
#pragma unroll
    for (int e = 0; e < 8; ++e) { const int kc = kc0 + 8 * g + e; const bool vis = (kc >= cs) && (kc < cs + 16);
        const float bv = tab[dr * 32 + (vis ? (kc - cq + 15) : 15)]; sb[e] = vis ? bv : -1e30f; }
}

__device__ __forceinline__ void attn_item(const Args& a, int l, int item, int lane, LAS float* tab) {
    unsigned char* ws = a.ws;
    const int q = lane & 15, g = lane >> 4;
    QSt sA, sB;
#pragma unroll
    for (int dt = 0; dt < 4; ++dt) { sA.o[dt] = (f32x4){0.f, 0.f, 0.f, 0.f}; sB.o[dt] = (f32x4){0.f, 0.f, 0.f, 0.f}; }
    sA.m = -1e30f; sA.lsum = 0.f; sB.m = -1e30f; sB.lsum = 0.f;
    float nb0[8];
    int tokq, h;
    if (item < 2048) {
        const int bb = item >> 8; h = (item >> 5) & 7; const int r = (item >> 1) & 15, p = item & 1;
        tokq = NCTXT + bb * 1024 + r * 64 + 32 * p + q;
        bf16x8 qA[2], qB[2];
        { const bf16_t* pp = (const bf16_t*)(ws + O_QP) + (size_t)tokq * 512 + h * 64 + 8 * g; qA[0] = *(const bf16x8*)pp; qA[1] = *(const bf16x8*)(pp + 32); qB[0] = *(const bf16x8*)(pp + 16 * 512); qB[1] = *(const bf16x8*)(pp + 16 * 512 + 32); }
        const bf16_t* ck = (const bf16_t*)(ws + O_CK) + (((size_t)bb * 2 + l) * 8 + h) * 512 * 64;
        const bf16_t* cv = (const bf16_t*)(ws + O_VTC) + (((size_t)bb * 2 + l) * 8 + h) * 64 * 512;
        int rs = r - 4; if (rs < 0) rs = 0; if (rs > 8) rs = 8;
        const int cqA = 32 * p + q, cqB = cqA + 16; int csA = cqA - 8; if (csA < 0) csA = 0; if (csA > 48) csA = 48; int csB = cqB - 8; if (csB < 0) csB = 0; if (csB > 48) csB = 48;
        { const float* rpb = a.in[I_RPB] + (size_t)(l * 8 + h) * 15 * 31;
          float tv[8];
#pragma unroll
          for (int u = 0; u < 8; ++u) { const int i = lane + 64 * u; tv[u] = i < 465 ? rpb[i] : 0.f; }
#pragma unroll
          for (int u = 0; u < 8; ++u) { const int i = lane + 64 * u; if (i < 465) { const int rr = (i * 2115) >> 16; tab[rr * 32 + (i - rr * 31)] = tv[u]; } } }
        const bf16_t* kl = (const bf16_t*)(ws + O_KB) + (size_t)(NCTXT + bb * 1024) * 512 + h * 64;
        const bf16_t* vl = (const bf16_t*)(ws + O_VT) + (size_t)16 * 512 * 256 + ((size_t)bb * 512 + h * 64) * 1024;
        KVF f0, f1; KVOff oc = kv_off(64, 512, lane);
#pragma unroll 1
        for (int kb = 0; kb < 16; kb += 2) {
            kv_load(f0, ck + (size_t)kb * 32 * 64, cv + kb * 32, oc);
            kv_load(f1, ck + (size_t)(kb + 1) * 32 * 64, cv + (kb + 1) * 32, oc);
            attn_step2(f0, f1, qA, sA); attn_step2(f0, f1, qB, sB);
        }
        { const bf16_t* p2 = (const bf16_t*)(ws + O_QR) + (size_t)(tokq - NCTXT) * 512 + h * 64 + 8 * g; qA[0] = *(const bf16x8*)p2; qA[1] = *(const bf16x8*)(p2 + 32); qB[0] = *(const bf16x8*)(p2 + 16 * 512); qB[1] = *(const bf16x8*)(p2 + 16 * 512 + 32); }
        oc = kv_off(512, 1024, lane);
        const int kcA = (32 * p - 8) < 0 ? 0 : (32 * p - 8), kcB = (32 * p + 8) > 32 ? 32 : (32 * p + 8);
#pragma unroll 1
        for (int wi = 0; wi < 8; ++wi) {
            const int dr = rs + wi - r + 7; const int key0 = (rs + wi) * 64;
            kv_load(f0, kl + (size_t)(key0 + kcA) * 512, vl + key0 + kcA, oc);
            kv_load(f1, kl + (size_t)(key0 + kcB) * 512, vl + key0 + kcB, oc);
            local_bias(nb0, tab, dr, kcA, g, cqA, csA); attn_step(f0, qA, nb0, true, sA);
            local_bias(nb0, tab, dr, kcB, g, cqB, csB); attn_step(f1, qB, nb0, true, sB);
        }
    } else {
        const int it = item - 2048; const int bb = it >> 6; h = (it >> 3) & 7; const int qb = it & 7;
        tokq = bb * 256 + qb * 32 + q;
        bf16x8 qpA[2], qpB[2];
        { const bf16_t* pp = (const bf16_t*)(ws + O_QP) + (size_t)tokq * 512 + h * 64 + 8 * g; qpA[0] = *(const bf16x8*)pp; qpA[1] = *(const bf16x8*)(pp + 32); qpB[0] = *(const bf16x8*)(pp + 16 * 512); qpB[1] = *(const bf16x8*)(pp + 16 * 512 + 32); }
        const bf16_t* kl = (const bf16_t*)(ws + O_KB) + (size_t)(bb * 256) * 512 + h * 64;
        const bf16_t* vl = (const bf16_t*)(ws + O_VT) + ((size_t)bb * 512 + h * 64) * 256;
        KVF f0, f1; const KVOff oc = kv_off(512, 256, lane);
#pragma unroll 1
        for (int kb = 0; kb < 8; kb += 2) {
            kv_load(f0, kl + (size_t)kb * 32 * 512, vl + kb * 32, oc);
            kv_load(f1, kl + (size_t)(kb + 1) * 32 * 512, vl + (kb + 1) * 32, oc);
            attn_step2(f0, f1, qpA, sA); attn_step2(f0, f1, qpB, sB);
        }
    }
    bf16_t* op = (bf16_t*)(ws + O_BR) + (size_t)tokq * 2048 + h * 64 + 4 * g;
    attn_store(sA, op); attn_store(sB, op + (size_t)16 * 2048);
}

__device__ __forceinline__ void gmlp_item(const Args& a, int l, int item, int lane) {
    unsigned char* ws = a.ws;
    const int tt = item >> 4, gg = (item >> 2) & 3, pb = item & 3;
    const int i = lane & 15, g = lane >> 4;
    const bf16_t* A = (const bf16_t*)(ws + O_VNT) + ((size_t)tt * 512 + gg * 128) * 128;
    const bf16_t* B = (const bf16_t*)(ws + O_WSB) + ((size_t)(l * 4 + gg) * 128 + pb * 32) * 128;
    f32x4 acc[8][2];
#pragma unroll
    for (int mi = 0; mi < 8; ++mi) { acc[mi][0] = (f32x4){0.f, 0.f, 0.f, 0.f}; acc[mi][1] = (f32x4){0.f, 0.f, 0.f, 0.f}; }
    const unsigned offA = (unsigned)(i * 128 + 8 * g) * 2u, offB = offA;
    const char* Ac = (const char*)A; const char* Bc = (const char*)B;
#define GM_LOAD(af, b0, b1, ks) do { b0 = *(const bf16x8*)(Bc + offB + (ks) * 64); b1 = *(const bf16x8*)(Bc + offB + 16 * 256 + (ks) * 64); \
        _Pragma("unroll") for (int mi = 0; mi < 8; ++mi) af[mi] = *(const bf16x8*)(Ac + offA + mi * 16 * 256 + (ks) * 64); } while (0)
#define GM_MMA(af, b0, b1) do { _Pragma("unroll") for (int mi = 0; mi < 8; ++mi) { acc[mi][0] = MFMA16(af[mi], b0, acc[mi][0]); acc[mi][1] = MFMA16(af[mi], b1, acc[mi][1]); } } while (0)
    bf16x8 afA[8], afB[8], bA0, bA1, bB0, bB1;
    GM_LOAD(afA, bA0, bA1, 0);
    GM_LOAD(afB, bB0, bB1, 1);
    GM_MMA(afA, bA0, bA1);
    GM_LOAD(afA, bA0, bA1, 2);
    GM_MMA(afB, bB0, bB1);
    GM_LOAD(afB, bB0, bB1, 3);
    GM_MMA(afA, bA0, bA1);
    GM_MMA(afB, bB0, bB1);
#undef GM_LOAD
#undef GM_MMA
    const bf16_t* Zm = (const bf16_t*)(ws + O_ZM);
#pragma unroll
    for (int nj = 0; nj < 2; ++nj) { const int p = pb * 32 + 16 * nj + i; const int tok = tt * 128 + p; const float bs = a.in[I_BSP][(l * 4 + gg) * 128 + p];
        u32x2 uw[8];
#pragma unroll
        for (int mi = 0; mi < 8; ++mi) uw[mi] = *(const u32x2*)(Zm + (size_t)tok * 4096 + 1536 + gg * 128 + 16 * mi + 4 * g);
#pragma unroll
        for (int mi = 0; mi < 8; ++mi) { const int c = gg * 128 + 16 * mi + 4 * g; const f32x4 v = acc[mi][nj];
            u32x2 ow; ow.x = cvt_pk_bf16(bflo(uw[mi].x) * (v[0] + bs), bfhi(uw[mi].x) * (v[1] + bs)); ow.y = cvt_pk_bf16(bflo(uw[mi].y) * (v[2] + bs), bfhi(uw[mi].y) * (v[3] + bs));
            *(u32x2*)((bf16_t*)(ws + O_BR) + (size_t)tok * 2048 + 512 + c) = ow; } }
}

#define XB_TMO      128
#define XB_XCNT(j)  (256  + 64 * (j))
#define XB_XSUB(j)  (1280 + 64 * (j))
#define XB_XGEN(j)  (2304 + 64 * (j))
#define XB_TOP      3328
#define XB_TOPGEN   3392
#define XCD_BAR_WORDS 3456
#define XB_SPIN_CAP (1u << 22)
constexpr int CW_BAR = 4096, CW_FLAG = 8192;
__device__ __forceinline__ unsigned xb_ld(unsigned* p)              { return __hip_atomic_load(p, __ATOMIC_RELAXED, __HIP_MEMORY_SCOPE_AGENT); }
__device__ __forceinline__ unsigned xb_add(unsigned* p, unsigned v) { return __hip_atomic_fetch_add(p, v, __ATOMIC_RELAXED, __HIP_MEMORY_SCOPE_AGENT); }
__device__ __forceinline__ unsigned xb_xcc_id() { return (unsigned)__builtin_amdgcn_s_getreg((3 << 11) | 20) & 0xFu; }
#define XB_SPIN(cond, bar) do { unsigned _sp = 0; while (cond) { __builtin_amdgcn_s_sleep(1); \
    if ((++_sp & 255u) == 0u) { if (xb_ld(&(bar)[XB_TMO])) break; if (_sp > XB_SPIN_CAP) { atomicAdd(&(bar)[XB_TMO], 1u); break; } } } } while (0)
struct XcdBarrier { unsigned* bar; unsigned x; volatile LAS unsigned* st; };
__device__ __forceinline__ XcdBarrier xcd_barrier_post(unsigned* bar, volatile LAS unsigned* st) {
    XcdBarrier b; b.bar = bar; b.x = xb_xcc_id(); b.st = st;
    if (threadIdx.x == 0) (void)xb_add(&bar[XB_XCNT(b.x)], 1u);
    return b;
}
__device__ __forceinline__ void xcd_barrier_complete(unsigned* bar, unsigned x, unsigned& nloc, unsigned& nx) {
    const unsigned G = gridDim.x * gridDim.y * gridDim.z;
    unsigned sum, cnt, mine, sp = 0u;
    for (;;) {
        sum = 0u; cnt = 0u; mine = 0u;
#pragma unroll
        for (unsigned j = 0; j < 16; ++j) { const unsigned c = xb_ld(&bar[XB_XCNT(j)]); sum += c; cnt += (c > 0u) ? 1u : 0u; mine = (j == x) ? c : mine; }
        if (sum == G) break;
        __builtin_amdgcn_s_sleep(1);
        if ((++sp & 255u) == 0u) { if (xb_ld(&bar[XB_TMO])) break; if (sp > XB_SPIN_CAP) { atomicAdd(&bar[XB_TMO], 1u); break; } }
    }
    nloc = mine > 0u ? mine : 1u; nx = cnt > 0u ? cnt : 1u;
}
__device__ __forceinline__ void xcd_barrier(const XcdBarrier& b) {
    asm volatile("s_waitcnt vmcnt(0)" ::: "memory");
    __syncthreads();
    if (threadIdx.x == 0) {
        unsigned* bar = b.bar;
        __builtin_amdgcn_s_waitcnt(0);
        unsigned nloc = b.st[0], nx = b.st[1];
        if (nloc == 0u) { xcd_barrier_complete(bar, b.x, nloc, nx); b.st[0] = nloc; b.st[1] = nx; }
        const unsigned old = xb_add(&bar[XB_XSUB(b.x)], 1u);
        const unsigned gen = old / nloc;
        if (old + 1u == (gen + 1u) * nloc) {
            __builtin_amdgcn_fence(__ATOMIC_RELEASE, "agent");
            asm volatile("s_waitcnt vmcnt(0)" ::: "memory");
            const unsigned og = xb_add(&bar[XB_TOP], 1u);
            const unsigned tg = og / nx;
            if (og + 1u == (tg + 1u) * nx) xb_add(&bar[XB_TOPGEN], 1u);
            else XB_SPIN(xb_ld(&bar[XB_TOPGEN]) == tg, bar);
            __builtin_amdgcn_fence(__ATOMIC_ACQUIRE, "agent");
            xb_add(&bar[XB_XGEN(b.x)], 1u);
            asm volatile("s_waitcnt vmcnt(0)" ::: "memory");
        } else {
            XB_SPIN(xb_ld(&bar[XB_XGEN(b.x)]) == gen, bar);
            __builtin_amdgcn_fence(__ATOMIC_ACQUIRE, "agent");
            asm volatile("s_waitcnt vmcnt(0)" ::: "memory");
        }
    }
    __syncthreads();
}

__global__ void __launch_bounds__(512, 2) fwd(Args a) {
    extern __shared__ __attribute__((aligned(16))) unsigned char lds_raw[];
    LAS unsigned char* lds = (LAS unsigned char*)lds_raw;
    cg::grid_group grid = cg::this_grid();
    int tid0 = threadIdx.x; const int wave = __builtin_amdgcn_readfirstlane(tid0 >> 6), G = gridDim.x, bid = blockIdx.x;
#define OPQ int tid = tid0; asm volatile("" : "+v"(tid)); const int lane = tid & 63; (void)lane;
    unsigned char* ws = a.ws;
    const int lo = a.ph_lo, hi = a.ph_hi;
    int ph = 0;
#ifndef EN
#define EN 0xFFFF
#endif
#define RUN(k) ((k) >= lo && (k) < hi)
#define ENB(t) if constexpr ((EN >> (t)) & 1)
#ifndef DUP
#define DUP 0
#endif
#define REP(t) _Pragma("nounroll") for (int rep = 0; rep < ((((DUP) >> (t)) & 1) ? 2 : 1); ++rep)
#define REPSYNC(t) do { if (((((DUP) >> (t)) & 1)) && rep == 0) xcd_barrier(xbar); } while (0)
#define SEAM(k) do { if ((k) + 1 < hi) xcd_barrier(xbar); } while (0)

    const bool ksplit = (G == 256) && (hi - lo > 1);
    XcdBarrier xbar; xbar.bar = (unsigned*)(ws + O_CTL) + CW_BAR; xbar.x = 0; xbar.st = (volatile LAS unsigned*)(lds + 131072 + 64);
    if (hi - lo > 1) {
        if (tid0 < 2) xbar.st[tid0] = 0u;
        if (bid == 0) { for (int i = tid0; i < XCD_BAR_WORDS; i += 512) xbar.bar[i] = 0u; if (tid0 < 16) ((unsigned*)(ws + O_CTL))[64 * tid0] = 0u; if (tid0 < 32) ((unsigned*)(ws + O_CTL))[1024 + 64 * tid0] = 0u;
            for (int i = tid0; i < 12288; i += 512) ((unsigned*)(ws + O_CTL))[CW_FLAG + i] = 0u; }
        grid.sync();
        xbar = xcd_barrier_post(xbar.bar, xbar.st);
    }
    if (RUN(0)) { REP(0) { ENB(0) { OPQ phase_p0(a, lds, tid, lane, wave, G, bid); } REPSYNC(0); } SEAM(0); }
    if (RUN(1)) { ENB(1) {
#pragma nounroll
        for (int pass = 0; pass < 2; ++pass) {
            pg8::SchedFold S{(const char*)(ws + (pass ? O_WBD : O_CS)), (const char*)(ws + (pass ? O_BDP : O_WFN)), pass, pass ? bid - 64 : bid};
            pg8::EpiStore E{(bf16_t*)(ws + (pass ? O_WBT : O_WINT)), 2048};
            pg8::gemm_phase(lds, pass ? 512 : 256, pass ? 512 : 128, pass ? 512 : 256, S, E); }
        { OPQ phase_p1_modreduce(a, tid, G, bid); } }
        SEAM(1);
    }
    for (int l = 0; l < 2; ++l) {
        const int p0 = 2 + 9 * l;
        const float* mod_l = (const float*)(ws + O_MOD) + (size_t)l * NCOND * 6 * 2048;
        if (RUN(p0 + 0)) {
#ifdef EXP_NANFILL
            { OPQ for (int i = bid * 512 + tid; i < 12288 * 1024; i += G * 512) ((u32x4*)(ws + O_ZG))[i] = (u32x4){0x7fc07fc0u, 0x7fc07fc0u, 0x7fc07fc0u, 0x7fc07fc0u}; }
#endif
            REP(2) { ENB(2) { OPQ phase_norm(a, l, 0, l == 0, lane, wave, G, bid); } REPSYNC(2); } SEAM(p0 + 0); }
        if (RUN(p0 + 1)) { REP(3) { ENB(3) {
            pg8::SchedMN S{(const char*)(ws + O_H), (const char*)(ws + O_WINT) + (size_t)l * 12288 * 2048 * 2, 2048, 2048, 48, 48, G, bid, 0, 48 * 48, 0, 0, 0, 0};
            pg8::EpiZ E{(bf16_t*)(ws + O_ZM), (bf16_t*)(ws + O_ZG), a.in[I_BGATE] + (size_t)l * 8192};
            pg8::gemm_phase(lds, 2048, 2048, 2048, S, E); } REPSYNC(3); }
            SEAM(p0 + 1);
        }
        if (RUN(p0 + 2)) { REP(4) { ENB(4) { OPQ phase_prep(a, l, lds, tid, lane, wave, G, bid); } REPSYNC(4); } SEAM(p0 + 2); }
        if (RUN(p0 + 3)) { REP(5) { ENB(5) {
#pragma nounroll
            for (int pass = 0; pass < 2; ++pass) { const int lat = 1 - pass, Kd = lat ? 2048 : 512;
              pg8::SchedDFT S{(const char*)(ws + (lat ? O_DFT1024 : O_DFT256)), (const char*)(ws + O_TT) + (lat ? (size_t)16 * 512 * 512 * 2 : 0), lat, lat ? bid : bid - 64}; pg8::EpiStore E{(bf16_t*)(ws + O_BR), 2048};
              pg8::gemm_phase(lds, Kd, Kd, Kd, S, E); }
            } ENB(10) { OPQ
            unsigned* cbase = (unsigned*)(ws + O_CTL) + 1024 + (l + 2 * rep) * 8 * 64;
            const int myx = (int)(xb_xcc_id() & 7u);
            constexpr int CPX = (3072 + 1536) / 8;
#pragma unroll 1
            for (int k = 0; k < 8; ++k) {
                const int x = (myx + k) & 7; unsigned* ctr = cbase + x * 64;
                for (;;) {
                    int c = CPX;
                    if (lane == 0) { if (__hip_atomic_load(ctr, __ATOMIC_RELAXED, __HIP_MEMORY_SCOPE_AGENT) < (unsigned)CPX) c = (int)atomicAdd(ctr, 1u); }
                    c = __builtin_amdgcn_readfirstlane(c);
                    if (c >= CPX) break;
                    const int idx = (((c >> 5) * 8 + x) << 5) + (c & 31);
                    if (idx < 3072) attn_item(a, l, idx, lane, (LAS float*)(lds + 131072 + 512 + wave * 1920)); else gmlp_item(a, l, idx - 3072, lane);
                }
            } } REPSYNC(5); }
            SEAM(p0 + 3);
        }
        if (RUN(p0 + 4)) { REP(6) { ENB(6) {
            const int nps = ksplit ? 2 : 1;
#pragma nounroll
            for (int pass = 0; pass < nps; ++pass) {
                pg8::SchedMN S{(const char*)(ws + O_BR), (const char*)(ws + O_WBT) + (size_t)l * DM * DM * 2, 2048, 2048, 48, 8, G, bid, 0, ksplit ? 256 : 384, pass, 256, 128, 1024 * 2};
                pg8::EpiBR E{(const bf16_t*)(ws + O_ZG), (bf16_t*)(ws + O_H), (float*)(ws + O_ZM), (unsigned*)(ws + O_CTL) + CW_FLAG + (4 + l) * 128 * 16};
                pg8::gemm_phase(lds, 2048, 2048, pass ? 1024 : 2048, S, E); } } REPSYNC(6); }
            SEAM(p0 + 4);
        }
        if (RUN(p0 + 5)) { ENB(7) {
            const int nps = ksplit ? 2 : 1;
#pragma nounroll
            for (int pass = 0; pass < nps; ++pass) {
                pg8::SchedMN S{(const char*)(ws + O_H), (const char*)(ws + O_WOT) + (size_t)l * DM * DM * 2, 2048, 2048, 48, 8, G, bid, 0, ksplit ? 256 : 384, pass, 256, 128, 1024 * 2};
                pg8::EpiRes E{l == 0 ? a.in[I_XP] : a.out, l == 0 ? a.in[I_XS] : a.out + (size_t)NCTXT * DM, a.out, mod_l, 2, (float*)(ws + O_ZM), (unsigned*)(ws + O_CTL) + CW_FLAG + (l * 2 + 0) * 128 * 16};
                pg8::gemm_phase(lds, 2048, 2048, pass ? 1024 : 2048, S, E); } }
            SEAM(p0 + 5);
        }
        if (RUN(p0 + 6)) { ENB(2) { OPQ phase_norm(a, l, 3, false, lane, wave, G, bid); } SEAM(p0 + 6); }
        if (RUN(p0 + 7)) { REP(8) { ENB(8) {
            pg8::SchedMN S{(const char*)(ws + O_H), (const char*)(ws + O_W1T) + (size_t)l * DFF * DM * 2, 2048, 2048, 48, 32, G, bid, 0, 48 * 32, 0, 0, 0, 0};
            pg8::EpiHid E{(bf16_t*)(ws + O_ZG)};
            pg8::gemm_phase(lds, 2048, 2048, 2048, S, E); } REPSYNC(8); }
            SEAM(p0 + 7);
        }
        if (RUN(p0 + 8)) { ENB(9) {
            const int nps = ksplit ? 2 : 1;
#pragma nounroll
            for (int pass = 0; pass < nps; ++pass) {
                pg8::SchedMN S{(const char*)(ws + O_ZG), (const char*)(ws + O_W2T) + (size_t)l * DM * DFF * 2, 8192, 8192, 48, 8, G, bid, 0, ksplit ? 256 : 384, pass, 256, 128, 4096 * 2};
                pg8::EpiRes E{a.out, a.out + (size_t)NCTXT * DM, a.out, mod_l, 5, (float*)(ws + O_ZM), (unsigned*)(ws + O_CTL) + CW_FLAG + (l * 2 + 1) * 128 * 16};
                pg8::gemm_phase(lds, 8192, 8192, pass ? 4096 : 8192, S, E); } }
            SEAM(p0 + 8);
        }
    }
    (void)ph;
}

extern "C" void kernel_launch(void* const* d_in, const int* in_sizes, int n_in, void* d_out, int out_size, void* d_ws, size_t ws_size, hipStream_t stream) {
    static int grid = 0;
    if (grid == 0) {
        if (n_in != 24 || ws_size < WS_NEED) { fprintf(stderr, "kernel_launch: need 24 inputs and %zu B of workspace (got %d, %zu)\n", (size_t)WS_NEED, n_in, ws_size); grid = -1; return; }
        int dev = 0, cus = 0, per_cu = 0;
        hipGetDevice(&dev); hipDeviceGetAttribute(&cus, hipDeviceAttributeMultiprocessorCount, dev);
        if (hipFuncSetAttribute((const void*)fwd, hipFuncAttributeMaxDynamicSharedMemorySize, LDS_BYTES) != hipSuccess) { fprintf(stderr, "kernel_launch: hipFuncSetAttribute failed\n"); grid = -1; return; }
        if (hipOccupancyMaxActiveBlocksPerMultiprocessor(&per_cu, (const void*)fwd, 512, LDS_BYTES) != hipSuccess || per_cu < 1) { fprintf(stderr, "kernel_launch: occupancy query says %d\n", per_cu); per_cu = 1; }
        (void)hipGetLastError();
        grid = cus;
    }
    if (grid < 0) return;
    Args a{};
    for (int i = 0; i < 24; ++i) a.in[i] = (const float*)d_in[i];
    a.out = (float*)d_out; a.ws = (unsigned char*)d_ws;
#if N_LAUNCH_MODE == 1
    a.ph_lo = 0; a.ph_hi = NPHASE;
    void* args[] = {&a};
    hipError_t e = hipLaunchCooperativeKernel((const void*)fwd, dim3(grid), dim3(512), args, LDS_BYTES, stream);
    if (e != hipSuccess) fprintf(stderr, "kernel_launch: cooperative launch failed: %s (grid %d)\n", hipGetErrorString(e), grid);
#else
    for (int p = 0; p < NPHASE; ++p) { a.ph_lo = p; a.ph_hi = p + 1; hipLaunchKernelGGL(fwd, dim3(grid), dim3(512), LDS_BYTES, stream, a); }
#endif
}
```

```cpp
#include <hip/hip_runtime.h>
#include <hip/hip_cooperative_groups.h>
#include <cstdio>
#include <cstdint>
namespace cg = cooperative_groups;


#ifndef N_LAUNCH_MODE
#define N_LAUNCH_MODE 1
#endif

#define LAS __attribute__((address_space(3)))
typedef unsigned short bf16_t;
typedef short bf16x8 __attribute__((ext_vector_type(8)));
typedef float f32x4 __attribute__((ext_vector_type(4)));
typedef float f32x2 __attribute__((ext_vector_type(2)));
typedef unsigned u32x4 __attribute__((ext_vector_type(4)));
typedef unsigned u32x2 __attribute__((ext_vector_type(2)));

constexpr int DM = 2048, NTOK = 12288, NCTXT = 4096, DFF = 8192, INC = 11776;
constexpr int NCOND = 9;
constexpr size_t MiB = 1u << 20;
constexpr size_t O_CTL = 0, O_WINT = 1 * MiB, O_WBT = 97 * MiB, O_WOT = 113 * MiB, O_W1T = 129 * MiB, O_W2T = 193 * MiB,
                 O_WFN = 257 * MiB, O_WBD = 261 * MiB, O_BDP = 265 * MiB, O_CS = 266 * MiB, O_DFT256 = 267 * MiB, O_DFT1024 = 268 * MiB,
                 O_WSB = 272 * MiB, O_MODP = 273 * MiB, O_MOD = 287 * MiB, O_CK = 288 * MiB, O_VTC = 296 * MiB, O_H = 304 * MiB,
                 O_ZM = 352 * MiB, O_ZG = 448 * MiB, O_QP = 640 * MiB, O_QR = 652 * MiB, O_KB = 660 * MiB, O_VT = 672 * MiB,
                 O_VNT = 684 * MiB, O_TT = 696 * MiB, O_BR = 720 * MiB, WS_NEED = 768 * MiB;
constexpr size_t OUTK = (size_t)NTOK * DM, OUTV = OUTK + (size_t)16 * 2 * 8 * 256 * 64;
constexpr int LDS_BYTES = 147456;
constexpr int NPHASE = 2 + 9 * 2;

struct Args { const float* in[24]; float* out; unsigned char* ws; int ph_lo, ph_hi; };
enum { I_XP = 0, I_XS, I_CK, I_CV, I_C, I_CCTX, I_N1G, I_WIN, I_BGATE, I_QNG, I_KNG, I_RPB, I_GNG, I_WSP, I_BSP, I_WPOOL, I_PSC, I_WBR, I_WOUT, I_N2G, I_W1, I_W2, I_WADA, I_BADA };

typedef __bf16 bf16x2_t __attribute__((ext_vector_type(2)));
__device__ __forceinline__ unsigned cvt_pk_bf16(float lo, float hi) { const f32x2 v = {lo, hi}; const bf16x2_t b = __builtin_convertvector(v, bf16x2_t); return __builtin_bit_cast(unsigned, b); }
__device__ __forceinline__ float bf2f(unsigned short u) { return __uint_as_float(((unsigned)u) << 16); }
__device__ __forceinline__ float bflo(unsigned u) { return __uint_as_float(u << 16); }
__device__ __forceinline__ float bfhi(unsigned u) { return __uint_as_float(u & 0xffff0000u); }
__device__ __forceinline__ bf16_t f2bf(float f) { return (bf16_t)(cvt_pk_bf16(f, 0.f) & 0xffffu); }
__device__ __forceinline__ float wave_sum(float v) {
#pragma unroll
    for (int o = 1; o < 64; o <<= 1) v += __shfl_xor(v, o);
    return v;
}
__device__ __forceinline__ float fast_exp(float x) { return __builtin_amdgcn_exp2f(x * 1.44269504089f); }
__device__ __forceinline__ float sigmoidf_(float x) { return __builtin_amdgcn_rcpf(1.0f + fast_exp(-x)); }
__device__ __forceinline__ float gelu_tanh(float x) { const float u = 0.7978845608f * (x + 0.044715f * x * x * x); return x * sigmoidf_(2.0f * u); }
#define LDS_WAIT() asm volatile("s_waitcnt lgkmcnt(0)" ::: "memory")
#define VM_WAIT() asm volatile("s_waitcnt vmcnt(0)" ::: "memory")

namespace pg8 {
constexpr int BM = 256, BK = 64, HALF = 128, HTB = HALF * BK * 2, STAGE_BYTES = 8 * HTB;
__device__ __forceinline__ int lds_byte(int r, int c) { const int st = (r >> 4) * 2 + (c >> 5), rr = r & 15, cc = c & 31, ob = rr * 64 + cc * 2; return st * 1024 + (ob ^ (((ob >> 9) & 1) << 5)); }
__device__ __forceinline__ void stage_rc(int b, int& R, int& C) { const int st = b / 1024, sb = b % 1024, swz = sb ^ (((sb >> 9) & 1) << 5); R = (st >> 1) * 16 + swz / 64; C = (st & 1) * 32 + (swz % 64) / 2; }
__device__ __forceinline__ int perm32(int rho) { const int n = rho >> 4, i = rho & 15; return 8 * (i >> 2) + 4 * n + (i & 3); }

struct Unit { const char* A; const char* B; long hA; int orow0, orow1, ocol, aux; };
__device__ __forceinline__ void tile_map(int L, int nM, int nN, int& pm, int& pn) {
    const int nwg = nM * nN; int wgid = L;
    { const int q = nwg / 8, r = nwg % 8, xcd = wgid % 8, off = wgid / 8; wgid = (xcd < r ? xcd * (q + 1) : r * (q + 1) + (xcd - r) * q) + off; }
    const int nig = 8 * nN, gid = wgid / nig, fm = gid * 8, gsz = (nM - fm) < 8 ? (nM - fm) : 8;
    pm = fm + ((wgid % nig) % gsz); pn = (wgid % nig) / gsz;
}
template <class Epi, class Sched>
__device__ __forceinline__ void gemm_phase(LAS unsigned char* lds, const int lda, const int ldb, const int K, const Sched& S, const Epi& E) {
    int tid = threadIdx.x; asm volatile("" : "+v"(tid));
    const int wid = __builtin_amdgcn_readfirstlane(tid >> 6), lane = tid & 63, wr = wid >> 2, wc = wid & 3, fr = lane & 15, fq = lane >> 4;
    const int nt = K / BK;
    unsigned voffA[2], voffB[2];
#pragma unroll
    for (int i = 0; i < 2; ++i) { int R, C; stage_rc(tid * 16 + i * 8192, R, C); const int Rb = (R & ~31) + perm32(R & 31);
        voffA[i] = (unsigned)(R * lda + C) * 2u; voffB[i] = (unsigned)(Rb * ldb + C) * 2u; }
    const size_t kstep = (size_t)(BK * 2);
    const size_t hstepB = (size_t)HALF * ldb * 2;
    const unsigned ldsw = (unsigned)wid * 1024u;
    const int aoff = lds_byte(wr * 64 + fr, fq * 8), boff = lds_byte(wc * 32 + fr, fq * 8);
#define PG8_SA(b, h) (((b) * 2 + (h)) * HTB)
#define PG8_SB(b, h) ((4 + (b) * 2 + (h)) * HTB)
#define PG8_STAGE(bufoff, gbase, voff) do { _Pragma("unroll") for (int _i = 0; _i < 2; ++_i) \
        __builtin_amdgcn_global_load_lds((const unsigned*)((const char*)(gbase) + (voff)[_i]), (LAS unsigned*)(lds + (bufoff) + ldsw + _i * 8192), 16, 0, 0); } while (0)
#define PG8_LDA(dst, b, h) do { _Pragma("unroll") for (int m = 0; m < 4; ++m) _Pragma("unroll") for (int k = 0; k < 2; ++k) dst[m][k] = *(const LAS bf16x8*)(lds + PG8_SA(b, h) + aoff + m * 2048 + k * 1024); } while (0)
#define PG8_LDB(dst, b, h) do { _Pragma("unroll") for (int n = 0; n < 2; ++n) _Pragma("unroll") for (int k = 0; k < 2; ++k) dst[n][k] = *(const LAS bf16x8*)(lds + PG8_SB(b, h) + boff + n * 2048 + k * 1024); } while (0)
#define PG8_MMA(ai, bj, At, Bt) do { __builtin_amdgcn_s_setprio(1); _Pragma("unroll") for (int m = 0; m < 4; ++m) _Pragma("unroll") for (int n = 0; n < 2; ++n) _Pragma("unroll") for (int k = 0; k < 2; ++k) \
        acc[ai][bj][m][n] = __builtin_amdgcn_mfma_f32_16x16x32_bf16(Bt[n][k], At[m][k], acc[ai][bj][m][n], 0, 0, 0); __builtin_amdgcn_s_setprio(0); } while (0)
#define PG8_WAIT_V(n) asm volatile("s_waitcnt vmcnt(" #n ")" ::: "memory")
#define PG8_WAIT_L(n) asm volatile("s_waitcnt lgkmcnt(" #n ")" ::: "memory")
#define PG8_BAR __builtin_amdgcn_s_barrier()
#define PG8_SCHED __builtin_amdgcn_sched_barrier(0)
    Unit cur, nxt; int ui = 0;
    if (!S.next(0, cur)) return;
    f32x4 acc[2][2][4][2];
#pragma unroll
    for (int a = 0; a < 2; ++a)
#pragma unroll
        for (int b = 0; b < 2; ++b)
#pragma unroll
            for (int m = 0; m < 4; ++m)
#pragma unroll
                for (int n = 0; n < 2; ++n) acc[a][b][m][n] = (f32x4){0.f, 0.f, 0.f, 0.f};
    bf16x8 At[4][2], B0[2][2], B1[2][2];
    const char* cA = cur.A; const char* cB = cur.B; long chA = cur.hA;
    PG8_STAGE(PG8_SB(0, 0), cB, voffB); PG8_STAGE(PG8_SB(0, 1), cB + hstepB, voffB); PG8_STAGE(PG8_SA(0, 0), cA, voffA); PG8_STAGE(PG8_SA(0, 1), cA + chA, voffA);
    if (wr == 1) PG8_BAR;
    PG8_WAIT_V(2); PG8_BAR;
    PG8_STAGE(PG8_SB(1, 0), cB + kstep, voffB); PG8_STAGE(PG8_SA(1, 0), cA + kstep, voffA); PG8_STAGE(PG8_SB(1, 1), cB + hstepB + kstep, voffB);
    PG8_WAIT_V(6); PG8_BAR;
    for (;;) {
        const bool has_next = S.next(ui + 1, nxt);
        const char* nA = has_next ? nxt.A : cA; const char* nB = has_next ? nxt.B : cB; const long nhA = has_next ? nxt.hA : chA;
        for (int t = 0; t < nt; t += 2) {
            const bool last = (t == nt - 2);
            const char* a1 = cA + (size_t)(t + 1) * kstep;
            const char* a2 = last ? nA : cA + (size_t)(t + 2) * kstep; const char* b2 = last ? nB : cB + (size_t)(t + 2) * kstep;
            const char* a3 = a2 + kstep; const char* b3 = b2 + kstep; const long h2 = last ? nhA : chA;
            PG8_LDB(B0, 0, 0); PG8_LDB(B1, 0, 1); PG8_SCHED; PG8_LDA(At, 0, 0); PG8_STAGE(PG8_SA(1, 1), a1 + chA, voffA);
            PG8_WAIT_V(8); PG8_WAIT_L(0); PG8_BAR; PG8_MMA(0, 0, At, B0); PG8_MMA(0, 1, At, B1); PG8_BAR; PG8_SCHED;
            PG8_LDA(At, 0, 1); PG8_STAGE(PG8_SB(0, 0), b2, voffB); PG8_STAGE(PG8_SB(0, 1), b2 + hstepB, voffB); PG8_STAGE(PG8_SA(0, 0), a2, voffA);
            PG8_WAIT_V(8); PG8_WAIT_L(0); PG8_BAR; PG8_MMA(1, 0, At, B0); PG8_MMA(1, 1, At, B1); PG8_BAR; PG8_SCHED;
            PG8_LDB(B0, 1, 0); PG8_LDB(B1, 1, 1); PG8_SCHED; PG8_LDA(At, 1, 0); PG8_STAGE(PG8_SA(0, 1), a2 + h2, voffA);
            PG8_WAIT_V(8); PG8_WAIT_L(0); PG8_BAR; PG8_MMA(0, 0, At, B0); PG8_MMA(0, 1, At, B1); PG8_BAR; PG8_SCHED;
            PG8_LDA(At, 1, 1); PG8_STAGE(PG8_SB(1, 0), b3, voffB); PG8_STAGE(PG8_SB(1, 1), b3 + hstepB, voffB); PG8_STAGE(PG8_SA(1, 0), a3, voffA);
            PG8_WAIT_V(8); PG8_WAIT_L(0); PG8_BAR; PG8_MMA(1, 0, At, B0); PG8_MMA(1, 1, At, B1); PG8_BAR; PG8_SCHED;
            if constexpr (Epi::MID) { if (((t + 2) & 7) == 0 && t + 2 < nt) E.mid(acc, cur, (t + 2) >> 3, wr, wc, fr, fq); }
        }
        if (wr == 0) PG8_BAR;
        E(acc, cur, wr, wc, fr, fq);
        if (!has_next) break;
#pragma unroll
        for (int a = 0; a < 2; ++a)
#pragma unroll
            for (int b = 0; b < 2; ++b)
#pragma unroll
                for (int m = 0; m < 4; ++m)
#pragma unroll
                    for (int n = 0; n < 2; ++n) acc[a][b][m][n] = (f32x4){0.f, 0.f, 0.f, 0.f};
        cur = nxt; cA = nA; cB = nB; chA = nhA; ++ui;
        if (wr == 1) PG8_BAR;
    }
    PG8_WAIT_V(0);
    PG8_BAR;
#undef PG8_SA
#undef PG8_SB
#undef PG8_STAGE
#undef PG8_LDA
#undef PG8_LDB
#undef PG8_MMA
#undef PG8_WAIT_V
#undef PG8_WAIT_L
#undef PG8_BAR
#undef PG8_SCHED
}

struct SchedMN {
    const char* A; const char* B; int lda, ldb, nM, nN, G, c, ocol_off, lim, split, L0, nsplit, khalf_bytes;
    __device__ __forceinline__ bool next(int i, Unit& u) const {
        int L, kh = 0, aux = 0;
        if (!split) { L = i * G + c; if (c < 0 || L >= lim) return false; }
        else { if (i > 0 || c >= 2 * nsplit) return false; const int j = c >> 1; kh = c & 1; L = L0 + j; aux = (j << 2) | 2 | kh; }
        int pm, pn; tile_map(L, nM, nN, pm, pn);
        const long h = (long)128 * lda * 2;
        u.A = A + (size_t)pm * 256 * lda * 2 + (size_t)kh * khalf_bytes + (kh ? h : 0); u.B = B + (size_t)pn * 256 * ldb * 2 + (size_t)kh * khalf_bytes;
        u.hA = kh ? -h : h;
        u.orow0 = pm * 256 + (kh ? 128 : 0); u.orow1 = pm * 256 + (kh ? 0 : 128); u.ocol = pn * 256 + ocol_off; u.aux = aux; return true;
    }
};
struct SchedBR {
    const char* A; const char* B; int G, c;
    __device__ __forceinline__ bool next(int i, Unit& u) const {
#ifdef EXP_B3
        const int L = i * G + c; if (L >= 48 * 8) return false;
        const int b = 3; int pm, pn; tile_map(L, 48, 8, pm, pn);
#else
        const int L = (i >> 2) * G + c; if (L >= 48 * 8) return false;
        const int b = i & 3; int pm, pn; tile_map(L, 48, 8, pm, pn);
#endif
        u.A = A + (size_t)pm * 256 * 2048 * 2 + b * 1024; u.B = B + (size_t)pn * 256 * 2048 * 2 + b * 1024; u.hA = (long)128 * 2048 * 2; u.orow0 = pm * 256; u.orow1 = pm * 256 + 128; u.ocol = pn * 256; u.aux = b; return true;
    }
};
struct SchedFold {
    const char* A0; const char* B0; int mode, c;
    __device__ __forceinline__ bool next(int i, Unit& u) const {
        if (i > 0 || c < 0) return false;
        if (mode == 0) { if (c >= 64) return false; const int l = c >> 5, g = (c >> 3) & 3, pn = c & 7;
            u.A = A0; u.hA = (long)128 * 256 * 2; u.B = B0 + ((size_t)(l * 4 + g) * 2048 + pn * 256) * 128 * 2; u.orow0 = l * 12288 + 2560 + g * 128; u.orow1 = l * 12288 + 3072 + g * 128; u.ocol = pn * 256; u.aux = g; }
        else { if (c >= 32) return false; const int l = c >> 4, pm = (c & 15) >> 1, pn = c & 1;
            u.A = A0 + ((size_t)l * 2048 + pm * 256) * 512 * 2; u.hA = (long)128 * 512 * 2; u.B = B0 + ((size_t)l * 512 + pn * 256) * 512 * 2; u.orow0 = l * 2048 + pm * 256; u.orow1 = u.orow0 + 128; u.ocol = 1536 + pn * 256; u.aux = 0; }
        return true;
    }
};
struct SchedDFT {
    const char* Amat; const char* TT; int latent, c;
    __device__ __forceinline__ bool next(int i, Unit& u) const {
        if (i > 0 || c < 0) return false;
        if (latent) { if (c >= 64) return false; const int bb = c >> 3, pm = (c & 7) >> 1, pn = c & 1;
            u.A = Amat + (size_t)pm * 256 * 2048 * 2; u.hA = (long)128 * 2048 * 2; u.B = TT + ((size_t)bb * 512 + pn * 256) * 2048 * 2; u.orow0 = NCTXT + bb * 1024 + pm * 256; u.orow1 = u.orow0 + 128; u.ocol = 1024 + pn * 256; }
        else { if (c >= 32) return false; const int bb = c >> 1, pn = c & 1;
            u.A = Amat; u.hA = (long)128 * 512 * 2; u.B = TT + ((size_t)bb * 512 + pn * 256) * 512 * 2; u.orow0 = bb * 256; u.orow1 = u.orow0 + 128; u.ocol = 1024 + pn * 256; }
        u.aux = 0; return true;
    }
};

__device__ __forceinline__ u32x4 pack8(const f32x4 v0, const f32x4 v1) { u32x4 w; w.x = cvt_pk_bf16(v0[0], v0[1]); w.y = cvt_pk_bf16(v0[2], v0[3]); w.z = cvt_pk_bf16(v1[0], v1[1]); w.w = cvt_pk_bf16(v1[2], v1[3]); return w; }
struct EpiStore {
    static constexpr bool MID = false;
    bf16_t* O; int ldc;
    __device__ __forceinline__ void operator()(const f32x4 (&acc)[2][2][4][2], const Unit& u, int wr, int wc, int fr, int fq) const {
        asm volatile("" : "+v"(fr), "+v"(fq));
#pragma unroll
        for (int ai = 0; ai < 2; ++ai)
#pragma unroll
            for (int m = 0; m < 4; ++m) { bf16_t* rowp = O + (size_t)((ai ? u.orow1 : u.orow0) + wr * 64 + m * 16 + fr) * ldc + u.ocol + wc * 32 + 8 * fq;
#pragma unroll
                for (int bj = 0; bj < 2; ++bj) *(u32x4*)(rowp + bj * 128) = pack8(acc[ai][bj][m][0], acc[ai][bj][m][1]); }
    }
};
struct EpiZ {
    static constexpr bool MID = false;
    bf16_t* Zm; bf16_t* Zg; const float* bgate;
    __device__ __forceinline__ void operator()(const f32x4 (&acc)[2][2][4][2], const Unit& u, int wr, int wc, int fr, int fq) const {
        asm volatile("" : "+v"(fr), "+v"(fq));
        const int pn = u.ocol >> 8; const int cb = wc * 32 + 8 * fq;
        if (pn >= 16) {
            const int col0 = u.ocol - 4096 + cb;
            f32x4 bv[2][2];
#pragma unroll
            for (int bj = 0; bj < 2; ++bj)
#pragma unroll
                for (int n = 0; n < 2; ++n) bv[bj][n] = *(const f32x4*)(bgate + col0 + bj * 128 + 4 * n);
#pragma unroll
            for (int ai = 0; ai < 2; ++ai)
#pragma unroll
                for (int m = 0; m < 4; ++m) { bf16_t* rowp = Zg + (size_t)((ai ? u.orow1 : u.orow0) + wr * 64 + m * 16 + fr) * 8192 + col0;
#pragma unroll
                    for (int bj = 0; bj < 2; ++bj) { f32x4 v0 = acc[ai][bj][m][0] + bv[bj][0], v1 = acc[ai][bj][m][1] + bv[bj][1];
#pragma unroll
                        for (int e = 0; e < 4; ++e) { v0[e] = sigmoidf_(v0[e]); v1[e] = sigmoidf_(v1[e]); }
                        *(u32x4*)(rowp + bj * 128) = pack8(v0, v1); } }
        } else {
            const bool gel = (pn >= 6 && pn < 10);
#pragma unroll
            for (int ai = 0; ai < 2; ++ai)
#pragma unroll
                for (int m = 0; m < 4; ++m) { bf16_t* rowp = Zm + (size_t)((ai ? u.orow1 : u.orow0) + wr * 64 + m * 16 + fr) * 4096 + u.ocol + cb;
#pragma unroll
                    for (int bj = 0; bj < 2; ++bj) { f32x4 v0 = acc[ai][bj][m][0], v1 = acc[ai][bj][m][1];
                        if (gel) {
#pragma unroll
                            for (int e = 0; e < 4; ++e) { v0[e] = gelu_tanh(v0[e]); v1[e] = gelu_tanh(v1[e]); } }
                        *(u32x4*)(rowp + bj * 128) = pack8(v0, v1); } }
        }
    }
};
struct EpiHid {
    static constexpr bool MID = false;
    bf16_t* O;
    __device__ __forceinline__ void operator()(const f32x4 (&acc)[2][2][4][2], const Unit& u, int wr, int wc, int fr, int fq) const {
        asm volatile("" : "+v"(fr), "+v"(fq));
#pragma unroll
        for (int ai = 0; ai < 2; ++ai)
#pragma unroll
            for (int m = 0; m < 4; ++m) { bf16_t* rowp = O + (size_t)((ai ? u.orow1 : u.orow0) + wr * 64 + m * 16 + fr) * DFF + u.ocol + wc * 32 + 8 * fq;
#pragma unroll
                for (int bj = 0; bj < 2; ++bj) { f32x4 v0 = acc[ai][bj][m][0], v1 = acc[ai][bj][m][1];
#pragma unroll
                    for (int e = 0; e < 4; ++e) { const float a = fmaxf(v0[e], 0.f), b = fmaxf(v1[e], 0.f); v0[e] = a * a; v1[e] = b * b; }
                    *(u32x4*)(rowp + bj * 128) = pack8(v0, v1); } }
    }
};
__device__ __forceinline__ void ho_send(const f32x4 (&acc)[2][2][4][2], unsigned long long* sb, unsigned* flag, int tidp) {
#pragma unroll
    for (int m = 0; m < 4; ++m)
#pragma unroll
        for (int bj = 0; bj < 2; ++bj)
#pragma unroll
            for (int n = 0; n < 2; ++n) { const f32x4 v = acc[1][bj][m][n]; unsigned long long* p = sb + (size_t)(((m * 2 + bj) * 2 + n) * 1024);
                __hip_atomic_store(p, ((unsigned long long)__float_as_uint(v[1]) << 32) | __float_as_uint(v[0]), __ATOMIC_RELAXED, __HIP_MEMORY_SCOPE_AGENT);
                __hip_atomic_store(p + 1, ((unsigned long long)__float_as_uint(v[3]) << 32) | __float_as_uint(v[2]), __ATOMIC_RELAXED, __HIP_MEMORY_SCOPE_AGENT); }
    asm volatile("s_waitcnt vmcnt(0)" ::: "memory");
    __syncthreads();
    if (tidp == 0) __hip_atomic_store(flag, 1u, __ATOMIC_RELEASE, __HIP_MEMORY_SCOPE_AGENT);
}
__device__ __forceinline__ void ho_wait(unsigned* flag, int tidp) {
    if (tidp == 0) { unsigned spin = 0; while (__hip_atomic_load(flag, __ATOMIC_ACQUIRE, __HIP_MEMORY_SCOPE_AGENT) == 0u) { __builtin_amdgcn_s_sleep(2); if (++spin > (1u << 24)) break; } }
    __syncthreads();
}
__device__ __forceinline__ f32x4 ho_get(unsigned long long* sb, int m, int bj, int n) {
    unsigned long long* p = sb + (size_t)(((m * 2 + bj) * 2 + n) * 1024);
    const unsigned long long a0 = __hip_atomic_load(p, __ATOMIC_RELAXED, __HIP_MEMORY_SCOPE_AGENT), a1 = __hip_atomic_load(p + 1, __ATOMIC_RELAXED, __HIP_MEMORY_SCOPE_AGENT);
    return (f32x4){__uint_as_float((unsigned)a0), __uint_as_float((unsigned)(a0 >> 32)), __uint_as_float((unsigned)a1), __uint_as_float((unsigned)(a1 >> 32))};
}
struct EpiRes {
    static constexpr bool MID = false;
    const float* xp; const float* xs; float* out; const float* mod; int gsel;
    float* S; unsigned* flags;
    __device__ __forceinline__ void operator()(const f32x4 (&acc)[2][2][4][2], const Unit& u, int wr, int wc, int fr, int fq) const {
        asm volatile("" : "+v"(fr), "+v"(fq));
        const int sp = u.aux & 2, jt = u.aux >> 2;
        const int tidp = (wr * 4 + wc) * 64 + fq * 16 + fr;
        const int kh = u.aux & 1;
        unsigned long long* sbs = (unsigned long long*)(S + (size_t)jt * 65536 + kh * 32768) + (size_t)tidp * 2;
        unsigned long long* sb = (unsigned long long*)(S + (size_t)jt * 65536 + (1 - kh) * 32768) + (size_t)tidp * 2;
        if (sp) { ho_send(acc, sbs, flags + jt * 16 + kh * 8, tidp); ho_wait(flags + jt * 16 + (1 - kh) * 8, tidp); }
        const int pm = u.orow0 >> 8; const int cond = pm < 16 ? 0 : 1 + ((pm - 16) >> 2);
        const int col0 = u.ocol + wc * 32 + 8 * fq;
        const float* gp = mod + ((size_t)cond * 6 + gsel) * 2048 + col0;
        f32x4 gv[2][2];
#pragma unroll
        for (int bj = 0; bj < 2; ++bj)
#pragma unroll
            for (int n = 0; n < 2; ++n) gv[bj][n] = *(const f32x4*)(gp + bj * 128 + 4 * n);
        const float* src = pm < 16 ? xp : xs - (size_t)NCTXT * DM;
#pragma unroll
        for (int ai = 0; ai < 2; ++ai) {
            if (ai == 1 && sp) break;
#pragma unroll
            for (int m = 0; m < 4; ++m) {
                f32x4 xv[2][2], pv[2][2]; const size_t off = (size_t)((ai ? u.orow1 : u.orow0) + wr * 64 + m * 16 + fr) * DM + col0;
#pragma unroll
                for (int bj = 0; bj < 2; ++bj)
#pragma unroll
                    for (int n = 0; n < 2; ++n) { xv[bj][n] = *(const f32x4*)(src + off + bj * 128 + 4 * n); if (ai == 0 && sp) pv[bj][n] = ho_get(sb, m, bj, n); }
#pragma unroll
                for (int bj = 0; bj < 2; ++bj)
#pragma unroll
                    for (int n = 0; n < 2; ++n) { f32x4 v = acc[ai][bj][m][n]; if (ai == 0 && sp) v += pv[bj][n];
                        *(f32x4*)(out + off + bj * 128 + 4 * n) = xv[bj][n] + gv[bj][n] * v; }
                asm volatile("" ::: "memory"); } }
    }
};
struct EpiBR {
    static constexpr bool MID = true;
    const bf16_t* Zg; bf16_t* merged; float* S; unsigned* flags;
    __device__ __forceinline__ void scale(f32x4 (&acc)[2][2][4][2], const Unit& u, int b, bool ratio, int wr, int wc, int fr, int fq) const {
        const int col0 = u.ocol + wc * 32 + 8 * fq;
#pragma unroll
        for (int ai = 0; ai < 2; ++ai) {
            u32x4 gw[4][2], nw[4][2];
#pragma unroll
            for (int m = 0; m < 4; ++m)
#pragma unroll
                for (int bj = 0; bj < 2; ++bj) { const bf16_t* gp = Zg + (size_t)((ai ? u.orow1 : u.orow0) + wr * 64 + m * 16 + fr) * 8192 + b * 2048 + col0 + bj * 128;
                    gw[m][bj] = *(const u32x4*)gp; if (ratio) nw[m][bj] = *(const u32x4*)(gp + 2048); }
#pragma unroll
            for (int m = 0; m < 4; ++m)
#pragma unroll
                for (int bj = 0; bj < 2; ++bj) { const u32x4 g4 = gw[m][bj];
                    float g[8] = {bflo(g4.x), bfhi(g4.x), bflo(g4.y), bfhi(g4.y), bflo(g4.z), bfhi(g4.z), bflo(g4.w), bfhi(g4.w)};
#pragma unroll
                    for (int e = 0; e < 8; ++e) g[e] = fmaxf(g[e], 1e-6f);
                    if (ratio) { const u32x4 n4 = nw[m][bj];
                        const float gn[8] = {bflo(n4.x), bfhi(n4.x), bflo(n4.y), bfhi(n4.y), bflo(n4.z), bfhi(n4.z), bflo(n4.w), bfhi(n4.w)};
#pragma unroll
                        for (int e = 0; e < 8; ++e) g[e] *= __builtin_amdgcn_rcpf(fmaxf(gn[e], 1e-6f)); }
                    f32x4 v0 = acc[ai][bj][m][0], v1 = acc[ai][bj][m][1];
                    v0[0] *= g[0]; v0[1] *= g[1]; v0[2] *= g[2]; v0[3] *= g[3]; v1[0] *= g[4]; v1[1] *= g[5]; v1[2] *= g[6]; v1[3] *= g[7];
                    acc[ai][bj][m][0] = v0; acc[ai][bj][m][1] = v1; }
            asm volatile("" ::: "memory"); }
    }
    __device__ __forceinline__ void mid(f32x4 (&acc)[2][2][4][2], const Unit& u, int seg, int wr, int wc, int fr, int fq) const {
        asm volatile("" : "+v"(fr), "+v"(fq));
        const int base = (u.aux & 2) ? (u.aux & 1) * 2 : 0;
        scale(acc, u, base + seg - 1, true, wr, wc, fr, fq);
    }
    __device__ __forceinline__ void operator()(f32x4 (&acc)[2][2][4][2], const Unit& u, int wr, int wc, int fr, int fq) const {
        asm volatile("" : "+v"(fr), "+v"(fq));
        const int sp = u.aux & 2, kh = u.aux & 1, jt = u.aux >> 2;
        const int tidp = (wr * 4 + wc) * 64 + fq * 16 + fr;
        unsigned long long* sbs = (unsigned long long*)(S + (size_t)jt * 65536 + kh * 32768) + (size_t)tidp * 2;
        unsigned long long* sb = (unsigned long long*)(S + (size_t)jt * 65536 + (1 - kh) * 32768) + (size_t)tidp * 2;
        scale(acc, u, sp ? kh * 2 + 1 : 3, false, wr, wc, fr, fq);
        if (sp) { ho_send(acc, sbs, flags + jt * 16 + kh * 8, tidp); ho_wait(flags + jt * 16 + (1 - kh) * 8, tidp); }
        const int col0 = u.ocol + wc * 32 + 8 * fq;
        if (sp) {
            f32x4 pv[4][2][2];
#pragma unroll
            for (int m = 0; m < 4; ++m)
#pragma unroll
                for (int bj = 0; bj < 2; ++bj) { pv[m][bj][0] = ho_get(sb, m, bj, 0); pv[m][bj][1] = ho_get(sb, m, bj, 1); }
#pragma unroll
            for (int m = 0; m < 4; ++m) { const size_t row = (size_t)(u.orow0 + wr * 64 + m * 16 + fr);
#pragma unroll
                for (int bj = 0; bj < 2; ++bj) *(u32x4*)(merged + row * DM + col0 + bj * 128) = pack8(acc[0][bj][m][0] + pv[m][bj][0], acc[0][bj][m][1] + pv[m][bj][1]); }
        } else {
#pragma unroll
            for (int ai = 0; ai < 2; ++ai)
#pragma unroll
                for (int m = 0; m < 4; ++m) { const size_t row = (size_t)((ai ? u.orow1 : u.orow0) + wr * 64 + m * 16 + fr);
#pragma unroll
                    for (int bj = 0; bj < 2; ++bj) *(u32x4*)(merged + row * DM + col0 + bj * 128) = pack8(acc[ai][bj][m][0], acc[ai][bj][m][1]); }
        }
    }
};
}

__device__ __forceinline__ void transpose_item(const float* W, int N, int k0, int n0, bf16_t* D, int ldo, int dn0, int dk0, LAS float* scr, int lane) {
#pragma unroll 8
    for (int i = 0; i < 32; ++i) { const int kk = 2 * i + (lane >> 5); scr[kk * 33 + (lane & 31)] = W[(size_t)(k0 + kk) * N + n0 + (lane & 31)]; }
    LDS_WAIT(); asm volatile("" ::: "memory");
    const int c = lane & 7;
#pragma unroll
    for (int j = 0; j < 4; ++j) { const int n = (lane >> 3) + 8 * j; const LAS float* s = scr + (8 * c) * 33 + n;
        u32x4 o; o.x = cvt_pk_bf16(s[0 * 33], s[1 * 33]); o.y = cvt_pk_bf16(s[2 * 33], s[3 * 33]); o.z = cvt_pk_bf16(s[4 * 33], s[5 * 33]); o.w = cvt_pk_bf16(s[6 * 33], s[7 * 33]);
        *(u32x4*)(D + (size_t)(dn0 + n) * ldo + dk0 + 8 * c) = o; }
    LDS_WAIT(); asm volatile("" ::: "memory");
}

__device__ __forceinline__ void phase_p0(const Args& a, LAS unsigned char* lds, int tid, int lane, int wave, int G, int bid) {
    unsigned char* ws = a.ws;
    LAS float* scr = (LAS float*)(lds + wave * 16384);
    const int gw = bid * 8 + wave, NGW = G * 8;
    if (bid == 0 && tid < 16) ((unsigned*)(ws + O_CTL))[64 * tid] = 0u;
    if (bid == 0 && tid < 32) ((unsigned*)(ws + O_CTL))[1024 + 64 * tid] = 0u;
    constexpr int IT_WIN = 32 * 368, IT_WBR = 32 * 64, IT_WOUT = 32 * 64, IT_W1 = 32 * 256, IT_W2 = 128 * 64, IT_L = IT_WIN + IT_WBR + IT_WOUT + IT_W1 + IT_W2;
    constexpr int IT_CV = 128 * 16;
    for (int it = gw; it < 2 * IT_L + IT_CV; it += NGW) {
        if (it >= 2 * IT_L) {
            const int r = it - 2 * IT_L, mtx = r >> 4, kb = (r >> 1) & 7, nb = r & 1;
            transpose_item(a.in[I_CV] + (size_t)mtx * 512 * 64, 64, kb * 64, nb * 32, (bf16_t*)(ws + O_VTC) + (size_t)mtx * 64 * 512, 512, nb * 32, kb * 64, scr, lane);
            continue;
        }
        const int l = it / IT_L; int r = it % IT_L;
        if (r < IT_WIN) {
            const int kb = r / 368, nb = r % 368, k0 = kb * 64, n0 = nb * 32;
            const float* W = a.in[I_WIN] + (size_t)l * DM * INC;
            if (n0 >= 2560 && n0 < 3072) {
                const int g = (n0 - 2560) >> 7, c0 = (n0 - 2560) & 127;
                bf16_t* D = (bf16_t*)(ws + O_WFN) + ((size_t)(l * 4 + g) * 2048) * 128;
#pragma unroll 8
                for (int i = 0; i < 32; ++i) { const int kk = 2 * i + (lane >> 5); D[(size_t)(k0 + kk) * 128 + c0 + (lane & 31)] = f2bf(W[(size_t)(k0 + kk) * INC + n0 + (lane & 31)]); }
            } else {
                const int dn0 = n0 < 2560 ? n0 : n0 + 512;
                transpose_item(W, INC, k0, n0, (bf16_t*)(ws + O_WINT) + (size_t)l * 12288 * 2048, 2048, dn0, k0, scr, lane);
            }
            continue;
        } r -= IT_WIN;
        if (r < IT_WBR) {
            const int kb = r / 64, nb = r % 64, k0 = kb * 64, n0 = nb * 32;
            const float* W = a.in[I_WBR] + (size_t)l * DM * DM;
            if (k0 < 1536) transpose_item(W, DM, k0, n0, (bf16_t*)(ws + O_WBT) + (size_t)l * DM * DM, 2048, n0, k0, scr, lane);
            else transpose_item(W, DM, k0, n0, (bf16_t*)(ws + O_WBD) + (size_t)l * DM * 512, 512, n0, k0 - 1536, scr, lane);
            continue;
        } r -= IT_WBR;
        if (r < IT_WOUT) { const int kb = r / 64, nb = r % 64; transpose_item(a.in[I_WOUT] + (size_t)l * DM * DM, DM, kb * 64, nb * 32, (bf16_t*)(ws + O_WOT) + (size_t)l * DM * DM, 2048, nb * 32, kb * 64, scr, lane); continue; } r -= IT_WOUT;
        if (r < IT_W1) { const int kb = r / 256, nb = r % 256; transpose_item(a.in[I_W1] + (size_t)l * DM * DFF, DFF, kb * 64, nb * 32, (bf16_t*)(ws + O_W1T) + (size_t)l * DFF * DM, 2048, nb * 32, kb * 64, scr, lane); continue; } r -= IT_W1;
        { const int kb = r / 64, nb = r % 64; transpose_item(a.in[I_W2] + (size_t)l * DFF * DM, DM, kb * 64, nb * 32, (bf16_t*)(ws + O_W2T) + (size_t)l * DM * DFF, 8192, nb * 32, kb * 64, scr, lane); }
    }
    const int gt = bid * 512 + tid, NGT = G * 512;
    for (int i = gt; i < 2 * 512 * 512; i += NGT) {
        const int l = i >> 18, c = (i >> 9) & 511, d = i & 511; float v = 0.f;
        if ((c >> 7) == (d >> 7)) v = a.in[I_WPOOL][(((size_t)l * 4 + (c >> 7)) * 128 + (c & 127)) * 128 + (d & 127)] * a.in[I_PSC][l * 512 + d];
        ((bf16_t*)(ws + O_BDP))[i] = f2bf(v);
    }
    for (int i = gt; i < 256 * 256; i += NGT) {
        const int r = i >> 8, c = i & 255, cp = r & 127; const float t = (float)((cp * c) & 127) * (2.0f / 128.0f);
        ((bf16_t*)(ws + O_CS))[i] = f2bf(c < 128 ? (r < 128 ? cospif(t) : sinpif(t)) * 0.08838834764831845f : 0.f);
    }
    for (int i = gt; i < 256 * 512; i += NGT) {
        const int k = i >> 9, c = i & 511, n = c & 255; const float t = (float)((k * n) & 255) * (2.0f / 256.0f);
        ((bf16_t*)(ws + O_DFT256))[i] = f2bf((c < 256 ? cospif(t) : -sinpif(t)) * 0.0625f);
    }
    for (int i = gt; i < 1024 * 2048; i += NGT) {
        const int k = i >> 11, c = i & 2047, n = c & 1023; const float t = (float)((k * n) & 1023) * (2.0f / 1024.0f);
        ((bf16_t*)(ws + O_DFT1024))[i] = f2bf((c < 1024 ? cospif(t) : -sinpif(t)) * 0.03125f);
    }
    for (int i = gt; i < 2 * 4 * 128 * 128; i += NGT) ((bf16_t*)(ws + O_WSB))[i] = f2bf(a.in[I_WSP][i]);
    for (int i = gt; i < 8 * 2 * 8 * 512 * 64 / 4; i += NGT) { const f32x4 v = ((const f32x4*)a.in[I_CK])[i]; u32x2 w; w.x = cvt_pk_bf16(v[0], v[1]); w.y = cvt_pk_bf16(v[2], v[3]); ((u32x2*)(ws + O_CK))[i] = w; }
    __syncthreads();
    for (int it = gw; it < 2 * 16 * 48; it += NGW) {
        const int l = it / 768, rem = it % 768, dch = rem / 48, cb = rem % 48, j0 = cb * 256 + lane * 4, d0 = dch * 128;
        for (int i = lane; i < NCOND * 128; i += 64) { const int cond = i >> 7, d = i & 127; const float x = cond == 0 ? a.in[I_CCTX][d0 + d] : a.in[I_C][(size_t)(cond - 1) * DM + d0 + d]; scr[i] = x * sigmoidf_(x); }
        LDS_WAIT(); asm volatile("" ::: "memory");
        f32x4 acc[NCOND];
#pragma unroll
        for (int c = 0; c < NCOND; ++c) acc[c] = (f32x4){0.f, 0.f, 0.f, 0.f};
        const float* wp = a.in[I_WADA] + ((size_t)l * DM + d0) * 12288 + j0;
#pragma unroll 1
        for (int d0b = 0; d0b < 128; d0b += 16) {
            f32x4 w[16];
#pragma unroll
            for (int u = 0; u < 16; ++u) w[u] = *(const f32x4*)(wp + (size_t)(d0b + u) * 12288);
#pragma unroll
            for (int u = 0; u < 16; ++u)
#pragma unroll
                for (int c = 0; c < NCOND; ++c) acc[c] += w[u] * scr[c * 128 + d0b + u]; }
#pragma unroll
        for (int c = 0; c < NCOND; ++c) *(f32x4*)((float*)(ws + O_MODP) + ((size_t)(dch * 2 + l) * NCOND + c) * 12288 + j0) = acc[c];
        LDS_WAIT(); asm volatile("" ::: "memory");
    }
}

__device__ __forceinline__ void phase_p1_modreduce(const Args& a, int tid, int G, int bid) {
    const int gt = bid * 512 + tid, NGT = G * 512;
    const float* P = (const float*)(a.ws + O_MODP); float* M = (float*)(a.ws + O_MOD);
    for (int i = gt; i < 2 * NCOND * 2048; i += NGT) {
        const int l = i / (NCOND * 2048), cond = (i / 2048) % NCOND, col = i & 2047;
        float m[6];
#pragma unroll
        for (int s = 0; s < 6; ++s) { float v = a.in[I_BADA][l * 12288 + s * 2048 + col];
            for (int dch = 0; dch < 16; ++dch) v += P[((size_t)(dch * 2 + l) * NCOND + cond) * 12288 + s * 2048 + col];
            m[s] = v; }
        float* o = M + ((size_t)(l * NCOND + cond) * 6) * 2048 + col;
        o[0] = a.in[I_N1G][l * 2048 + col] * (1.f + m[1]); o[2048] = m[0]; o[2 * 2048] = m[2];
        o[3 * 2048] = a.in[I_N2G][l * 2048 + col] * (1.f + m[4]); o[4 * 2048] = m[3]; o[5 * 2048] = m[5];
    }
}

__device__ __forceinline__ void phase_norm(const Args& a, int l, int which, bool from_input, int lane, int wave, int G, int bid) {
    const int gw = bid * 8 + wave, NGW = G * 8;
    bf16_t* H = (bf16_t*)(a.ws + O_H);
    const int chunk = (NTOK + NGW - 1) / NGW;
    int row = gw * chunk; const int rend = (row + chunk) < NTOK ? (row + chunk) : NTOK;
    if (row >= rend) return;
#define NORM_XPTR(r) (from_input ? ((r) < NCTXT ? a.in[I_XP] + (size_t)(r) * DM : a.in[I_XS] + (size_t)((r) - NCTXT) * DM) : a.out + (size_t)(r) * DM)
    f32x4 v[8], av[8], sv[8]; int ccond = -1;
    { const float* xr = NORM_XPTR(row);
#pragma unroll
      for (int j = 0; j < 8; ++j) v[j] = *(const f32x4*)(xr + j * 256 + lane * 4); }
    for (; row < rend; ++row) {
        f32x4 vn[8];
        if (row + 1 < rend) { const float* xr = NORM_XPTR(row + 1);
#pragma unroll
            for (int j = 0; j < 8; ++j) vn[j] = *(const f32x4*)(xr + j * 256 + lane * 4); }
        const int cond = row < NCTXT ? 0 : 1 + ((row - NCTXT) >> 10);
        if (cond != ccond) { ccond = cond; const float* ap = (const float*)(a.ws + O_MOD) + ((size_t)(l * NCOND + cond) * 6 + which) * 2048;
#pragma unroll
            for (int j = 0; j < 8; ++j) { av[j] = *(const f32x4*)(ap + j * 256 + lane * 4); sv[j] = *(const f32x4*)(ap + 2048 + j * 256 + lane * 4); } }
        float s = 0.f;
#pragma unroll
        for (int j = 0; j < 8; ++j) s += (v[j][0] * v[j][0] + v[j][1] * v[j][1]) + (v[j][2] * v[j][2] + v[j][3] * v[j][3]);
        const float r = rsqrtf(wave_sum(s) * (1.0f / DM) + 1e-6f);
#pragma unroll
        for (int j = 0; j < 8; ++j) { const f32x4 o = v[j] * r * av[j] + sv[j]; u32x2 w; w.x = cvt_pk_bf16(o[0], o[1]); w.y = cvt_pk_bf16(o[2], o[3]);
            *(u32x2*)(H + (size_t)row * DM + j * 256 + lane * 4) = w; }
#pragma unroll
        for (int j = 0; j < 8; ++j) v[j] = vn[j];
    }
#undef NORM_XPTR
}

template <bool SCALE>
__device__ __forceinline__ void transpose128(const bf16_t* src, int ld_src, bf16_t* dst, int ld_dst, LAS unsigned char* lds, int tid, const LAS float* rtab, const float* gvec) {
    LAS bf16_t* T = (LAS bf16_t*)lds;
    u32x4 vv[4];
#pragma unroll
    for (int j = 0; j < 4; ++j) { const int ch = tid + j * 512, row = ch >> 4, cc = ch & 15; vv[j] = *(const u32x4*)(src + (size_t)row * ld_src + cc * 8); }
    f32x4 g0 = {0.f, 0.f, 0.f, 0.f}, g1 = {0.f, 0.f, 0.f, 0.f};
    if (SCALE) { const int cc = tid & 15; g0 = *(const f32x4*)(gvec + cc * 8); g1 = *(const f32x4*)(gvec + cc * 8 + 4); }
#pragma unroll
    for (int j = 0; j < 4; ++j) { const int ch = tid + j * 512, row = ch >> 4, cc = ch & 15;
        u32x4 v = vv[j];
        if (SCALE) { const float r = rtab[row];
            v.x = cvt_pk_bf16(bflo(v.x) * r * g0[0], bfhi(v.x) * r * g0[1]); v.y = cvt_pk_bf16(bflo(v.y) * r * g0[2], bfhi(v.y) * r * g0[3]);
            v.z = cvt_pk_bf16(bflo(v.z) * r * g1[0], bfhi(v.z) * r * g1[1]); v.w = cvt_pk_bf16(bflo(v.w) * r * g1[2], bfhi(v.w) * r * g1[3]); }
        *(LAS u32x4*)(T + row * 136 + cc * 8) = v; }
    __syncthreads();
#pragma unroll
    for (int j = 0; j < 4; ++j) { const int ch = tid + j * 512, c = ch & 127, qc = ch >> 7;
        unsigned short e[8];
#pragma unroll
        for (int k = 0; k < 8; ++k) e[k] = T[(qc * 8 + k) * 136 + c];
        u32x4 o; o.x = e[0] | ((unsigned)e[1] << 16); o.y = e[2] | ((unsigned)e[3] << 16); o.z = e[4] | ((unsigned)e[5] << 16); o.w = e[6] | ((unsigned)e[7] << 16);
        *(u32x4*)(dst + (size_t)c * ld_dst + qc * 8) = o; }
    __syncthreads();
}

template <int W>
__device__ __forceinline__ void pool_rows(const bf16_t* base, bf16_t* outp, int pos0, int npos, int tl0, int tsub) {
#pragma unroll 2
    for (int it = 0; it < 16; ++it) {
        const int tl = tl0 + it * 4 + tsub, pos = pos0 + tl;
        int lo = pos - (W >> 1); if (lo < 0) lo = 0; int hi = pos + (W >> 1) - 1; if (hi > npos - 1) hi = npos - 1;
        u32x4 x[W];
#pragma unroll
        for (int j = 0; j < W; ++j) { int p = pos - (W >> 1) + j; p = p < lo ? lo : (p > hi ? hi : p); x[j] = *(const u32x4*)(base + (size_t)p * 4096); }
        float s[8] = {0.f, 0.f, 0.f, 0.f, 0.f, 0.f, 0.f, 0.f};
#pragma unroll
        for (int j = 0; j < W; ++j) { const int p = pos - (W >> 1) + j; const float wgt = (p >= lo && p <= hi) ? 1.f : 0.f;
            s[0] += wgt * bflo(x[j].x); s[1] += wgt * bfhi(x[j].x); s[2] += wgt * bflo(x[j].y); s[3] += wgt * bfhi(x[j].y);
            s[4] += wgt * bflo(x[j].z); s[5] += wgt * bfhi(x[j].z); s[6] += wgt * bflo(x[j].w); s[7] += wgt * bfhi(x[j].w); }
        const u32x4 xc = x[W >> 1]; const float inv = 1.0f / (float)(hi - lo + 1);
        u32x4 o; o.x = cvt_pk_bf16(s[0] * inv - bflo(xc.x), s[1] * inv - bfhi(xc.x)); o.y = cvt_pk_bf16(s[2] * inv - bflo(xc.y), s[3] * inv - bfhi(xc.y));
        o.z = cvt_pk_bf16(s[4] * inv - bflo(xc.z), s[5] * inv - bfhi(xc.z)); o.w = cvt_pk_bf16(s[6] * inv - bflo(xc.w), s[7] * inv - bfhi(xc.w));
        *(u32x4*)(outp + (size_t)tl * 2048) = o;
    }
}

__device__ __forceinline__ void phase_prep(const Args& a, int l, LAS unsigned char* lds, int tid, int lane, int wave, int G, int bid) {
    unsigned char* ws = a.ws;
    const bf16_t* Zm = (const bf16_t*)(ws + O_ZM);
    unsigned* qctr = (unsigned*)(ws + O_CTL) + 64 * (8 + l);
    LAS int* qslot = (LAS int*)(lds + 131072 + 128);
    for (;;) {
        __syncthreads();
        if (tid == 0) *qslot = (int)atomicAdd(qctr, 1u);
        __syncthreads();
        const int qi = *qslot; if (qi >= 96 * 6) break;
        const int ord = qi / 96, tt = qi % 96; const int task = ord == 0 ? 0 : (ord == 1 ? 5 : ord - 1);
        const bool ctx = tt < 32; const int bb = ctx ? (tt >> 1) : ((tt - 32) >> 3); const int pos0 = ctx ? (tt & 1) * 128 : ((tt - 32) & 7) * 128; const int npos = ctx ? 256 : 1024;
        const int tok0 = tt * 128;
        if (task == 0) {
            const int j = lane & 7, hd = lane >> 3;
            const f32x4 gq0 = *(const f32x4*)(a.in[I_QNG] + l * 64 + j * 8), gq1 = *(const f32x4*)(a.in[I_QNG] + l * 64 + j * 8 + 4);
            const f32x4 gk0 = *(const f32x4*)(a.in[I_KNG] + l * 64 + j * 8), gk1 = *(const f32x4*)(a.in[I_KNG] + l * 64 + j * 8 + 4);
            const int ax = j >> 2; const bool isx2 = (j & 2) != 0; const int i0 = (j & 1) * 8;
            float invf[8];
#pragma unroll
            for (int e = 0; e < 8; ++e) invf[e] = __builtin_amdgcn_exp2f(-(float)(i0 + e) * (13.287712379549449f / 16.0f));
#pragma unroll 1
            for (int tb = 0; tb < 4; ++tb) {
                u32x4 qw4[4], kw4[4];
#pragma unroll
                for (int u = 0; u < 4; ++u) { const int tok = tok0 + wave * 16 + tb * 4 + u; qw4[u] = *(const u32x4*)(Zm + (size_t)tok * 4096 + lane * 8); kw4[u] = *(const u32x4*)(Zm + (size_t)tok * 4096 + 512 + lane * 8); }
#pragma unroll
                for (int u = 0; u < 4; ++u) {
                    const int tl = wave * 16 + tb * 4 + u, tok = tok0 + tl, pos = pos0 + tl;
                    const u32x4 qw = qw4[u], kw = kw4[u];
                    float q[8] = {bflo(qw.x), bfhi(qw.x), bflo(qw.y), bfhi(qw.y), bflo(qw.z), bfhi(qw.z), bflo(qw.w), bfhi(qw.w)};
                    float k[8] = {bflo(kw.x), bfhi(kw.x), bflo(kw.y), bfhi(kw.y), bflo(kw.z), bfhi(kw.z), bflo(kw.w), bfhi(kw.w)};
                    float sq = 0.f, sk = 0.f;
#pragma unroll
                    for (int e = 0; e < 8; ++e) { sq += q[e] * q[e]; sk += k[e] * k[e]; }
                    sq += __shfl_xor(sq, 1); sq += __shfl_xor(sq, 2); sq += __shfl_xor(sq, 4);
                    sk += __shfl_xor(sk, 1); sk += __shfl_xor(sk, 2); sk += __shfl_xor(sk, 4);
                    const float rq = rsqrtf(sq * (1.f / 64.f) + 1e-6f), rk = rsqrtf(sk * (1.f / 64.f) + 1e-6f);
#pragma unroll
                    for (int e = 0; e < 8; ++e) { q[e] *= rq * (e < 4 ? gq0[e & 3] : gq1[e & 3]); k[e] *= rk * (e < 4 ? gk0[e & 3] : gk1[e & 3]); }
                    { u32x4 o; o.x = cvt_pk_bf16(q[0] * 0.125f, q[1] * 0.125f); o.y = cvt_pk_bf16(q[2] * 0.125f, q[3] * 0.125f); o.z = cvt_pk_bf16(q[4] * 0.125f, q[5] * 0.125f); o.w = cvt_pk_bf16(q[6] * 0.125f, q[7] * 0.125f);
                      *(u32x4*)((bf16_t*)(ws + O_QP) + (size_t)tok * 512 + lane * 8) = o; }
                    if (ctx) {
                        u32x4 o; o.x = cvt_pk_bf16(k[0], k[1]); o.y = cvt_pk_bf16(k[2], k[3]); o.z = cvt_pk_bf16(k[4], k[5]); o.w = cvt_pk_bf16(k[6], k[7]);
                        *(u32x4*)((bf16_t*)(ws + O_KB) + (size_t)tok * 512 + lane * 8) = o;
                        float* ok = a.out + OUTK + ((((size_t)bb * 2 + l) * 8 + hd) * 256 + pos) * 64 + j * 8;
                        *(f32x4*)ok = (f32x4){k[0], k[1], k[2], k[3]}; *(f32x4*)(ok + 4) = (f32x4){k[4], k[5], k[6], k[7]};
                    } else {
                        const float p = (float)(ax == 0 ? (pos >> 6) : (pos & 63));
                        float qr[8], kr[8];
#pragma unroll
                        for (int e = 0; e < 8; ++e) {
                            const float ang = p * invf[e]; const float cs = __cosf(ang), sn = __sinf(ang);
                            const float pq = __shfl_xor(q[e], 2), pk = __shfl_xor(k[e], 2);
                            qr[e] = q[e] * cs + (isx2 ? pq : -pq) * sn; kr[e] = k[e] * cs + (isx2 ? pk : -pk) * sn;
                        }
                        u32x4 o; o.x = cvt_pk_bf16(qr[0] * 0.125f, qr[1] * 0.125f); o.y = cvt_pk_bf16(qr[2] * 0.125f, qr[3] * 0.125f); o.z = cvt_pk_bf16(qr[4] * 0.125f, qr[5] * 0.125f); o.w = cvt_pk_bf16(qr[6] * 0.125f, qr[7] * 0.125f);
                        *(u32x4*)((bf16_t*)(ws + O_QR) + (size_t)(tok - NCTXT) * 512 + lane * 8) = o;
                        u32x4 o2; o2.x = cvt_pk_bf16(kr[0], kr[1]); o2.y = cvt_pk_bf16(kr[2], kr[3]); o2.z = cvt_pk_bf16(kr[4], kr[5]); o2.w = cvt_pk_bf16(kr[6], kr[7]);
                        *(u32x4*)((bf16_t*)(ws + O_KB) + (size_t)tok * 512 + lane * 8) = o2;
                    }
                }
            }
        } else if (task == 1) {
            bf16_t* vt = (bf16_t*)(ws + O_VT) + (ctx ? (size_t)bb * 512 * 256 : (size_t)16 * 512 * 256 + (size_t)bb * 512 * 1024) + pos0;
            if (ctx) {
                const int j = lane & 7, hd = lane >> 3;
#pragma unroll 1
                for (int tb = 0; tb < 2; ++tb) {
                    u32x4 w8[8];
#pragma unroll
                    for (int u = 0; u < 8; ++u) w8[u] = *(const u32x4*)(Zm + (size_t)(tok0 + wave * 16 + tb * 8 + u) * 4096 + 1024 + lane * 8);
#pragma unroll
                    for (int u = 0; u < 8; ++u) { const int pos = pos0 + wave * 16 + tb * 8 + u; const u32x4 w = w8[u];
                        float* ov = a.out + OUTV + ((((size_t)bb * 2 + l) * 8 + hd) * 256 + pos) * 64 + j * 8;
                        *(f32x4*)ov = (f32x4){bflo(w.x), bfhi(w.x), bflo(w.y), bfhi(w.y)}; *(f32x4*)(ov + 4) = (f32x4){bflo(w.z), bfhi(w.z), bflo(w.w), bfhi(w.w)}; }
                }
            }
            for (int sub = 0; sub < 4; ++sub)
                transpose128<false>(Zm + (size_t)tok0 * 4096 + 1024 + sub * 128, 4096, vt + (size_t)sub * 128 * npos, npos, lds, tid, nullptr, nullptr);
        } else if (task == 2) {
            LAS float* rtab = (LAS float*)(lds + 40960);
#pragma unroll 1
            for (int tb = 0; tb < 2; ++tb) {
                u32x4 w8[8];
#pragma unroll
                for (int u = 0; u < 8; ++u) w8[u] = *(const u32x4*)(Zm + (size_t)(tok0 + wave * 16 + tb * 8 + u) * 4096 + 2048 + lane * 8);
#pragma unroll
                for (int u = 0; u < 8; ++u) { const u32x4 w = w8[u];
                    float s = bflo(w.x) * bflo(w.x) + bfhi(w.x) * bfhi(w.x) + bflo(w.y) * bflo(w.y) + bfhi(w.y) * bfhi(w.y) + bflo(w.z) * bflo(w.z) + bfhi(w.z) * bfhi(w.z) + bflo(w.w) * bflo(w.w) + bfhi(w.w) * bfhi(w.w);
                    s = wave_sum(s); if (lane == 0) rtab[wave * 16 + tb * 8 + u] = rsqrtf(s * (1.f / 512.f) + 1e-6f); }
            }
            __syncthreads();
            for (int sub = 0; sub < 4; ++sub)
                transpose128<true>(Zm + (size_t)tok0 * 4096 + 2048 + sub * 128, 4096, (bf16_t*)(ws + O_VNT) + ((size_t)tt * 512 + sub * 128) * 128, 128, lds, tid, rtab, a.in[I_GNG] + l * 512 + sub * 128);
        } else if (task == 3 || task == 4) {
            const int part = task - 3;
            bf16_t* tb = (bf16_t*)(ws + O_TT) + (ctx ? (size_t)bb * 512 * 512 : (size_t)16 * 512 * 512 + (size_t)bb * 512 * 2048) + part * npos + pos0;
            for (int sub = 0; sub < 4; ++sub)
                transpose128<false>(Zm + (size_t)tok0 * 4096 + 2560 + part * 512 + sub * 128, 4096, tb + (size_t)sub * 128 * 2 * npos, 2 * npos, lds, tid, nullptr, nullptr);
        } else {
            const int gi = wave & 3, half = wave >> 2, tsub = lane >> 4, c8 = gi * 16 + (lane & 15);
            const bf16_t* base = Zm + (size_t)(tok0 - pos0) * 4096 + 3584 + c8 * 8;
            bf16_t* outp = (bf16_t*)(ws + O_BR) + (size_t)tok0 * 2048 + 1536 + c8 * 8;
            if (gi == 0) pool_rows<2>(base, outp, pos0, npos, half * 64, tsub);
            else if (gi == 1) pool_rows<4>(base, outp, pos0, npos, half * 64, tsub);
            else if (gi == 2) pool_rows<8>(base, outp, pos0, npos, half * 64, tsub);
            else pool_rows<16>(base, outp, pos0, npos, half * 64, tsub);
        }
    }
}

#define MFMA16(a, b, c) __builtin_amdgcn_mfma_f32_16x16x32_bf16(a, b, c, 0, 0, 0)
struct KVF { bf16x8 k[4]; bf16x8 v[4]; };
struct KVOff { unsigned k0, k1, v[4]; };
__device__ __forceinline__ KVOff kv_off(int ldk, int ldv, int lane) {
    const int i = lane & 15, g = lane >> 4; const int ko0 = 8 * (i >> 2) + (i & 3);
    KVOff o; o.k0 = (unsigned)(ko0 * ldk + 8 * g) * 2u; o.k1 = o.k0 + (unsigned)(4 * ldk) * 2u;
#pragma unroll
    for (int dt = 0; dt < 4; ++dt) o.v[dt] = (unsigned)((16 * dt + i) * ldv + 8 * g) * 2u;
    return o;
}
__device__ __forceinline__ void kv_load(KVF& f, const bf16_t* kp, const bf16_t* vp, const KVOff& o) {
    const char* kc = (const char*)kp; const char* vc = (const char*)vp;
    f.k[0] = *(const bf16x8*)(kc + o.k0); f.k[1] = *(const bf16x8*)(kc + o.k0 + 64); f.k[2] = *(const bf16x8*)(kc + o.k1); f.k[3] = *(const bf16x8*)(kc + o.k1 + 64);
#pragma unroll
    for (int dt = 0; dt < 4; ++dt) f.v[dt] = *(const bf16x8*)(vc + o.v[dt]);
}
struct QSt { f32x4 o[4]; float m, lsum; };
__device__ __forceinline__ void attn_step(const KVF& f, const bf16x8 (&qf)[2], const float (&sb)[8], bool use_sb, QSt& st) {
    f32x4 s0 = {0.f, 0.f, 0.f, 0.f}, s1 = {0.f, 0.f, 0.f, 0.f};
    s0 = MFMA16(f.k[0], qf[0], s0); s0 = MFMA16(f.k[1], qf[1], s0);
    s1 = MFMA16(f.k[2], qf[0], s1); s1 = MFMA16(f.k[3], qf[1], s1);
    float s[8] = {s0[0], s0[1], s0[2], s0[3], s1[0], s1[1], s1[2], s1[3]};
    if (use_sb) {
#pragma unroll
        for (int e = 0; e < 8; ++e) s[e] = sb[e] < -1e29f ? -3e30f : s[e] + sb[e];
    }
    float mx = fmaxf(fmaxf(fmaxf(s[0], s[1]), fmaxf(s[2], s[3])), fmaxf(fmaxf(s[4], s[5]), fmaxf(s[6], s[7])));
    mx = fmaxf(mx, __shfl_xor(mx, 16)); mx = fmaxf(mx, __shfl_xor(mx, 32));
    const float mn = fmaxf(st.m, mx); const float alpha = fast_exp(st.m - mn); st.m = mn;
    float ps = 0.f;
#pragma unroll
    for (int e = 0; e < 8; ++e) { s[e] = fast_exp(s[e] - mn); ps += s[e]; }
    st.lsum = st.lsum * alpha + ps;
#pragma unroll
    for (int dt = 0; dt < 4; ++dt) st.o[dt] *= alpha;
    u32x4 pw; pw.x = cvt_pk_bf16(s[0], s[1]); pw.y = cvt_pk_bf16(s[2], s[3]); pw.z = cvt_pk_bf16(s[4], s[5]); pw.w = cvt_pk_bf16(s[6], s[7]);
    const bf16x8 pf = __builtin_bit_cast(bf16x8, pw);
#pragma unroll
    for (int dt = 0; dt < 4; ++dt) st.o[dt] = MFMA16(f.v[dt], pf, st.o[dt]);
}
__device__ __forceinline__ void attn_step2(const KVF& f0, const KVF& f1, const bf16x8 (&qf)[2], QSt& st) {
    f32x4 s0 = {0.f, 0.f, 0.f, 0.f}, s1 = {0.f, 0.f, 0.f, 0.f}, s2 = {0.f, 0.f, 0.f, 0.f}, s3 = {0.f, 0.f, 0.f, 0.f};
    s0 = MFMA16(f0.k[0], qf[0], s0); s1 = MFMA16(f0.k[2], qf[0], s1); s2 = MFMA16(f1.k[0], qf[0], s2); s3 = MFMA16(f1.k[2], qf[0], s3);
    s0 = MFMA16(f0.k[1], qf[1], s0); s1 = MFMA16(f0.k[3], qf[1], s1); s2 = MFMA16(f1.k[1], qf[1], s2); s3 = MFMA16(f1.k[3], qf[1], s3);
    float s[16] = {s0[0], s0[1], s0[2], s0[3], s1[0], s1[1], s1[2], s1[3], s2[0], s2[1], s2[2], s2[3], s3[0], s3[1], s3[2], s3[3]};
    float mx = fmaxf(fmaxf(fmaxf(s[0], s[1]), fmaxf(s[2], s[3])), fmaxf(fmaxf(s[4], s[5]), fmaxf(s[6], s[7])));
    mx = fmaxf(mx, fmaxf(fmaxf(fmaxf(s[8], s[9]), fmaxf(s[10], s[11])), fmaxf(fmaxf(s[12], s[13]), fmaxf(s[14], s[15]))));
    mx = fmaxf(mx, __shfl_xor(mx, 16)); mx = fmaxf(mx, __shfl_xor(mx, 32));
    const float mn = fmaxf(st.m, mx); const float alpha = fast_exp(st.m - mn); st.m = mn;
    float ps = 0.f;
#pragma unroll
    for (int e = 0; e < 16; ++e) { s[e] = fast_exp(s[e] - mn); ps += s[e]; }
    st.lsum = st.lsum * alpha + ps;
#pragma unroll
    for (int dt = 0; dt < 4; ++dt) st.o[dt] *= alpha;
    u32x4 pw0, pw1; pw0.x = cvt_pk_bf16(s[0], s[1]); pw0.y = cvt_pk_bf16(s[2], s[3]); pw0.z = cvt_pk_bf16(s[4], s[5]); pw0.w = cvt_pk_bf16(s[6], s[7]);
    pw1.x = cvt_pk_bf16(s[8], s[9]); pw1.y = cvt_pk_bf16(s[10], s[11]); pw1.z = cvt_pk_bf16(s[12], s[13]); pw1.w = cvt_pk_bf16(s[14], s[15]);
    const bf16x8 pf0 = __builtin_bit_cast(bf16x8, pw0), pf1 = __builtin_bit_cast(bf16x8, pw1);
#pragma unroll
    for (int dt = 0; dt < 4; ++dt) { st.o[dt] = MFMA16(f0.v[dt], pf0, st.o[dt]); st.o[dt] = MFMA16(f1.v[dt], pf1, st.o[dt]); }
}
__device__ __forceinline__ void attn_store(const QSt& st0, bf16_t* op) {
    QSt st = st0; st.lsum += __shfl_xor(st.lsum, 16); st.lsum += __shfl_xor(st.lsum, 32);
    const float inv = 1.0f / st.lsum;
#pragma unroll
    for (int dt = 0; dt < 4; ++dt) { u32x2 w2; w2.x = cvt_pk_bf16(st.o[dt][0] * inv, st.o[dt][1] * inv); w2.y = cvt_pk_bf16(st.o[dt][2] * inv, st.o[dt][3] * inv); *(u32x2*)(op + 16 * dt) = w2; }
}
__device__ __forceinline__ void local_bias(float (&sb)[8], const LAS float* tab, int dr, int kc0, int g, int cq, int cs) {
    asm volatile("" : "+v"(g));
#pragma unroll
    for (int e = 0; e < 8; ++e) { const int kc = kc0 + 8 * g + e; const bool vis = (kc >= cs) && (kc < cs + 16);
        const float bv = tab[dr * 32 + (vis ? (kc - cq + 15) : 15)]; sb[e] = vis ? bv : -1e30f; }
}

__device__ __forceinline__ void attn_item(const Args& a, int l, int item, int lane, LAS float* tab) {
    unsigned char* ws = a.ws;
    const int q = lane & 15, g = lane >> 4;
    QSt sA, sB;
#pragma unroll
    for (int dt = 0; dt < 4; ++dt) { sA.o[dt] = (f32x4){0.f, 0.f, 0.f, 0.f}; sB.o[dt] = (f32x4){0.f, 0.f, 0.f, 0.f}; }
    sA.m = -1e30f; sA.lsum = 0.f; sB.m = -1e30f; sB.lsum = 0.f;
    float nb0[8];
    int tokq, h;
    if (item < 2048) {
        const int bb = item >> 8; h = (item >> 5) & 7; const int r = (item >> 1) & 15, p = item & 1;
        tokq = NCTXT + bb * 1024 + r * 64 + 32 * p + q;
        bf16x8 qA[2], qB[2];
        { const bf16_t* pp = (const bf16_t*)(ws + O_QP) + (size_t)tokq * 512 + h * 64 + 8 * g; qA[0] = *(const bf16x8*)pp; qA[1] = *(const bf16x8*)(pp + 32); qB[0] = *(const bf16x8*)(pp + 16 * 512); qB[1] = *(const bf16x8*)(pp + 16 * 512 + 32); }
        const bf16_t* ck = (const bf16_t*)(ws + O_CK) + (((size_t)bb * 2 + l) * 8 + h) * 512 * 64;
        const bf16_t* cv = (const bf16_t*)(ws + O_VTC) + (((size_t)bb * 2 + l) * 8 + h) * 64 * 512;
        int rs = r - 4; if (rs < 0) rs = 0; if (rs > 8) rs = 8;
        const int cqA = 32 * p + q, cqB = cqA + 16; int csA = cqA - 8; if (csA < 0) csA = 0; if (csA > 48) csA = 48; int csB = cqB - 8; if (csB < 0) csB = 0; if (csB > 48) csB = 48;
        { const float* rpb = a.in[I_RPB] + (size_t)(l * 8 + h) * 15 * 31;
          float tv[8];
#pragma unroll
          for (int u = 0; u < 8; ++u) { const int i = lane + 64 * u; tv[u] = i < 465 ? rpb[i] : 0.f; }
#pragma unroll
          for (int u = 0; u < 8; ++u) { const int i = lane + 64 * u; if (i < 465) { const int rr = (i * 2115) >> 16; tab[rr * 32 + (i - rr * 31)] = tv[u]; } } }
        const bf16_t* kl = (const bf16_t*)(ws + O_KB) + (size_t)(NCTXT + bb * 1024) * 512 + h * 64;
        const bf16_t* vl = (const bf16_t*)(ws + O_VT) + (size_t)16 * 512 * 256 + ((size_t)bb * 512 + h * 64) * 1024;
        KVF f0, f1; KVOff oc = kv_off(64, 512, lane);
#pragma unroll 1
        for (int kb = 0; kb < 16; kb += 2) {
            kv_load(f0, ck + (size_t)kb * 32 * 64, cv + kb * 32, oc);
            kv_load(f1, ck + (size_t)(kb + 1) * 32 * 64, cv + (kb + 1) * 32, oc);
            attn_step2(f0, f1, qA, sA); attn_step2(f0, f1, qB, sB);
        }
        { const bf16_t* p2 = (const bf16_t*)(ws + O_QR) + (size_t)(tokq - NCTXT) * 512 + h * 64 + 8 * g; qA[0] = *(const bf16x8*)p2; qA[1] = *(const bf16x8*)(p2 + 32); qB[0] = *(const bf16x8*)(p2 + 16 * 512); qB[1] = *(const bf16x8*)(p2 + 16 * 512 + 32); }
        oc = kv_off(512, 1024, lane);
        const int kcA = (32 * p - 8) < 0 ? 0 : (32 * p - 8), kcB = (32 * p + 8) > 32 ? 32 : (32 * p + 8);
#pragma unroll 1
        for (int wi = 0; wi < 8; ++wi) {
            const int dr = rs + wi - r + 7; const int key0 = (rs + wi) * 64;
            kv_load(f0, kl + (size_t)(key0 + kcA) * 512, vl + key0 + kcA, oc);
            kv_load(f1, kl + (size_t)(key0 + kcB) * 512, vl + key0 + kcB, oc);
            local_bias(nb0, tab, dr, kcA, g, cqA, csA); attn_step(f0, qA, nb0, true, sA);
            local_bias(nb0, tab, dr, kcB, g, cqB, csB); attn_step(f1, qB, nb0, true, sB);
        }
    } else {
        const int it = item - 2048; const int bb = it >> 6; h = (it >> 3) & 7; const int qb = it & 7;
        tokq = bb * 256 + qb * 32 + q;
        bf16x8 qpA[2], qpB[2];
        { const bf16_t* pp = (const bf16_t*)(ws + O_QP) + (size_t)tokq * 512 + h * 64 + 8 * g; qpA[0] = *(const bf16x8*)pp; qpA[1] = *(const bf16x8*)(pp + 32); qpB[0] = *(const bf16x8*)(pp + 16 * 512); qpB[1] = *(const bf16x8*)(pp + 16 * 512 + 32); }
        const bf16_t* kl = (const bf16_t*)(ws + O_KB) + (size_t)(bb * 256) * 512 + h * 64;
        const bf16_t* vl = (const bf16_t*)(ws + O_VT) + ((size_t)bb * 512 + h * 64) * 256;
        KVF f0, f1; const KVOff oc = kv_off(512, 256, lane);
#pragma unroll 1
        for (int kb = 0; kb < 8; kb += 2) {
            kv_load(f0, kl + (size_t)kb * 32 * 512, vl + kb * 32, oc);
            kv_load(f1, kl + (size_t)(kb + 1) * 32 * 512, vl + (kb + 1) * 32, oc);
            attn_step2(f0, f1, qpA, sA); attn_step2(f0, f1, qpB, sB);
        }
    }
    bf16_t* op = (bf16_t*)(ws + O_BR) + (size_t)tokq * 2048 + h * 64 + 4 * g;
    attn_store(sA, op); attn_store(sB, op + (size_t)16 * 2048);
}

__device__ __forceinline__ void gmlp_item(const Args& a, int l, int item, int lane) {
    unsigned char* ws = a.ws;
    const int tt = item >> 4, gg = (item >> 2) & 3, pb = item & 3;
    const int i = lane & 15, g = lane >> 4;
    const bf16_t* A = (const bf16_t*)(ws + O_VNT) + ((size_t)tt * 512 + gg * 128) * 128;
    const bf16_t* B = (const bf16_t*)(ws + O_WSB) + ((size_t)(l * 4 + gg) * 128 + pb * 32) * 128;
    f32x4 acc[8][2];
#pragma unroll
    for (int mi = 0; mi < 8; ++mi) { acc[mi][0] = (f32x4){0.f, 0.f, 0.f, 0.f}; acc[mi][1] = (f32x4){0.f, 0.f, 0.f, 0.f}; }
    const unsigned offA = (unsigned)(i * 128 + 8 * g) * 2u, offB = offA;
    const char* Ac = (const char*)A; const char* Bc = (const char*)B;
#define GM_LOAD(af, b0, b1, ks) do { b0 = *(const bf16x8*)(Bc + offB + (ks) * 64); b1 = *(const bf16x8*)(Bc + offB + 16 * 256 + (ks) * 64); \
        _Pragma("unroll") for (int mi = 0; mi < 8; ++mi) af[mi] = *(const bf16x8*)(Ac + offA + mi * 16 * 256 + (ks) * 64); } while (0)
#define GM_MMA(af, b0, b1) do { _Pragma("unroll") for (int mi = 0; mi < 8; ++mi) { acc[mi][0] = MFMA16(af[mi], b0, acc[mi][0]); acc[mi][1] = MFMA16(af[mi], b1, acc[mi][1]); } } while (0)
    bf16x8 afA[8], afB[4], bA0, bA1, bB0, bB1;
#define GM_LOADH(af, b0, b1, ks) do { b0 = *(const bf16x8*)(Bc + offB + (ks) * 64); b1 = *(const bf16x8*)(Bc + offB + 16 * 256 + (ks) * 64); \
        _Pragma("unroll") for (int mi = 0; mi < 4; ++mi) af[mi] = *(const bf16x8*)(Ac + offA + mi * 16 * 256 + (ks) * 64); } while (0)
#define GM_STEP(ks, last) do { \
        _Pragma("unroll") for (int mi = 0; mi < 4; ++mi) afA[mi] = afB[mi]; bA0 = bB0; bA1 = bB1; \
        _Pragma("unroll") for (int mi = 4; mi < 8; ++mi) afA[mi] = *(const bf16x8*)(Ac + offA + mi * 16 * 256 + (ks) * 64); \
        if (!(last)) GM_LOADH(afB, bB0, bB1, (ks) + 1); \
        GM_MMA(afA, bA0, bA1); } while (0)
    GM_LOADH(afB, bB0, bB1, 0);
    GM_STEP(0, false); GM_STEP(1, false); GM_STEP(2, false); GM_STEP(3, true);
#undef GM_LOADH
#undef GM_STEP
#undef GM_LOAD
#undef GM_MMA
    const bf16_t* Zm = (const bf16_t*)(ws + O_ZM);
#pragma unroll
    for (int nj = 0; nj < 2; ++nj) { const int p = pb * 32 + 16 * nj + i; const int tok = tt * 128 + p; const float bs = a.in[I_BSP][(l * 4 + gg) * 128 + p];
        u32x2 uw[8];
#pragma unroll
        for (int mi = 0; mi < 8; ++mi) uw[mi] = *(const u32x2*)(Zm + (size_t)tok * 4096 + 1536 + gg * 128 + 16 * mi + 4 * g);
#pragma unroll
        for (int mi = 0; mi < 8; ++mi) { const int c = gg * 128 + 16 * mi + 4 * g; const f32x4 v = acc[mi][nj];
            u32x2 ow; ow.x = cvt_pk_bf16(bflo(uw[mi].x) * (v[0] + bs), bfhi(uw[mi].x) * (v[1] + bs)); ow.y = cvt_pk_bf16(bflo(uw[mi].y) * (v[2] + bs), bfhi(uw[mi].y) * (v[3] + bs));
            *(u32x2*)((bf16_t*)(ws + O_BR) + (size_t)tok * 2048 + 512 + c) = ow; } }
}

#define XB_TMO      128
#define XB_XCNT(j)  (256  + 64 * (j))
#define XB_XSUB(j)  (1280 + 64 * (j))
#define XB_XGEN(j)  (2304 + 64 * (j))
#define XB_TOP      3328
#define XB_TOPGEN   3392
#define XCD_BAR_WORDS 3456
#define XB_SPIN_CAP (1u << 22)
constexpr int CW_BAR = 4096, CW_FLAG = 8192;
__device__ __forceinline__ unsigned xb_ld(unsigned* p)              { return __hip_atomic_load(p, __ATOMIC_RELAXED, __HIP_MEMORY_SCOPE_AGENT); }
__device__ __forceinline__ unsigned xb_add(unsigned* p, unsigned v) { return __hip_atomic_fetch_add(p, v, __ATOMIC_RELAXED, __HIP_MEMORY_SCOPE_AGENT); }
__device__ __forceinline__ unsigned xb_xcc_id() { return (unsigned)__builtin_amdgcn_s_getreg((3 << 11) | 20) & 0xFu; }
#define XB_SPIN(cond, bar) do { unsigned _sp = 0; while (cond) { __builtin_amdgcn_s_sleep(1); \
    if ((++_sp & 255u) == 0u) { if (xb_ld(&(bar)[XB_TMO])) break; if (_sp > XB_SPIN_CAP) { atomicAdd(&(bar)[XB_TMO], 1u); break; } } } } while (0)
struct XcdBarrier { unsigned* bar; unsigned x; volatile LAS unsigned* st; };
__device__ __forceinline__ XcdBarrier xcd_barrier_post(unsigned* bar, volatile LAS unsigned* st) {
    XcdBarrier b; b.bar = bar; b.x = xb_xcc_id(); b.st = st;
    if (threadIdx.x == 0) (void)xb_add(&bar[XB_XCNT(b.x)], 1u);
    return b;
}
__device__ __forceinline__ void xcd_barrier_complete(unsigned* bar, unsigned x, unsigned& nloc, unsigned& nx) {
    const unsigned G = gridDim.x * gridDim.y * gridDim.z;
    unsigned sum, cnt, mine, sp = 0u;
    for (;;) {
        sum = 0u; cnt = 0u; mine = 0u;
#pragma unroll
        for (unsigned j = 0; j < 16; ++j) { const unsigned c = xb_ld(&bar[XB_XCNT(j)]); sum += c; cnt += (c > 0u) ? 1u : 0u; mine = (j == x) ? c : mine; }
        if (sum == G) break;
        __builtin_amdgcn_s_sleep(1);
        if ((++sp & 255u) == 0u) { if (xb_ld(&bar[XB_TMO])) break; if (sp > XB_SPIN_CAP) { atomicAdd(&bar[XB_TMO], 1u); break; } }
    }
    nloc = mine > 0u ? mine : 1u; nx = cnt > 0u ? cnt : 1u;
}
__device__ __forceinline__ void xcd_barrier(const XcdBarrier& b) {
    asm volatile("s_waitcnt vmcnt(0)" ::: "memory");
    __syncthreads();
    if (threadIdx.x == 0) {
        unsigned* bar = b.bar;
        __builtin_amdgcn_s_waitcnt(0);
        unsigned nloc = b.st[0], nx = b.st[1];
        if (nloc == 0u) { xcd_barrier_complete(bar, b.x, nloc, nx); b.st[0] = nloc; b.st[1] = nx; }
        const unsigned old = xb_add(&bar[XB_XSUB(b.x)], 1u);
        const unsigned gen = old / nloc;
        if (old + 1u == (gen + 1u) * nloc) {
            __builtin_amdgcn_fence(__ATOMIC_RELEASE, "agent");
            asm volatile("s_waitcnt vmcnt(0)" ::: "memory");
            const unsigned og = xb_add(&bar[XB_TOP], 1u);
            const unsigned tg = og / nx;
            if (og + 1u == (tg + 1u) * nx) xb_add(&bar[XB_TOPGEN], 1u);
            else XB_SPIN(xb_ld(&bar[XB_TOPGEN]) == tg, bar);
            __builtin_amdgcn_fence(__ATOMIC_ACQUIRE, "agent");
            xb_add(&bar[XB_XGEN(b.x)], 1u);
            asm volatile("s_waitcnt vmcnt(0)" ::: "memory");
        } else {
            XB_SPIN(xb_ld(&bar[XB_XGEN(b.x)]) == gen, bar);
            __builtin_amdgcn_fence(__ATOMIC_ACQUIRE, "agent");
            asm volatile("s_waitcnt vmcnt(0)" ::: "memory");
        }
    }
    __syncthreads();
}

__global__ void __launch_bounds__(512, 2) fwd(Args a) {
    extern __shared__ __attribute__((aligned(16))) unsigned char lds_raw[];
    LAS unsigned char* lds = (LAS unsigned char*)lds_raw;
    cg::grid_group grid = cg::this_grid();
    int tid0 = threadIdx.x; const int wave = __builtin_amdgcn_readfirstlane(tid0 >> 6), G = gridDim.x, bid = blockIdx.x;
#define OPQ int tid = tid0; asm volatile("" : "+v"(tid)); const int lane = tid & 63; (void)lane;
    unsigned char* ws = a.ws;
    const int lo = a.ph_lo, hi = a.ph_hi;
    int ph = 0;
#ifndef EN
#define EN 0xFFFF
#endif
#define RUN(k) ((k) >= lo && (k) < hi)
#define ENB(t) if constexpr ((EN >> (t)) & 1)
#ifndef DUP
#define DUP 0
#endif
#define REP(t) _Pragma("nounroll") for (int rep = 0; rep < ((((DUP) >> (t)) & 1) ? 2 : 1); ++rep)
#define REPSYNC(t) do { if (((((DUP) >> (t)) & 1)) && rep == 0) xcd_barrier(xbar); } while (0)
#define SEAM(k) do { if ((k) + 1 < hi) xcd_barrier(xbar); } while (0)

    const bool ksplit = (G == 256) && (hi - lo > 1);
    XcdBarrier xbar; xbar.bar = (unsigned*)(ws + O_CTL) + CW_BAR; xbar.x = 0; xbar.st = (volatile LAS unsigned*)(lds + 131072 + 64);
    if (hi - lo > 1) {
        if (tid0 < 2) xbar.st[tid0] = 0u;
        if (bid == 0) { for (int i = tid0; i < XCD_BAR_WORDS; i += 512) xbar.bar[i] = 0u; if (tid0 < 16) ((unsigned*)(ws + O_CTL))[64 * tid0] = 0u; if (tid0 < 32) ((unsigned*)(ws + O_CTL))[1024 + 64 * tid0] = 0u;
            for (int i = tid0; i < 12288; i += 512) ((unsigned*)(ws + O_CTL))[CW_FLAG + i] = 0u; }
        grid.sync();
        xbar = xcd_barrier_post(xbar.bar, xbar.st);
    }
    if (RUN(0)) { REP(0) { ENB(0) { OPQ phase_p0(a, lds, tid, lane, wave, G, bid); } REPSYNC(0); } SEAM(0); }
    if (RUN(1)) { ENB(1) {
#pragma nounroll
        for (int pass = 0; pass < 2; ++pass) {
            pg8::SchedFold S{(const char*)(ws + (pass ? O_WBD : O_CS)), (const char*)(ws + (pass ? O_BDP : O_WFN)), pass, pass ? bid - 64 : bid};
            pg8::EpiStore E{(bf16_t*)(ws + (pass ? O_WBT : O_WINT)), 2048};
            pg8::gemm_phase(lds, pass ? 512 : 256, pass ? 512 : 128, pass ? 512 : 256, S, E); }
        { OPQ phase_p1_modreduce(a, tid, G, bid); } }
        SEAM(1);
    }
    for (int l = 0; l < 2; ++l) {
        const int p0 = 2 + 9 * l;
        const float* mod_l = (const float*)(ws + O_MOD) + (size_t)l * NCOND * 6 * 2048;
        if (RUN(p0 + 0)) {
#ifdef EXP_NANFILL
            { OPQ for (int i = bid * 512 + tid; i < 12288 * 1024; i += G * 512) ((u32x4*)(ws + O_ZG))[i] = (u32x4){0x7fc07fc0u, 0x7fc07fc0u, 0x7fc07fc0u, 0x7fc07fc0u}; }
#endif
            REP(2) { ENB(2) { OPQ phase_norm(a, l, 0, l == 0, lane, wave, G, bid); } REPSYNC(2); } SEAM(p0 + 0); }
        if (RUN(p0 + 1)) { REP(3) { ENB(3) {
            pg8::SchedMN S{(const char*)(ws + O_H), (const char*)(ws + O_WINT) + (size_t)l * 12288 * 2048 * 2, 2048, 2048, 48, 48, G, bid, 0, 48 * 48, 0, 0, 0, 0};
            pg8::EpiZ E{(bf16_t*)(ws + O_ZM), (bf16_t*)(ws + O_ZG), a.in[I_BGATE] + (size_t)l * 8192};
            pg8::gemm_phase(lds, 2048, 2048, 2048, S, E); } REPSYNC(3); }
            SEAM(p0 + 1);
        }
        if (RUN(p0 + 2)) { REP(4) { ENB(4) { OPQ phase_prep(a, l, lds, tid, lane, wave, G, bid); } REPSYNC(4); } SEAM(p0 + 2); }
        if (RUN(p0 + 3)) { REP(5) { ENB(5) {
#pragma nounroll
            for (int pass = 0; pass < 2; ++pass) { const int lat = 1 - pass, Kd = lat ? 2048 : 512;
              pg8::SchedDFT S{(const char*)(ws + (lat ? O_DFT1024 : O_DFT256)), (const char*)(ws + O_TT) + (lat ? (size_t)16 * 512 * 512 * 2 : 0), lat, lat ? bid : bid - 64}; pg8::EpiStore E{(bf16_t*)(ws + O_BR), 2048};
              pg8::gemm_phase(lds, Kd, Kd, Kd, S, E); }
            } ENB(10) { OPQ
            unsigned* cbase = (unsigned*)(ws + O_CTL) + 1024 + (l + 2 * rep) * 8 * 64;
            const int myx = (int)(xb_xcc_id() & 7u);
            constexpr int CPX = (3072 + 1536) / 8;
#pragma unroll 1
            for (int k = 0; k < 8; ++k) {
                const int x = (myx + k) & 7; unsigned* ctr = cbase + x * 64;
                for (;;) {
                    int c = CPX;
                    if (lane == 0) { if (__hip_atomic_load(ctr, __ATOMIC_RELAXED, __HIP_MEMORY_SCOPE_AGENT) < (unsigned)CPX) c = (int)atomicAdd(ctr, 1u); }
                    c = __builtin_amdgcn_readfirstlane(c);
                    if (c >= CPX) break;
                    const int idx = (((c >> 5) * 8 + x) << 5) + (c & 31);
                    if (idx < 3072) attn_item(a, l, idx, lane, (LAS float*)(lds + 131072 + 512 + wave * 1920)); else gmlp_item(a, l, idx - 3072, lane);
                }
            } } REPSYNC(5); }
            SEAM(p0 + 3);
        }
        if (RUN(p0 + 4)) { REP(6) { ENB(6) {
            const int nps = ksplit ? 2 : 1;
#pragma nounroll
            for (int pass = 0; pass < nps; ++pass) {
                pg8::SchedMN S{(const char*)(ws + O_BR), (const char*)(ws + O_WBT) + (size_t)l * DM * DM * 2, 2048, 2048, 48, 8, G, bid, 0, ksplit ? 256 : 384, pass, 256, 128, 1024 * 2};
                pg8::EpiBR E{(const bf16_t*)(ws + O_ZG), (bf16_t*)(ws + O_H), (float*)(ws + O_ZM), (unsigned*)(ws + O_CTL) + CW_FLAG + (4 + l) * 128 * 16};
                pg8::gemm_phase(lds, 2048, 2048, pass ? 1024 : 2048, S, E); } } REPSYNC(6); }
            SEAM(p0 + 4);
        }
        if (RUN(p0 + 5)) { ENB(7) {
            const int nps = ksplit ? 2 : 1;
#pragma nounroll
            for (int pass = 0; pass < nps; ++pass) {
                pg8::SchedMN S{(const char*)(ws + O_H), (const char*)(ws + O_WOT) + (size_t)l * DM * DM * 2, 2048, 2048, 48, 8, G, bid, 0, ksplit ? 256 : 384, pass, 256, 128, 1024 * 2};
                pg8::EpiRes E{l == 0 ? a.in[I_XP] : a.out, l == 0 ? a.in[I_XS] : a.out + (size_t)NCTXT * DM, a.out, mod_l, 2, (float*)(ws + O_ZM), (unsigned*)(ws + O_CTL) + CW_FLAG + (l * 2 + 0) * 128 * 16};
                pg8::gemm_phase(lds, 2048, 2048, pass ? 1024 : 2048, S, E); } }
            SEAM(p0 + 5);
        }
        if (RUN(p0 + 6)) { ENB(2) { OPQ phase_norm(a, l, 3, false, lane, wave, G, bid); } SEAM(p0 + 6); }
        if (RUN(p0 + 7)) { REP(8) { ENB(8) {
            pg8::SchedMN S{(const char*)(ws + O_H), (const char*)(ws + O_W1T) + (size_t)l * DFF * DM * 2, 2048, 2048, 48, 32, G, bid, 0, 48 * 32, 0, 0, 0, 0};
            pg8::EpiHid E{(bf16_t*)(ws + O_ZG)};
            pg8::gemm_phase(lds, 2048, 2048, 2048, S, E); } REPSYNC(8); }
            SEAM(p0 + 7);
        }
        if (RUN(p0 + 8)) { ENB(9) {
            const int nps = ksplit ? 2 : 1;
#pragma nounroll
            for (int pass = 0; pass < nps; ++pass) {
                pg8::SchedMN S{(const char*)(ws + O_ZG), (const char*)(ws + O_W2T) + (size_t)l * DM * DFF * 2, 8192, 8192, 48, 8, G, bid, 0, ksplit ? 256 : 384, pass, 256, 128, 4096 * 2};
                pg8::EpiRes E{a.out, a.out + (size_t)NCTXT * DM, a.out, mod_l, 5, (float*)(ws + O_ZM), (unsigned*)(ws + O_CTL) + CW_FLAG + (l * 2 + 1) * 128 * 16};
                pg8::gemm_phase(lds, 8192, 8192, pass ? 4096 : 8192, S, E); } }
            SEAM(p0 + 8);
        }
    }
    (void)ph;
}

extern "C" void kernel_launch(void* const* d_in, const int* in_sizes, int n_in, void* d_out, int out_size, void* d_ws, size_t ws_size, hipStream_t stream) {
    static int grid = 0;
    if (grid == 0) {
        if (n_in != 24 || ws_size < WS_NEED) { fprintf(stderr, "kernel_launch: need 24 inputs and %zu B of workspace (got %d, %zu)\n", (size_t)WS_NEED, n_in, ws_size); grid = -1; return; }
        int dev = 0, cus = 0, per_cu = 0;
        hipGetDevice(&dev); hipDeviceGetAttribute(&cus, hipDeviceAttributeMultiprocessorCount, dev);
        if (hipFuncSetAttribute((const void*)fwd, hipFuncAttributeMaxDynamicSharedMemorySize, LDS_BYTES) != hipSuccess) { fprintf(stderr, "kernel_launch: hipFuncSetAttribute failed\n"); grid = -1; return; }
        if (hipOccupancyMaxActiveBlocksPerMultiprocessor(&per_cu, (const void*)fwd, 512, LDS_BYTES) != hipSuccess || per_cu < 1) { fprintf(stderr, "kernel_launch: occupancy query says %d\n", per_cu); per_cu = 1; }
        (void)hipGetLastError();
        grid = cus;
    }
    if (grid < 0) return;
    Args a{};
    for (int i = 0; i < 24; ++i) a.in[i] = (const float*)d_in[i];
    a.out = (float*)d_out; a.ws = (unsigned char*)d_ws;
#if N_LAUNCH_MODE == 1
    a.ph_lo = 0; a.ph_hi = NPHASE;
    void* args[] = {&a};
    hipError_t e = hipLaunchCooperativeKernel((const void*)fwd, dim3(grid), dim3(512), args, LDS_BYTES, stream);
    if (e != hipSuccess) fprintf(stderr, "kernel_launch: cooperative launch failed: %s (grid %d)\n", hipGetErrorString(e), grid);
#else
    for (int p = 0; p < NPHASE; ++p) { a.ph_lo = p; a.ph_hi = p + 1; hipLaunchKernelGGL(fwd, dim3(grid), dim3(512), LDS_BYTES, stream, a); }
#endif
}
```

```cpp
#include <hip/hip_runtime.h>
#include <hip/hip_cooperative_groups.h>
#include <cstdio>
#include <cstdint>
namespace cg = cooperative_groups;


#ifndef N_LAUNCH_MODE
#define N_LAUNCH_MODE 1
#endif

#define LAS __attribute__((address_space(3)))
typedef unsigned short bf16_t;
typedef short bf16x8 __attribute__((ext_vector_type(8)));
typedef float f32x4 __attribute__((ext_vector_type(4)));
typedef float f32x2 __attribute__((ext_vector_type(2)));
typedef unsigned u32x4 __attribute__((ext_vector_type(4)));
typedef unsigned u32x2 __attribute__((ext_vector_type(2)));

constexpr int DM = 2048, NTOK = 12288, NCTXT = 4096, DFF = 8192, INC = 11776;
constexpr int NCOND = 9;
constexpr size_t MiB = 1u << 20;
constexpr size_t O_CTL = 0, O_WINT = 1 * MiB, O_WBT = 97 * MiB, O_WOT = 113 * MiB, O_W1T = 129 * MiB, O_W2T = 193 * MiB,
                 O_WFN = 257 * MiB, O_WBD = 261 * MiB, O_BDP = 265 * MiB, O_CS = 266 * MiB, O_DFT256 = 267 * MiB, O_DFT1024 = 268 * MiB,
                 O_WSB = 272 * MiB, O_MODP = 273 * MiB, O_MOD = 287 * MiB, O_CK = 288 * MiB, O_VTC = 296 * MiB, O_H = 304 * MiB,
                 O_ZM = 352 * MiB, O_ZG = 448 * MiB, O_QP = 640 * MiB, O_QR = 652 * MiB, O_KB = 660 * MiB, O_VT = 672 * MiB,
                 O_VNT = 684 * MiB, O_TT = 696 * MiB, O_BR = 720 * MiB, WS_NEED = 768 * MiB;
constexpr size_t OUTK = (size_t)NTOK * DM, OUTV = OUTK + (size_t)16 * 2 * 8 * 256 * 64;
constexpr int LDS_BYTES = 147456;
constexpr int NPHASE = 2 + 9 * 2;

struct Args { const float* in[24]; float* out; unsigned char* ws; int ph_lo, ph_hi; };
enum { I_XP = 0, I_XS, I_CK, I_CV, I_C, I_CCTX, I_N1G, I_WIN, I_BGATE, I_QNG, I_KNG, I_RPB, I_GNG, I_WSP, I_BSP, I_WPOOL, I_PSC, I_WBR, I_WOUT, I_N2G, I_W1, I_W2, I_WADA, I_BADA };

typedef __bf16 bf16x2_t __attribute__((ext_vector_type(2)));
__device__ __forceinline__ unsigned cvt_pk_bf16(float lo, float hi) { const f32x2 v = {lo, hi}; const bf16x2_t b = __builtin_convertvector(v, bf16x2_t); return __builtin_bit_cast(unsigned, b); }
__device__ __forceinline__ float bf2f(unsigned short u) { return __uint_as_float(((unsigned)u) << 16); }
__device__ __forceinline__ float bflo(unsigned u) { return __uint_as_float(u << 16); }
__device__ __forceinline__ float bfhi(unsigned u) { return __uint_as_float(u & 0xffff0000u); }
__device__ __forceinline__ bf16_t f2bf(float f) { return (bf16_t)(cvt_pk_bf16(f, 0.f) & 0xffffu); }
__device__ __forceinline__ float wave_sum(float v) {
#pragma unroll
    for (int o = 1; o < 64; o <<= 1) v += __shfl_xor(v, o);
    return v;
}
__device__ __forceinline__ float fast_exp(float x) { return __builtin_amdgcn_exp2f(x * 1.44269504089f); }
__device__ __forceinline__ float sigmoidf_(float x) { return __builtin_amdgcn_rcpf(1.0f + fast_exp(-x)); }
__device__ __forceinline__ float gelu_tanh(float x) { const float u = 0.7978845608f * (x + 0.044715f * x * x * x); return x * sigmoidf_(2.0f * u); }
#define LDS_WAIT() asm volatile("s_waitcnt lgkmcnt(0)" ::: "memory")
#define VM_WAIT() asm volatile("s_waitcnt vmcnt(0)" ::: "memory")

namespace pg8 {
constexpr int BM = 256, BK = 64, HALF = 128, HTB = HALF * BK * 2, STAGE_BYTES = 8 * HTB;
__device__ __forceinline__ int lds_byte(int r, int c) { const int st = (r >> 4) * 2 + (c >> 5), rr = r & 15, cc = c & 31, ob = rr * 64 + cc * 2; return st * 1024 + (ob ^ (((ob >> 9) & 1) << 5)); }
__device__ __forceinline__ void stage_rc(int b, int& R, int& C) { const int st = b / 1024, sb = b % 1024, swz = sb ^ (((sb >> 9) & 1) << 5); R = (st >> 1) * 16 + swz / 64; C = (st & 1) * 32 + (swz % 64) / 2; }
__device__ __forceinline__ int perm32(int rho) { const int n = rho >> 4, i = rho & 15; return 8 * (i >> 2) + 4 * n + (i & 3); }

struct Unit { const char* A; const char* B; long hA; int orow0, orow1, ocol, aux; };
__device__ __forceinline__ void tile_map(int L, int nM, int nN, int& pm, int& pn) {
    const int nwg = nM * nN; int wgid = L;
    { const int q = nwg / 8, r = nwg % 8, xcd = wgid % 8, off = wgid / 8; wgid = (xcd < r ? xcd * (q + 1) : r * (q + 1) + (xcd - r) * q) + off; }
    const int nig = 8 * nN, gid = wgid / nig, fm = gid * 8, gsz = (nM - fm) < 8 ? (nM - fm) : 8;
    pm = fm + ((wgid % nig) % gsz); pn = (wgid % nig) / gsz;
}
template <class Epi, class Sched>
__device__ __forceinline__ void gemm_phase(LAS unsigned char* lds, const int lda, const int ldb, const int K, const Sched& S, const Epi& E) {
    int tid = threadIdx.x; asm volatile("" : "+v"(tid));
    const int wid = __builtin_amdgcn_readfirstlane(tid >> 6), lane = tid & 63, wr = wid >> 2, wc = wid & 3, fr = lane & 15, fq = lane >> 4;
    const int nt = K / BK;
    unsigned voffA[2], voffB[2];
#pragma unroll
    for (int i = 0; i < 2; ++i) { int R, C; stage_rc(tid * 16 + i * 8192, R, C); const int Rb = (R & ~31) + perm32(R & 31);
        voffA[i] = (unsigned)(R * lda + C) * 2u; voffB[i] = (unsigned)(Rb * ldb + C) * 2u; }
    const size_t kstep = (size_t)(BK * 2);
    const size_t hstepB = (size_t)HALF * ldb * 2;
    const unsigned ldsw = (unsigned)wid * 1024u;
    const int aoff = lds_byte(wr * 64 + fr, fq * 8), boff = lds_byte(wc * 32 + fr, fq * 8);
#define PG8_SA(b, h) (((b) * 2 + (h)) * HTB)
#define PG8_SB(b, h) ((4 + (b) * 2 + (h)) * HTB)
#define PG8_STAGE(bufoff, gbase, voff) do { _Pragma("unroll") for (int _i = 0; _i < 2; ++_i) \
        __builtin_amdgcn_global_load_lds((const unsigned*)((const char*)(gbase) + (voff)[_i]), (LAS unsigned*)(lds + (bufoff) + ldsw + _i * 8192), 16, 0, 0); } while (0)
#define PG8_LDA(dst, b, h) do { _Pragma("unroll") for (int m = 0; m < 4; ++m) _Pragma("unroll") for (int k = 0; k < 2; ++k) dst[m][k] = *(const LAS bf16x8*)(lds + PG8_SA(b, h) + aoff + m * 2048 + k * 1024); } while (0)
#define PG8_LDB(dst, b, h) do { _Pragma("unroll") for (int n = 0; n < 2; ++n) _Pragma("unroll") for (int k = 0; k < 2; ++k) dst[n][k] = *(const LAS bf16x8*)(lds + PG8_SB(b, h) + boff + n * 2048 + k * 1024); } while (0)
#define PG8_MMA(ai, bj, At, Bt) do { __builtin_amdgcn_s_setprio(1); _Pragma("unroll") for (int m = 0; m < 4; ++m) _Pragma("unroll") for (int n = 0; n < 2; ++n) _Pragma("unroll") for (int k = 0; k < 2; ++k) \
        acc[ai][bj][m][n] = __builtin_amdgcn_mfma_f32_16x16x32_bf16(Bt[n][k], At[m][k], acc[ai][bj][m][n], 0, 0, 0); __builtin_amdgcn_s_setprio(0); } while (0)
#define PG8_WAIT_V(n) asm volatile("s_waitcnt vmcnt(" #n ")" ::: "memory")
#define PG8_WAIT_L(n) asm volatile("s_waitcnt lgkmcnt(" #n ")" ::: "memory")
#define PG8_BAR __builtin_amdgcn_s_barrier()
#define PG8_SCHED __builtin_amdgcn_sched_barrier(0)
    Unit cur, nxt; int ui = 0;
    if (!S.next(0, cur)) return;
    f32x4 acc[2][2][4][2];
#pragma unroll
    for (int a = 0; a < 2; ++a)
#pragma unroll
        for (int b = 0; b < 2; ++b)
#pragma unroll
            for (int m = 0; m < 4; ++m)
#pragma unroll
                for (int n = 0; n < 2; ++n) acc[a][b][m][n] = (f32x4){0.f, 0.f, 0.f, 0.f};
    bf16x8 At[4][2], B0[2][2], B1[2][2];
    const char* cA = cur.A; const char* cB = cur.B; long chA = cur.hA;
    PG8_STAGE(PG8_SB(0, 0), cB, voffB); PG8_STAGE(PG8_SB(0, 1), cB + hstepB, voffB); PG8_STAGE(PG8_SA(0, 0), cA, voffA); PG8_STAGE(PG8_SA(0, 1), cA + chA, voffA);
    if (wr == 1) PG8_BAR;
    PG8_WAIT_V(2); PG8_BAR;
    PG8_STAGE(PG8_SB(1, 0), cB + kstep, voffB); PG8_STAGE(PG8_SA(1, 0), cA + kstep, voffA); PG8_STAGE(PG8_SB(1, 1), cB + hstepB + kstep, voffB);
    PG8_WAIT_V(6); PG8_BAR;
    for (;;) {
        const bool has_next = S.next(ui + 1, nxt);
        const char* nA = has_next ? nxt.A : cA; const char* nB = has_next ? nxt.B : cB; const long nhA = has_next ? nxt.hA : chA;
        for (int t = 0; t < nt; t += 2) {
            const bool last = (t == nt - 2);
            const char* a1 = cA + (size_t)(t + 1) * kstep;
            const char* a2 = last ? nA : cA + (size_t)(t + 2) * kstep; const char* b2 = last ? nB : cB + (size_t)(t + 2) * kstep;
            const char* a3 = a2 + kstep; const char* b3 = b2 + kstep; const long h2 = last ? nhA : chA;
            PG8_LDB(B0, 0, 0); PG8_LDB(B1, 0, 1); PG8_SCHED; PG8_LDA(At, 0, 0); PG8_STAGE(PG8_SA(1, 1), a1 + chA, voffA);
            PG8_WAIT_V(8); PG8_WAIT_L(0); PG8_BAR; PG8_MMA(0, 0, At, B0); PG8_MMA(0, 1, At, B1); PG8_BAR; PG8_SCHED;
            PG8_LDA(At, 0, 1); PG8_STAGE(PG8_SB(0, 0), b2, voffB); PG8_STAGE(PG8_SB(0, 1), b2 + hstepB, voffB); PG8_STAGE(PG8_SA(0, 0), a2, voffA);
            PG8_WAIT_V(8); PG8_WAIT_L(0); PG8_BAR; PG8_MMA(1, 0, At, B0); PG8_MMA(1, 1, At, B1); PG8_BAR; PG8_SCHED;
            PG8_LDB(B0, 1, 0); PG8_LDB(B1, 1, 1); PG8_SCHED; PG8_LDA(At, 1, 0); PG8_STAGE(PG8_SA(0, 1), a2 + h2, voffA);
            PG8_WAIT_V(8); PG8_WAIT_L(0); PG8_BAR; PG8_MMA(0, 0, At, B0); PG8_MMA(0, 1, At, B1); PG8_BAR; PG8_SCHED;
            PG8_LDA(At, 1, 1); PG8_STAGE(PG8_SB(1, 0), b3, voffB); PG8_STAGE(PG8_SB(1, 1), b3 + hstepB, voffB); PG8_STAGE(PG8_SA(1, 0), a3, voffA);
            PG8_WAIT_V(8); PG8_WAIT_L(0); PG8_BAR; PG8_MMA(1, 0, At, B0); PG8_MMA(1, 1, At, B1); PG8_BAR; PG8_SCHED;
            if constexpr (Epi::MID) { if (((t + 2) & 7) == 0 && t + 2 < nt) E.mid(acc, cur, (t + 2) >> 3, wr, wc, fr, fq); }
        }
        if (wr == 0) PG8_BAR;
        E(acc, cur, wr, wc, fr, fq);
        if (!has_next) break;
#pragma unroll
        for (int a = 0; a < 2; ++a)
#pragma unroll
            for (int b = 0; b < 2; ++b)
#pragma unroll
                for (int m = 0; m < 4; ++m)
#pragma unroll
                    for (int n = 0; n < 2; ++n) acc[a][b][m][n] = (f32x4){0.f, 0.f, 0.f, 0.f};
        cur = nxt; cA = nA; cB = nB; chA = nhA; ++ui;
        if (wr == 1) PG8_BAR;
    }
    PG8_WAIT_V(0);
    PG8_BAR;
#undef PG8_SA
#undef PG8_SB
#undef PG8_STAGE
#undef PG8_LDA
#undef PG8_LDB
#undef PG8_MMA
#undef PG8_WAIT_V
#undef PG8_WAIT_L
#undef PG8_BAR
#undef PG8_SCHED
}

struct SchedMN {
    const char* A; const char* B; int lda, ldb, nM, nN, G, c, ocol_off, lim, split, L0, nsplit, khalf_bytes;
    __device__ __forceinline__ bool next(int i, Unit& u) const {
        int L, kh = 0, aux = 0;
        if (!split) { L = i * G + c; if (c < 0 || L >= lim) return false; }
        else { if (i > 0 || c >= 2 * nsplit) return false; const int j = c >> 1; kh = c & 1; L = L0 + j; aux = (j << 2) | 2 | kh; }
        int pm, pn; tile_map(L, nM, nN, pm, pn);
        const long h = (long)128 * lda * 2;
        u.A = A + (size_t)pm * 256 * lda * 2 + (size_t)kh * khalf_bytes + (kh ? h : 0); u.B = B + (size_t)pn * 256 * ldb * 2 + (size_t)kh * khalf_bytes;
        u.hA = kh ? -h : h;
        u.orow0 = pm * 256 + (kh ? 128 : 0); u.orow1 = pm * 256 + (kh ? 0 : 128); u.ocol = pn * 256 + ocol_off; u.aux = aux; return true;
    }
};
struct SchedBR {
    const char* A; const char* B; int G, c;
    __device__ __forceinline__ bool next(int i, Unit& u) const {
#ifdef EXP_B3
        const int L = i * G + c; if (L >= 48 * 8) return false;
        const int b = 3; int pm, pn; tile_map(L, 48, 8, pm, pn);
#else
        const int L = (i >> 2) * G + c; if (L >= 48 * 8) return false;
        const int b = i & 3; int pm, pn; tile_map(L, 48, 8, pm, pn);
#endif
        u.A = A + (size_t)pm * 256 * 2048 * 2 + b * 1024; u.B = B + (size_t)pn * 256 * 2048 * 2 + b * 1024; u.hA = (long)128 * 2048 * 2; u.orow0 = pm * 256; u.orow1 = pm * 256 + 128; u.ocol = pn * 256; u.aux = b; return true;
    }
};
struct SchedFold {
    const char* A0; const char* B0; int mode, c;
    __device__ __forceinline__ bool next(int i, Unit& u) const {
        if (i > 0 || c < 0) return false;
        if (mode == 0) { if (c >= 64) return false; const int l = c >> 5, g = (c >> 3) & 3, pn = c & 7;
            u.A = A0; u.hA = (long)128 * 256 * 2; u.B = B0 + ((size_t)(l * 4 + g) * 2048 + pn * 256) * 128 * 2; u.orow0 = l * 12288 + 2560 + g * 128; u.orow1 = l * 12288 + 3072 + g * 128; u.ocol = pn * 256; u.aux = g; }
        else { if (c >= 32) return false; const int l = c >> 4, pm = (c & 15) >> 1, pn = c & 1;
            u.A = A0 + ((size_t)l * 2048 + pm * 256) * 512 * 2; u.hA = (long)128 * 512 * 2; u.B = B0 + ((size_t)l * 512 + pn * 256) * 512 * 2; u.orow0 = l * 2048 + pm * 256; u.orow1 = u.orow0 + 128; u.ocol = 1536 + pn * 256; u.aux = 0; }
        return true;
    }
};
struct SchedDFT {
    const char* Amat; const char* TT; int latent, c;
    __device__ __forceinline__ bool next(int i, Unit& u) const {
        if (i > 0 || c < 0) return false;
        if (latent) { if (c >= 64) return false; const int bb = c >> 3, pm = (c & 7) >> 1, pn = c & 1;
            u.A = Amat + (size_t)pm * 256 * 2048 * 2; u.hA = (long)128 * 2048 * 2; u.B = TT + ((size_t)bb * 512 + pn * 256) * 2048 * 2; u.orow0 = NCTXT + bb * 1024 + pm * 256; u.orow1 = u.orow0 + 128; u.ocol = 1024 + pn * 256; }
        else { if (c >= 32) return false; const int bb = c >> 1, pn = c & 1;
            u.A = Amat; u.hA = (long)128 * 512 * 2; u.B = TT + ((size_t)bb * 512 + pn * 256) * 512 * 2; u.orow0 = bb * 256; u.orow1 = u.orow0 + 128; u.ocol = 1024 + pn * 256; }
        u.aux = 0; return true;
    }
};

__device__ __forceinline__ u32x4 pack8(const f32x4 v0, const f32x4 v1) { u32x4 w; w.x = cvt_pk_bf16(v0[0], v0[1]); w.y = cvt_pk_bf16(v0[2], v0[3]); w.z = cvt_pk_bf16(v1[0], v1[1]); w.w = cvt_pk_bf16(v1[2], v1[3]); return w; }
struct EpiStore {
    static constexpr bool MID = false;
    bf16_t* O; int ldc;
    __device__ __forceinline__ void operator()(const f32x4 (&acc)[2][2][4][2], const Unit& u, int wr, int wc, int fr, int fq) const {
        asm volatile("" : "+v"(fr), "+v"(fq));
#pragma unroll
        for (int ai = 0; ai < 2; ++ai)
#pragma unroll
            for (int m = 0; m < 4; ++m) { bf16_t* rowp = O + (size_t)((ai ? u.orow1 : u.orow0) + wr * 64 + m * 16 + fr) * ldc + u.ocol + wc * 32 + 8 * fq;
#pragma unroll
                for (int bj = 0; bj < 2; ++bj) *(u32x4*)(rowp + bj * 128) = pack8(acc[ai][bj][m][0], acc[ai][bj][m][1]); }
    }
};
struct EpiZ {
    static constexpr bool MID = false;
    bf16_t* Zm; bf16_t* Zg; const float* bgate;
    __device__ __forceinline__ void operator()(const f32x4 (&acc)[2][2][4][2], const Unit& u, int wr, int wc, int fr, int fq) const {
        asm volatile("" : "+v"(fr), "+v"(fq));
        const int pn = u.ocol >> 8; const int cb = wc * 32 + 8 * fq;
        if (pn >= 16) {
            const int col0 = u.ocol - 4096 + cb;
            f32x4 bv[2][2];
#pragma unroll
            for (int bj = 0; bj < 2; ++bj)
#pragma unroll
                for (int n = 0; n < 2; ++n) bv[bj][n] = *(const f32x4*)(bgate + col0 + bj * 128 + 4 * n);
#pragma unroll
            for (int ai = 0; ai < 2; ++ai)
#pragma unroll
                for (int m = 0; m < 4; ++m) { bf16_t* rowp = Zg + (size_t)((ai ? u.orow1 : u.orow0) + wr * 64 + m * 16 + fr) * 8192 + col0;
#pragma unroll
                    for (int bj = 0; bj < 2; ++bj) { f32x4 v0 = acc[ai][bj][m][0] + bv[bj][0], v1 = acc[ai][bj][m][1] + bv[bj][1];
#pragma unroll
                        for (int e = 0; e < 4; ++e) { v0[e] = sigmoidf_(v0[e]); v1[e] = sigmoidf_(v1[e]); }
                        *(u32x4*)(rowp + bj * 128) = pack8(v0, v1); } }
        } else {
            const bool gel = (pn >= 6 && pn < 10);
#pragma unroll
            for (int ai = 0; ai < 2; ++ai)
#pragma unroll
                for (int m = 0; m < 4; ++m) { bf16_t* rowp = Zm + (size_t)((ai ? u.orow1 : u.orow0) + wr * 64 + m * 16 + fr) * 4096 + u.ocol + cb;
#pragma unroll
                    for (int bj = 0; bj < 2; ++bj) { f32x4 v0 = acc[ai][bj][m][0], v1 = acc[ai][bj][m][1];
                        if (gel) {
#pragma unroll
                            for (int e = 0; e < 4; ++e) { v0[e] = gelu_tanh(v0[e]); v1[e] = gelu_tanh(v1[e]); } }
                        *(u32x4*)(rowp + bj * 128) = pack8(v0, v1); } }
        }
    }
};
struct EpiHid {
    static constexpr bool MID = false;
    bf16_t* O;
    __device__ __forceinline__ void operator()(const f32x4 (&acc)[2][2][4][2], const Unit& u, int wr, int wc, int fr, int fq) const {
        asm volatile("" : "+v"(fr), "+v"(fq));
#pragma unroll
        for (int ai = 0; ai < 2; ++ai)
#pragma unroll
            for (int m = 0; m < 4; ++m) { bf16_t* rowp = O + (size_t)((ai ? u.orow1 : u.orow0) + wr * 64 + m * 16 + fr) * DFF + u.ocol + wc * 32 + 8 * fq;
#pragma unroll
                for (int bj = 0; bj < 2; ++bj) { f32x4 v0 = acc[ai][bj][m][0], v1 = acc[ai][bj][m][1];
#pragma unroll
                    for (int e = 0; e < 4; ++e) { const float a = fmaxf(v0[e], 0.f), b = fmaxf(v1[e], 0.f); v0[e] = a * a; v1[e] = b * b; }
                    *(u32x4*)(rowp + bj * 128) = pack8(v0, v1); } }
    }
};
__device__ __forceinline__ void ho_send(const f32x4 (&acc)[2][2][4][2], unsigned long long* sb, unsigned* flag, int tidp) {
#pragma unroll
    for (int m = 0; m < 4; ++m)
#pragma unroll
        for (int bj = 0; bj < 2; ++bj)
#pragma unroll
            for (int n = 0; n < 2; ++n) { const f32x4 v = acc[1][bj][m][n]; unsigned long long* p = sb + (size_t)(((m * 2 + bj) * 2 + n) * 1024);
                __hip_atomic_store(p, ((unsigned long long)__float_as_uint(v[1]) << 32) | __float_as_uint(v[0]), __ATOMIC_RELAXED, __HIP_MEMORY_SCOPE_AGENT);
                __hip_atomic_store(p + 1, ((unsigned long long)__float_as_uint(v[3]) << 32) | __float_as_uint(v[2]), __ATOMIC_RELAXED, __HIP_MEMORY_SCOPE_AGENT); }
    asm volatile("s_waitcnt vmcnt(0)" ::: "memory");
    __syncthreads();
    if (tidp == 0) __hip_atomic_store(flag, 1u, __ATOMIC_RELEASE, __HIP_MEMORY_SCOPE_AGENT);
}
__device__ __forceinline__ void ho_wait(unsigned* flag, int tidp) {
    if (tidp == 0) { unsigned spin = 0; while (__hip_atomic_load(flag, __ATOMIC_ACQUIRE, __HIP_MEMORY_SCOPE_AGENT) == 0u) { __builtin_amdgcn_s_sleep(2); if (++spin > (1u << 24)) break; } }
    __syncthreads();
}
__device__ __forceinline__ f32x4 ho_get(unsigned long long* sb, int m, int bj, int n) {
    unsigned long long* p = sb + (size_t)(((m * 2 + bj) * 2 + n) * 1024);
    const unsigned long long a0 = __hip_atomic_load(p, __ATOMIC_RELAXED, __HIP_MEMORY_SCOPE_AGENT), a1 = __hip_atomic_load(p + 1, __ATOMIC_RELAXED, __HIP_MEMORY_SCOPE_AGENT);
    return (f32x4){__uint_as_float((unsigned)a0), __uint_as_float((unsigned)(a0 >> 32)), __uint_as_float((unsigned)a1), __uint_as_float((unsigned)(a1 >> 32))};
}
struct EpiRes {
    static constexpr bool MID = false;
    const float* xp; const float* xs; float* out; const float* mod; int gsel;
    float* S; unsigned* flags;
    __device__ __forceinline__ void operator()(const f32x4 (&acc)[2][2][4][2], const Unit& u, int wr, int wc, int fr, int fq) const {
        asm volatile("" : "+v"(fr), "+v"(fq));
        const int sp = u.aux & 2, jt = u.aux >> 2;
        const int tidp = (wr * 4 + wc) * 64 + fq * 16 + fr;
        const int kh = u.aux & 1;
        unsigned long long* sbs = (unsigned long long*)(S + (size_t)jt * 65536 + kh * 32768) + (size_t)tidp * 2;
        unsigned long long* sb = (unsigned long long*)(S + (size_t)jt * 65536 + (1 - kh) * 32768) + (size_t)tidp * 2;
        if (sp) { ho_send(acc, sbs, flags + jt * 16 + kh * 8, tidp); ho_wait(flags + jt * 16 + (1 - kh) * 8, tidp); }
        const int pm = u.orow0 >> 8; const int cond = pm < 16 ? 0 : 1 + ((pm - 16) >> 2);
        const int col0 = u.ocol + wc * 32 + 8 * fq;
        const float* gp = mod + ((size_t)cond * 6 + gsel) * 2048 + col0;
        f32x4 gv[2][2];
#pragma unroll
        for (int bj = 0; bj < 2; ++bj)
#pragma unroll
            for (int n = 0; n < 2; ++n) gv[bj][n] = *(const f32x4*)(gp + bj * 128 + 4 * n);
        const float* src = pm < 16 ? xp : xs - (size_t)NCTXT * DM;
#pragma unroll
        for (int ai = 0; ai < 2; ++ai) {
            if (ai == 1 && sp) break;
#pragma unroll
            for (int m = 0; m < 4; ++m) {
                f32x4 xv[2][2], pv[2][2]; const size_t off = (size_t)((ai ? u.orow1 : u.orow0) + wr * 64 + m * 16 + fr) * DM + col0;
#pragma unroll
                for (int bj = 0; bj < 2; ++bj)
#pragma unroll
                    for (int n = 0; n < 2; ++n) { xv[bj][n] = *(const f32x4*)(src + off + bj * 128 + 4 * n); if (ai == 0 && sp) pv[bj][n] = ho_get(sb, m, bj, n); }
#pragma unroll
                for (int bj = 0; bj < 2; ++bj)
#pragma unroll
                    for (int n = 0; n < 2; ++n) { f32x4 v = acc[ai][bj][m][n]; if (ai == 0 && sp) v += pv[bj][n];
                        *(f32x4*)(out + off + bj * 128 + 4 * n) = xv[bj][n] + gv[bj][n] * v; }
                asm volatile("" ::: "memory"); } }
    }
};
struct EpiBR {
    static constexpr bool MID = true;
    const bf16_t* Zg; bf16_t* merged; float* S; unsigned* flags;
    __device__ __forceinline__ void scale(f32x4 (&acc)[2][2][4][2], const Unit& u, int b, bool ratio, int wr, int wc, int fr, int fq) const {
        const int col0 = u.ocol + wc * 32 + 8 * fq;
#pragma unroll
        for (int ai = 0; ai < 2; ++ai) {
            u32x4 gw[4][2], nw[4][2];
#pragma unroll
            for (int m = 0; m < 4; ++m)
#pragma unroll
                for (int bj = 0; bj < 2; ++bj) { const bf16_t* gp = Zg + (size_t)((ai ? u.orow1 : u.orow0) + wr * 64 + m * 16 + fr) * 8192 + b * 2048 + col0 + bj * 128;
                    gw[m][bj] = *(const u32x4*)gp; if (ratio) nw[m][bj] = *(const u32x4*)(gp + 2048); }
#pragma unroll
            for (int m = 0; m < 4; ++m)
#pragma unroll
                for (int bj = 0; bj < 2; ++bj) { const u32x4 g4 = gw[m][bj];
                    float g[8] = {bflo(g4.x), bfhi(g4.x), bflo(g4.y), bfhi(g4.y), bflo(g4.z), bfhi(g4.z), bflo(g4.w), bfhi(g4.w)};
#pragma unroll
                    for (int e = 0; e < 8; ++e) g[e] = fmaxf(g[e], 1e-6f);
                    if (ratio) { const u32x4 n4 = nw[m][bj];
                        const float gn[8] = {bflo(n4.x), bfhi(n4.x), bflo(n4.y), bfhi(n4.y), bflo(n4.z), bfhi(n4.z), bflo(n4.w), bfhi(n4.w)};
#pragma unroll
                        for (int e = 0; e < 8; ++e) g[e] *= __builtin_amdgcn_rcpf(fmaxf(gn[e], 1e-6f)); }
                    f32x4 v0 = acc[ai][bj][m][0], v1 = acc[ai][bj][m][1];
                    v0[0] *= g[0]; v0[1] *= g[1]; v0[2] *= g[2]; v0[3] *= g[3]; v1[0] *= g[4]; v1[1] *= g[5]; v1[2] *= g[6]; v1[3] *= g[7];
                    acc[ai][bj][m][0] = v0; acc[ai][bj][m][1] = v1; }
            asm volatile("" ::: "memory"); }
    }
    __device__ __forceinline__ void mid(f32x4 (&acc)[2][2][4][2], const Unit& u, int seg, int wr, int wc, int fr, int fq) const {
        asm volatile("" : "+v"(fr), "+v"(fq));
        const int base = (u.aux & 2) ? (u.aux & 1) * 2 : 0;
        scale(acc, u, base + seg - 1, true, wr, wc, fr, fq);
    }
    __device__ __forceinline__ void operator()(f32x4 (&acc)[2][2][4][2], const Unit& u, int wr, int wc, int fr, int fq) const {
        asm volatile("" : "+v"(fr), "+v"(fq));
        const int sp = u.aux & 2, kh = u.aux & 1, jt = u.aux >> 2;
        const int tidp = (wr * 4 + wc) * 64 + fq * 16 + fr;
        unsigned long long* sbs = (unsigned long long*)(S + (size_t)jt * 65536 + kh * 32768) + (size_t)tidp * 2;
        unsigned long long* sb = (unsigned long long*)(S + (size_t)jt * 65536 + (1 - kh) * 32768) + (size_t)tidp * 2;
        scale(acc, u, sp ? kh * 2 + 1 : 3, false, wr, wc, fr, fq);
        if (sp) { ho_send(acc, sbs, flags + jt * 16 + kh * 8, tidp); ho_wait(flags + jt * 16 + (1 - kh) * 8, tidp); }
        const int col0 = u.ocol + wc * 32 + 8 * fq;
        if (sp) {
            f32x4 pv[4][2][2];
#pragma unroll
            for (int m = 0; m < 4; ++m)
#pragma unroll
                for (int bj = 0; bj < 2; ++bj) { pv[m][bj][0] = ho_get(sb, m, bj, 0); pv[m][bj][1] = ho_get(sb, m, bj, 1); }
#pragma unroll
            for (int m = 0; m < 4; ++m) { const size_t row = (size_t)(u.orow0 + wr * 64 + m * 16 + fr);
#pragma unroll
                for (int bj = 0; bj < 2; ++bj) *(u32x4*)(merged + row * DM + col0 + bj * 128) = pack8(acc[0][bj][m][0] + pv[m][bj][0], acc[0][bj][m][1] + pv[m][bj][1]); }
        } else {
#pragma unroll
            for (int ai = 0; ai < 2; ++ai)
#pragma unroll
                for (int m = 0; m < 4; ++m) { const size_t row = (size_t)((ai ? u.orow1 : u.orow0) + wr * 64 + m * 16 + fr);
#pragma unroll
                    for (int bj = 0; bj < 2; ++bj) *(u32x4*)(merged + row * DM + col0 + bj * 128) = pack8(acc[ai][bj][m][0], acc[ai][bj][m][1]); }
        }
    }
};
}

__device__ __forceinline__ void transpose_item(const float* W, int N, int k0, int n0, bf16_t* D, int ldo, int dn0, int dk0, LAS float* scr, int lane) {
#pragma unroll 8
    for (int i = 0; i < 32; ++i) { const int kk = 2 * i + (lane >> 5); scr[kk * 33 + (lane & 31)] = W[(size_t)(k0 + kk) * N + n0 + (lane & 31)]; }
    LDS_WAIT(); asm volatile("" ::: "memory");
    const int c = lane & 7;
#pragma unroll
    for (int j = 0; j < 4; ++j) { const int n = (lane >> 3) + 8 * j; const LAS float* s = scr + (8 * c) * 33 + n;
        u32x4 o; o.x = cvt_pk_bf16(s[0 * 33], s[1 * 33]); o.y = cvt_pk_bf16(s[2 * 33], s[3 * 33]); o.z = cvt_pk_bf16(s[4 * 33], s[5 * 33]); o.w = cvt_pk_bf16(s[6 * 33], s[7 * 33]);
        *(u32x4*)(D + (size_t)(dn0 + n) * ldo + dk0 + 8 * c) = o; }
    LDS_WAIT(); asm volatile("" ::: "memory");
}

__device__ __forceinline__ void phase_p0(const Args& a, LAS unsigned char* lds, int tid, int lane, int wave, int G, int bid) {
    unsigned char* ws = a.ws;
    LAS float* scr = (LAS float*)(lds + wave * 16384);
    const int gw = bid * 8 + wave, NGW = G * 8;
    if (bid == 0 && tid < 16) ((unsigned*)(ws + O_CTL))[64 * tid] = 0u;
    if (bid == 0 && tid < 32) ((unsigned*)(ws + O_CTL))[1024 + 64 * tid] = 0u;
    constexpr int IT_WIN = 32 * 368, IT_WBR = 32 * 64, IT_WOUT = 32 * 64, IT_W1 = 32 * 256, IT_W2 = 128 * 64, IT_L = IT_WIN + IT_WBR + IT_WOUT + IT_W1 + IT_W2;
    constexpr int IT_CV = 128 * 16;
    for (int it = gw; it < 2 * IT_L + IT_CV; it += NGW) {
        if (it >= 2 * IT_L) {
            const int r = it - 2 * IT_L, mtx = r >> 4, kb = (r >> 1) & 7, nb = r & 1;
            transpose_item(a.in[I_CV] + (size_t)mtx * 512 * 64, 64, kb * 64, nb * 32, (bf16_t*)(ws + O_VTC) + (size_t)mtx * 64 * 512, 512, nb * 32, kb * 64, scr, lane);
            continue;
        }
        const int l = it / IT_L; int r = it % IT_L;
        if (r < IT_WIN) {
            const int kb = r / 368, nb = r % 368, k0 = kb * 64, n0 = nb * 32;
            const float* W = a.in[I_WIN] + (size_t)l * DM * INC;
            if (n0 >= 2560 && n0 < 3072) {
                const int g = (n0 - 2560) >> 7, c0 = (n0 - 2560) & 127;
                bf16_t* D = (bf16_t*)(ws + O_WFN) + ((size_t)(l * 4 + g) * 2048) * 128;
#pragma unroll 8
                for (int i = 0; i < 32; ++i) { const int kk = 2 * i + (lane >> 5); D[(size_t)(k0 + kk) * 128 + c0 + (lane & 31)] = f2bf(W[(size_t)(k0 + kk) * INC + n0 + (lane & 31)]); }
            } else {
                const int dn0 = n0 < 2560 ? n0 : n0 + 512;
                transpose_item(W, INC, k0, n0, (bf16_t*)(ws + O_WINT) + (size_t)l * 12288 * 2048, 2048, dn0, k0, scr, lane);
            }
            continue;
        } r -= IT_WIN;
        if (r < IT_WBR) {
            const int kb = r / 64, nb = r % 64, k0 = kb * 64, n0 = nb * 32;
            const float* W = a.in[I_WBR] + (size_t)l * DM * DM;
            if (k0 < 1536) transpose_item(W, DM, k0, n0, (bf16_t*)(ws + O_WBT) + (size_t)l * DM * DM, 2048, n0, k0, scr, lane);
            else transpose_item(W, DM, k0, n0, (bf16_t*)(ws + O_WBD) + (size_t)l * DM * 512, 512, n0, k0 - 1536, scr, lane);
            continue;
        } r -= IT_WBR;
        if (r < IT_WOUT) { const int kb = r / 64, nb = r % 64; transpose_item(a.in[I_WOUT] + (size_t)l * DM * DM, DM, kb * 64, nb * 32, (bf16_t*)(ws + O_WOT) + (size_t)l * DM * DM, 2048, nb * 32, kb * 64, scr, lane); continue; } r -= IT_WOUT;
        if (r < IT_W1) { const int kb = r / 256, nb = r % 256; transpose_item(a.in[I_W1] + (size_t)l * DM * DFF, DFF, kb * 64, nb * 32, (bf16_t*)(ws + O_W1T) + (size_t)l * DFF * DM, 2048, nb * 32, kb * 64, scr, lane); continue; } r -= IT_W1;
        { const int kb = r / 64, nb = r % 64; transpose_item(a.in[I_W2] + (size_t)l * DFF * DM, DM, kb * 64, nb * 32, (bf16_t*)(ws + O_W2T) + (size_t)l * DM * DFF, 8192, nb * 32, kb * 64, scr, lane); }
    }
    const int gt = bid * 512 + tid, NGT = G * 512;
    for (int i = gt; i < 2 * 512 * 512; i += NGT) {
        const int l = i >> 18, c = (i >> 9) & 511, d = i & 511; float v = 0.f;
        if ((c >> 7) == (d >> 7)) v = a.in[I_WPOOL][(((size_t)l * 4 + (c >> 7)) * 128 + (c & 127)) * 128 + (d & 127)] * a.in[I_PSC][l * 512 + d];
        ((bf16_t*)(ws + O_BDP))[i] = f2bf(v);
    }
    for (int i = gt; i < 256 * 256; i += NGT) {
        const int r = i >> 8, c = i & 255, cp = r & 127; const float t = (float)((cp * c) & 127) * (2.0f / 128.0f);
        ((bf16_t*)(ws + O_CS))[i] = f2bf(c < 128 ? (r < 128 ? cospif(t) : sinpif(t)) * 0.08838834764831845f : 0.f);
    }
    for (int i = gt; i < 256 * 512; i += NGT) {
        const int k = i >> 9, c = i & 511, n = c & 255; const float t = (float)((k * n) & 255) * (2.0f / 256.0f);
        ((bf16_t*)(ws + O_DFT256))[i] = f2bf((c < 256 ? cospif(t) : -sinpif(t)) * 0.0625f);
    }
    for (int i = gt; i < 1024 * 2048; i += NGT) {
        const int k = i >> 11, c = i & 2047, n = c & 1023; const float t = (float)((k * n) & 1023) * (2.0f / 1024.0f);
        ((bf16_t*)(ws + O_DFT1024))[i] = f2bf((c < 1024 ? cospif(t) : -sinpif(t)) * 0.03125f);
    }
    for (int i = gt; i < 2 * 4 * 128 * 128; i += NGT) ((bf16_t*)(ws + O_WSB))[i] = f2bf(a.in[I_WSP][i]);
    for (int i = gt; i < 8 * 2 * 8 * 512 * 64 / 4; i += NGT) { const f32x4 v = ((const f32x4*)a.in[I_CK])[i]; u32x2 w; w.x = cvt_pk_bf16(v[0], v[1]); w.y = cvt_pk_bf16(v[2], v[3]); ((u32x2*)(ws + O_CK))[i] = w; }
    __syncthreads();
    for (int it = gw; it < 2 * 16 * 48; it += NGW) {
        const int l = it / 768, rem = it % 768, dch = rem / 48, cb = rem % 48, j0 = cb * 256 + lane * 4, d0 = dch * 128;
        for (int i = lane; i < NCOND * 128; i += 64) { const int cond = i >> 7, d = i & 127; const float x = cond == 0 ? a.in[I_CCTX][d0 + d] : a.in[I_C][(size_t)(cond - 1) * DM + d0 + d]; scr[i] = x * sigmoidf_(x); }
        LDS_WAIT(); asm volatile("" ::: "memory");
        f32x4 acc[NCOND];
#pragma unroll
        for (int c = 0; c < NCOND; ++c) acc[c] = (f32x4){0.f, 0.f, 0.f, 0.f};
        const float* wp = a.in[I_WADA] + ((size_t)l * DM + d0) * 12288 + j0;
#pragma unroll 1
        for (int d0b = 0; d0b < 128; d0b += 16) {
            f32x4 w[16];
#pragma unroll
            for (int u = 0; u < 16; ++u) w[u] = *(const f32x4*)(wp + (size_t)(d0b + u) * 12288);
#pragma unroll
            for (int u = 0; u < 16; ++u)
#pragma unroll
                for (int c = 0; c < NCOND; ++c) acc[c] += w[u] * scr[c * 128 + d0b + u]; }
#pragma unroll
        for (int c = 0; c < NCOND; ++c) *(f32x4*)((float*)(ws + O_MODP) + ((size_t)(dch * 2 + l) * NCOND + c) * 12288 + j0) = acc[c];
        LDS_WAIT(); asm volatile("" ::: "memory");
    }
}

__device__ __forceinline__ void phase_p1_modreduce(const Args& a, int tid, int G, int bid) {
    const int gt = bid * 512 + tid, NGT = G * 512;
    const float* P = (const float*)(a.ws + O_MODP); float* M = (float*)(a.ws + O_MOD);
    for (int i = gt; i < 2 * NCOND * 2048; i += NGT) {
        const int l = i / (NCOND * 2048), cond = (i / 2048) % NCOND, col = i & 2047;
        float m[6];
#pragma unroll
        for (int s = 0; s < 6; ++s) { float v = a.in[I_BADA][l * 12288 + s * 2048 + col]; float pp[16];
#pragma unroll
            for (int dch = 0; dch < 16; ++dch) pp[dch] = P[((size_t)(dch * 2 + l) * NCOND + cond) * 12288 + s * 2048 + col];
#pragma unroll
            for (int dch = 0; dch < 16; ++dch) v += pp[dch];
            m[s] = v; }
        float* o = M + ((size_t)(l * NCOND + cond) * 6) * 2048 + col;
        o[0] = a.in[I_N1G][l * 2048 + col] * (1.f + m[1]); o[2048] = m[0]; o[2 * 2048] = m[2];
        o[3 * 2048] = a.in[I_N2G][l * 2048 + col] * (1.f + m[4]); o[4 * 2048] = m[3]; o[5 * 2048] = m[5];
    }
}

__device__ __forceinline__ void phase_norm(const Args& a, int l, int which, bool from_input, int lane, int wave, int G, int bid) {
    const int gw = bid * 8 + wave, NGW = G * 8;
    bf16_t* H = (bf16_t*)(a.ws + O_H);
    const int chunk = (NTOK + NGW - 1) / NGW;
    int row = gw * chunk; const int rend = (row + chunk) < NTOK ? (row + chunk) : NTOK;
    if (row >= rend) return;
#define NORM_XPTR(r) (from_input ? ((r) < NCTXT ? a.in[I_XP] + (size_t)(r) * DM : a.in[I_XS] + (size_t)((r) - NCTXT) * DM) : a.out + (size_t)(r) * DM)
    f32x4 v[8], av[8], sv[8]; int ccond = -1;
    { const float* xr = NORM_XPTR(row);
#pragma unroll
      for (int j = 0; j < 8; ++j) v[j] = *(const f32x4*)(xr + j * 256 + lane * 4); }
    for (; row < rend; ++row) {
        f32x4 vn[8];
        if (row + 1 < rend) { const float* xr = NORM_XPTR(row + 1);
#pragma unroll
            for (int j = 0; j < 8; ++j) vn[j] = *(const f32x4*)(xr + j * 256 + lane * 4); }
        const int cond = row < NCTXT ? 0 : 1 + ((row - NCTXT) >> 10);
        if (cond != ccond) { ccond = cond; const float* ap = (const float*)(a.ws + O_MOD) + ((size_t)(l * NCOND + cond) * 6 + which) * 2048;
#pragma unroll
            for (int j = 0; j < 8; ++j) { av[j] = *(const f32x4*)(ap + j * 256 + lane * 4); sv[j] = *(const f32x4*)(ap + 2048 + j * 256 + lane * 4); } }
        float s = 0.f;
#pragma unroll
        for (int j = 0; j < 8; ++j) s += (v[j][0] * v[j][0] + v[j][1] * v[j][1]) + (v[j][2] * v[j][2] + v[j][3] * v[j][3]);
        const float r = rsqrtf(wave_sum(s) * (1.0f / DM) + 1e-6f);
#pragma unroll
        for (int j = 0; j < 8; ++j) { const f32x4 o = v[j] * r * av[j] + sv[j]; u32x2 w; w.x = cvt_pk_bf16(o[0], o[1]); w.y = cvt_pk_bf16(o[2], o[3]);
            *(u32x2*)(H + (size_t)row * DM + j * 256 + lane * 4) = w; }
#pragma unroll
        for (int j = 0; j < 8; ++j) v[j] = vn[j];
    }
#undef NORM_XPTR
}

template <bool SCALE>
__device__ __forceinline__ void transpose128(const bf16_t* src, int ld_src, bf16_t* dst, int ld_dst, LAS unsigned char* lds, int tid, const LAS float* rtab, const float* gvec) {
    LAS bf16_t* T = (LAS bf16_t*)lds;
    u32x4 vv[4];
#pragma unroll
    for (int j = 0; j < 4; ++j) { const int ch = tid + j * 512, row = ch >> 4, cc = ch & 15; vv[j] = *(const u32x4*)(src + (size_t)row * ld_src + cc * 8); }
    f32x4 g0 = {0.f, 0.f, 0.f, 0.f}, g1 = {0.f, 0.f, 0.f, 0.f};
    if (SCALE) { const int cc = tid & 15; g0 = *(const f32x4*)(gvec + cc * 8); g1 = *(const f32x4*)(gvec + cc * 8 + 4); }
#pragma unroll
    for (int j = 0; j < 4; ++j) { const int ch = tid + j * 512, row = ch >> 4, cc = ch & 15;
        u32x4 v = vv[j];
        if (SCALE) { const float r = rtab[row];
            v.x = cvt_pk_bf16(bflo(v.x) * r * g0[0], bfhi(v.x) * r * g0[1]); v.y = cvt_pk_bf16(bflo(v.y) * r * g0[2], bfhi(v.y) * r * g0[3]);
            v.z = cvt_pk_bf16(bflo(v.z) * r * g1[0], bfhi(v.z) * r * g1[1]); v.w = cvt_pk_bf16(bflo(v.w) * r * g1[2], bfhi(v.w) * r * g1[3]); }
        *(LAS u32x4*)(T + row * 136 + cc * 8) = v; }
    __syncthreads();
#pragma unroll
    for (int j = 0; j < 4; ++j) { const int ch = tid + j * 512, c = ch & 127, qc = ch >> 7;
        unsigned short e[8];
#pragma unroll
        for (int k = 0; k < 8; ++k) e[k] = T[(qc * 8 + k) * 136 + c];
        u32x4 o; o.x = e[0] | ((unsigned)e[1] << 16); o.y = e[2] | ((unsigned)e[3] << 16); o.z = e[4] | ((unsigned)e[5] << 16); o.w = e[6] | ((unsigned)e[7] << 16);
        *(u32x4*)(dst + (size_t)c * ld_dst + qc * 8) = o; }
    __syncthreads();
}

template <int W>
__device__ __forceinline__ void pool_rows(const bf16_t* base, bf16_t* outp, int pos0, int npos, int tl0, int tsub) {
#pragma unroll 2
    for (int it = 0; it < 16; ++it) {
        const int tl = tl0 + it * 4 + tsub, pos = pos0 + tl;
        int lo = pos - (W >> 1); if (lo < 0) lo = 0; int hi = pos + (W >> 1) - 1; if (hi > npos - 1) hi = npos - 1;
        u32x4 x[W];
#pragma unroll
        for (int j = 0; j < W; ++j) { int p = pos - (W >> 1) + j; p = p < lo ? lo : (p > hi ? hi : p); x[j] = *(const u32x4*)(base + (size_t)p * 4096); }
        float s[8] = {0.f, 0.f, 0.f, 0.f, 0.f, 0.f, 0.f, 0.f};
#pragma unroll
        for (int j = 0; j < W; ++j) { const int p = pos - (W >> 1) + j; const float wgt = (p >= lo && p <= hi) ? 1.f : 0.f;
            s[0] += wgt * bflo(x[j].x); s[1] += wgt * bfhi(x[j].x); s[2] += wgt * bflo(x[j].y); s[3] += wgt * bfhi(x[j].y);
            s[4] += wgt * bflo(x[j].z); s[5] += wgt * bfhi(x[j].z); s[6] += wgt * bflo(x[j].w); s[7] += wgt * bfhi(x[j].w); }
        const u32x4 xc = x[W >> 1]; const float inv = 1.0f / (float)(hi - lo + 1);
        u32x4 o; o.x = cvt_pk_bf16(s[0] * inv - bflo(xc.x), s[1] * inv - bfhi(xc.x)); o.y = cvt_pk_bf16(s[2] * inv - bflo(xc.y), s[3] * inv - bfhi(xc.y));
        o.z = cvt_pk_bf16(s[4] * inv - bflo(xc.z), s[5] * inv - bfhi(xc.z)); o.w = cvt_pk_bf16(s[6] * inv - bflo(xc.w), s[7] * inv - bfhi(xc.w));
        *(u32x4*)(outp + (size_t)tl * 2048) = o;
    }
}

__device__ __forceinline__ void phase_prep(const Args& a, int l, LAS unsigned char* lds, int tid, int lane, int wave, int G, int bid) {
    unsigned char* ws = a.ws;
    const bf16_t* Zm = (const bf16_t*)(ws + O_ZM);
    unsigned* qctr = (unsigned*)(ws + O_CTL) + 64 * (8 + l);
    LAS int* qslot = (LAS int*)(lds + 131072 + 128);
    for (;;) {
        __syncthreads();
        if (tid == 0) *qslot = (int)atomicAdd(qctr, 1u);
        __syncthreads();
        const int qi = *qslot; if (qi >= 96 * 6) break;
        const int ord = qi / 96, tt = qi % 96; const int task = ord == 0 ? 0 : (ord == 1 ? 5 : ord - 1);
        const bool ctx = tt < 32; const int bb = ctx ? (tt >> 1) : ((tt - 32) >> 3); const int pos0 = ctx ? (tt & 1) * 128 : ((tt - 32) & 7) * 128; const int npos = ctx ? 256 : 1024;
        const int tok0 = tt * 128;
        if (task == 0) {
            const int j = lane & 7, hd = lane >> 3;
            const f32x4 gq0 = *(const f32x4*)(a.in[I_QNG] + l * 64 + j * 8), gq1 = *(const f32x4*)(a.in[I_QNG] + l * 64 + j * 8 + 4);
            const f32x4 gk0 = *(const f32x4*)(a.in[I_KNG] + l * 64 + j * 8), gk1 = *(const f32x4*)(a.in[I_KNG] + l * 64 + j * 8 + 4);
            const int ax = j >> 2; const bool isx2 = (j & 2) != 0; const int i0 = (j & 1) * 8;
            float invf[8];
#pragma unroll
            for (int e = 0; e < 8; ++e) invf[e] = __builtin_amdgcn_exp2f(-(float)(i0 + e) * (13.287712379549449f / 16.0f));
#pragma unroll 1
            for (int tb = 0; tb < 4; ++tb) {
                u32x4 qw4[4], kw4[4];
#pragma unroll
                for (int u = 0; u < 4; ++u) { const int tok = tok0 + wave * 16 + tb * 4 + u; qw4[u] = *(const u32x4*)(Zm + (size_t)tok * 4096 + lane * 8); kw4[u] = *(const u32x4*)(Zm + (size_t)tok * 4096 + 512 + lane * 8); }
#pragma unroll
                for (int u = 0; u < 4; ++u) {
                    const int tl = wave * 16 + tb * 4 + u, tok = tok0 + tl, pos = pos0 + tl;
                    const u32x4 qw = qw4[u], kw = kw4[u];
                    float q[8] = {bflo(qw.x), bfhi(qw.x), bflo(qw.y), bfhi(qw.y), bflo(qw.z), bfhi(qw.z), bflo(qw.w), bfhi(qw.w)};
                    float k[8] = {bflo(kw.x), bfhi(kw.x), bflo(kw.y), bfhi(kw.y), bflo(kw.z), bfhi(kw.z), bflo(kw.w), bfhi(kw.w)};
                    float sq = 0.f, sk = 0.f;
#pragma unroll
                    for (int e = 0; e < 8; ++e) { sq += q[e] * q[e]; sk += k[e] * k[e]; }
                    sq += __shfl_xor(sq, 1); sq += __shfl_xor(sq, 2); sq += __shfl_xor(sq, 4);
                    sk += __shfl_xor(sk, 1); sk += __shfl_xor(sk, 2); sk += __shfl_xor(sk, 4);
                    const float rq = rsqrtf(sq * (1.f / 64.f) + 1e-6f), rk = rsqrtf(sk * (1.f / 64.f) + 1e-6f);
#pragma unroll
                    for (int e = 0; e < 8; ++e) { q[e] *= rq * (e < 4 ? gq0[e & 3] : gq1[e & 3]); k[e] *= rk * (e < 4 ? gk0[e & 3] : gk1[e & 3]); }
                    { u32x4 o; o.x = cvt_pk_bf16(q[0] * 0.125f, q[1] * 0.125f); o.y = cvt_pk_bf16(q[2] * 0.125f, q[3] * 0.125f); o.z = cvt_pk_bf16(q[4] * 0.125f, q[5] * 0.125f); o.w = cvt_pk_bf16(q[6] * 0.125f, q[7] * 0.125f);
                      *(u32x4*)((bf16_t*)(ws + O_QP) + (size_t)tok * 512 + lane * 8) = o; }
                    if (ctx) {
                        u32x4 o; o.x = cvt_pk_bf16(k[0], k[1]); o.y = cvt_pk_bf16(k[2], k[3]); o.z = cvt_pk_bf16(k[4], k[5]); o.w = cvt_pk_bf16(k[6], k[7]);
                        *(u32x4*)((bf16_t*)(ws + O_KB) + (size_t)tok * 512 + lane * 8) = o;
                        float* ok = a.out + OUTK + ((((size_t)bb * 2 + l) * 8 + hd) * 256 + pos) * 64 + j * 8;
                        *(f32x4*)ok = (f32x4){k[0], k[1], k[2], k[3]}; *(f32x4*)(ok + 4) = (f32x4){k[4], k[5], k[6], k[7]};
                    } else {
                        const float p = (float)(ax == 0 ? (pos >> 6) : (pos & 63));
                        float qr[8], kr[8];
#pragma unroll
                        for (int e = 0; e < 8; ++e) {
                            const float ang = p * invf[e]; const float cs = __cosf(ang), sn = __sinf(ang);
                            const float pq = __shfl_xor(q[e], 2), pk = __shfl_xor(k[e], 2);
                            qr[e] = q[e] * cs + (isx2 ? pq : -pq) * sn; kr[e] = k[e] * cs + (isx2 ? pk : -pk) * sn;
                        }
                        u32x4 o; o.x = cvt_pk_bf16(qr[0] * 0.125f, qr[1] * 0.125f); o.y = cvt_pk_bf16(qr[2] * 0.125f, qr[3] * 0.125f); o.z = cvt_pk_bf16(qr[4] * 0.125f, qr[5] * 0.125f); o.w = cvt_pk_bf16(qr[6] * 0.125f, qr[7] * 0.125f);
                        *(u32x4*)((bf16_t*)(ws + O_QR) + (size_t)(tok - NCTXT) * 512 + lane * 8) = o;
                        u32x4 o2; o2.x = cvt_pk_bf16(kr[0], kr[1]); o2.y = cvt_pk_bf16(kr[2], kr[3]); o2.z = cvt_pk_bf16(kr[4], kr[5]); o2.w = cvt_pk_bf16(kr[6], kr[7]);
                        *(u32x4*)((bf16_t*)(ws + O_KB) + (size_t)tok * 512 + lane * 8) = o2;
                    }
                }
            }
        } else if (task == 1) {
            bf16_t* vt = (bf16_t*)(ws + O_VT) + (ctx ? (size_t)bb * 512 * 256 : (size_t)16 * 512 * 256 + (size_t)bb * 512 * 1024) + pos0;
            if (ctx) {
                const int j = lane & 7, hd = lane >> 3;
#pragma unroll 1
                for (int tb = 0; tb < 2; ++tb) {
                    u32x4 w8[8];
#pragma unroll
                    for (int u = 0; u < 8; ++u) w8[u] = *(const u32x4*)(Zm + (size_t)(tok0 + wave * 16 + tb * 8 + u) * 4096 + 1024 + lane * 8);
#pragma unroll
                    for (int u = 0; u < 8; ++u) { const int pos = pos0 + wave * 16 + tb * 8 + u; const u32x4 w = w8[u];
                        float* ov = a.out + OUTV + ((((size_t)bb * 2 + l) * 8 + hd) * 256 + pos) * 64 + j * 8;
                        *(f32x4*)ov = (f32x4){bflo(w.x), bfhi(w.x), bflo(w.y), bfhi(w.y)}; *(f32x4*)(ov + 4) = (f32x4){bflo(w.z), bfhi(w.z), bflo(w.w), bfhi(w.w)}; }
                }
            }
            for (int sub = 0; sub < 4; ++sub)
                transpose128<false>(Zm + (size_t)tok0 * 4096 + 1024 + sub * 128, 4096, vt + (size_t)sub * 128 * npos, npos, lds, tid, nullptr, nullptr);
        } else if (task == 2) {
            LAS float* rtab = (LAS float*)(lds + 40960);
#pragma unroll 1
            for (int tb = 0; tb < 2; ++tb) {
                u32x4 w8[8];
#pragma unroll
                for (int u = 0; u < 8; ++u) w8[u] = *(const u32x4*)(Zm + (size_t)(tok0 + wave * 16 + tb * 8 + u) * 4096 + 2048 + lane * 8);
#pragma unroll
                for (int u = 0; u < 8; ++u) { const u32x4 w = w8[u];
                    float s = bflo(w.x) * bflo(w.x) + bfhi(w.x) * bfhi(w.x) + bflo(w.y) * bflo(w.y) + bfhi(w.y) * bfhi(w.y) + bflo(w.z) * bflo(w.z) + bfhi(w.z) * bfhi(w.z) + bflo(w.w) * bflo(w.w) + bfhi(w.w) * bfhi(w.w);
                    s = wave_sum(s); if (lane == 0) rtab[wave * 16 + tb * 8 + u] = rsqrtf(s * (1.f / 512.f) + 1e-6f); }
            }
            __syncthreads();
            for (int sub = 0; sub < 4; ++sub)
                transpose128<true>(Zm + (size_t)tok0 * 4096 + 2048 + sub * 128, 4096, (bf16_t*)(ws + O_VNT) + ((size_t)tt * 512 + sub * 128) * 128, 128, lds, tid, rtab, a.in[I_GNG] + l * 512 + sub * 128);
        } else if (task == 3 || task == 4) {
            const int part = task - 3;
            bf16_t* tb = (bf16_t*)(ws + O_TT) + (ctx ? (size_t)bb * 512 * 512 : (size_t)16 * 512 * 512 + (size_t)bb * 512 * 2048) + part * npos + pos0;
            for (int sub = 0; sub < 4; ++sub)
                transpose128<false>(Zm + (size_t)tok0 * 4096 + 2560 + part * 512 + sub * 128, 4096, tb + (size_t)sub * 128 * 2 * npos, 2 * npos, lds, tid, nullptr, nullptr);
        } else {
            const int gi = wave & 3, half = wave >> 2, tsub = lane >> 4, c8 = gi * 16 + (lane & 15);
            const bf16_t* base = Zm + (size_t)(tok0 - pos0) * 4096 + 3584 + c8 * 8;
            bf16_t* outp = (bf16_t*)(ws + O_BR) + (size_t)tok0 * 2048 + 1536 + c8 * 8;
            if (gi == 0) pool_rows<2>(base, outp, pos0, npos, half * 64, tsub);
            else if (gi == 1) pool_rows<4>(base, outp, pos0, npos, half * 64, tsub);
            else if (gi == 2) pool_rows<8>(base, outp, pos0, npos, half * 64, tsub);
            else pool_rows<16>(base, outp, pos0, npos, half * 64, tsub);
        }
    }
}

#define MFMA16(a, b, c) __builtin_amdgcn_mfma_f32_16x16x32_bf16(a, b, c, 0, 0, 0)
struct KVF { bf16x8 k[4]; bf16x8 v[4]; };
struct KVOff { unsigned k0, k1, v[4]; };
__device__ __forceinline__ KVOff kv_off(int ldk, int ldv, int lane) {
    const int i = lane & 15, g = lane >> 4; const int ko0 = 8 * (i >> 2) + (i & 3);
    KVOff o; o.k0 = (unsigned)(ko0 * ldk + 8 * g) * 2u; o.k1 = o.k0 + (unsigned)(4 * ldk) * 2u;
#pragma unroll
    for (int dt = 0; dt < 4; ++dt) o.v[dt] = (unsigned)((16 * dt + i) * ldv + 8 * g) * 2u;
    return o;
}
__device__ __forceinline__ void kv_load(KVF& f, const bf16_t* kp, const bf16_t* vp, const KVOff& o) {
    const char* kc = (const char*)kp; const char* vc = (const char*)vp;
    f.k[0] = *(const bf16x8*)(kc + o.k0); f.k[1] = *(const bf16x8*)(kc + o.k0 + 64); f.k[2] = *(const bf16x8*)(kc + o.k1); f.k[3] = *(const bf16x8*)(kc + o.k1 + 64);
#pragma unroll
    for (int dt = 0; dt < 4; ++dt) f.v[dt] = *(const bf16x8*)(vc + o.v[dt]);
}
struct QSt { f32x4 o[4]; float m, lsum; };
__device__ __forceinline__ void attn_step(const KVF& f, const bf16x8 (&qf)[2], const float (&sb)[8], bool use_sb, QSt& st) {
    f32x4 s0 = {0.f, 0.f, 0.f, 0.f}, s1 = {0.f, 0.f, 0.f, 0.f};
    s0 = MFMA16(f.k[0], qf[0], s0); s0 = MFMA16(f.k[1], qf[1], s0);
    s1 = MFMA16(f.k[2], qf[0], s1); s1 = MFMA16(f.k[3], qf[1], s1);
    float s[8] = {s0[0], s0[1], s0[2], s0[3], s1[0], s1[1], s1[2], s1[3]};
    if (use_sb) {
#pragma unroll
        for (int e = 0; e < 8; ++e) s[e] = sb[e] < -1e29f ? -3e30f : s[e] + sb[e];
    }
    float mx = fmaxf(fmaxf(fmaxf(s[0], s[1]), fmaxf(s[2], s[3])), fmaxf(fmaxf(s[4], s[5]), fmaxf(s[6], s[7])));
    mx = fmaxf(mx, __shfl_xor(mx, 16)); mx = fmaxf(mx, __shfl_xor(mx, 32));
    const float mn = fmaxf(st.m, mx); const float alpha = fast_exp(st.m - mn); st.m = mn;
    float ps = 0.f;
#pragma unroll
    for (int e = 0; e < 8; ++e) { s[e] = fast_exp(s[e] - mn); ps += s[e]; }
    st.lsum = st.lsum * alpha + ps;
#pragma unroll
    for (int dt = 0; dt < 4; ++dt) st.o[dt] *= alpha;
    u32x4 pw; pw.x = cvt_pk_bf16(s[0], s[1]); pw.y = cvt_pk_bf16(s[2], s[3]); pw.z = cvt_pk_bf16(s[4], s[5]); pw.w = cvt_pk_bf16(s[6], s[7]);
    const bf16x8 pf = __builtin_bit_cast(bf16x8, pw);
#pragma unroll
    for (int dt = 0; dt < 4; ++dt) st.o[dt] = MFMA16(f.v[dt], pf, st.o[dt]);
}
__device__ __forceinline__ void attn_step2(const KVF& f0, const KVF& f1, const bf16x8 (&qf)[2], QSt& st) {
    f32x4 s0 = {0.f, 0.f, 0.f, 0.f}, s1 = {0.f, 0.f, 0.f, 0.f}, s2 = {0.f, 0.f, 0.f, 0.f}, s3 = {0.f, 0.f, 0.f, 0.f};
    s0 = MFMA16(f0.k[0], qf[0], s0); s1 = MFMA16(f0.k[2], qf[0], s1); s2 = MFMA16(f1.k[0], qf[0], s2); s3 = MFMA16(f1.k[2], qf[0], s3);
    s0 = MFMA16(f0.k[1], qf[1], s0); s1 = MFMA16(f0.k[3], qf[1], s1); s2 = MFMA16(f1.k[1], qf[1], s2); s3 = MFMA16(f1.k[3], qf[1], s3);
    float s[16] = {s0[0], s0[1], s0[2], s0[3], s1[0], s1[1], s1[2], s1[3], s2[0], s2[1], s2[2], s2[3], s3[0], s3[1], s3[2], s3[3]};
    float mx = fmaxf(fmaxf(fmaxf(s[0], s[1]), fmaxf(s[2], s[3])), fmaxf(fmaxf(s[4], s[5]), fmaxf(s[6], s[7])));
    mx = fmaxf(mx, fmaxf(fmaxf(fmaxf(s[8], s[9]), fmaxf(s[10], s[11])), fmaxf(fmaxf(s[12], s[13]), fmaxf(s[14], s[15]))));
    mx = fmaxf(mx, __shfl_xor(mx, 16)); mx = fmaxf(mx, __shfl_xor(mx, 32));
    const float mn = fmaxf(st.m, mx); const float alpha = fast_exp(st.m - mn); st.m = mn;
    float ps = 0.f;
#pragma unroll
    for (int e = 0; e < 16; ++e) { s[e] = fast_exp(s[e] - mn); ps += s[e]; }
    st.lsum = st.lsum * alpha + ps;
#pragma unroll
    for (int dt = 0; dt < 4; ++dt) st.o[dt] *= alpha;
    u32x4 pw0, pw1; pw0.x = cvt_pk_bf16(s[0], s[1]); pw0.y = cvt_pk_bf16(s[2], s[3]); pw0.z = cvt_pk_bf16(s[4], s[5]); pw0.w = cvt_pk_bf16(s[6], s[7]);
    pw1.x = cvt_pk_bf16(s[8], s[9]); pw1.y = cvt_pk_bf16(s[10], s[11]); pw1.z = cvt_pk_bf16(s[12], s[13]); pw1.w = cvt_pk_bf16(s[14], s[15]);
    const bf16x8 pf0 = __builtin_bit_cast(bf16x8, pw0), pf1 = __builtin_bit_cast(bf16x8, pw1);
#pragma unroll
    for (int dt = 0; dt < 4; ++dt) { st.o[dt] = MFMA16(f0.v[dt], pf0, st.o[dt]); st.o[dt] = MFMA16(f1.v[dt], pf1, st.o[dt]); }
}
__device__ __forceinline__ void attn_store(const QSt& st0, bf16_t* op) {
    QSt st = st0; st.lsum += __shfl_xor(st.lsum, 16); st.lsum += __shfl_xor(st.lsum, 32);
    const float inv = 1.0f / st.lsum;
#pragma unroll
    for (int dt = 0; dt < 4; ++dt) { u32x2 w2; w2.x = cvt_pk_bf16(st.o[dt][0] * inv, st.o[dt][1] * inv); w2.y = cvt_pk_bf16(st.o[dt][2] * inv, st.o[dt][3] * inv); *(u32x2*)(op + 16 * dt) = w2; }
}
__device__ __forceinline__ void local_bias(float (&sb)[8], const LAS float* tab, int dr, int kc0, int g, int cq, int cs) {
    asm volatile("" : "+v"(g));
#pragma unroll
    for (int e = 0; e < 8; ++e) { const int kc = kc0 + 8 * g + e; const bool vis = (kc >= cs) && (kc < cs + 16);
        const float bv = tab[dr * 32 + (vis ? (kc - cq + 15) : 15)]; sb[e] = vis ? bv : -1e30f; }
}

__device__ __forceinline__ void attn_item(const Args& a, int l, int item, int lane, LAS float* tab) {
    unsigned char* ws = a.ws;
    const int q = lane & 15, g = lane >> 4;
    QSt sA, sB;
#pragma unroll
    for (int dt = 0; dt < 4; ++dt) { sA.o[dt] = (f32x4){0.f, 0.f, 0.f, 0.f}; sB.o[dt] = (f32x4){0.f, 0.f, 0.f, 0.f}; }
    sA.m = -1e30f; sA.lsum = 0.f; sB.m = -1e30f; sB.lsum = 0.f;
    float nb0[8];
    int tokq, h;
    if (item < 2048) {
        const int bb = item >> 8; h = (item >> 5) & 7; const int r = (item >> 1) & 15, p = item & 1;
        tokq = NCTXT + bb * 1024 + r * 64 + 32 * p + q;
        bf16x8 qA[2], qB[2];
        { const bf16_t* pp = (const bf16_t*)(ws + O_QP) + (size_t)tokq * 512 + h * 64 + 8 * g; qA[0] = *(const bf16x8*)pp; qA[1] = *(const bf16x8*)(pp + 32); qB[0] = *(const bf16x8*)(pp + 16 * 512); qB[1] = *(const bf16x8*)(pp + 16 * 512 + 32); }
        const bf16_t* ck = (const bf16_t*)(ws + O_CK) + (((size_t)bb * 2 + l) * 8 + h) * 512 * 64;
        const bf16_t* cv = (const bf16_t*)(ws + O_VTC) + (((size_t)bb * 2 + l) * 8 + h) * 64 * 512;
        int rs = r - 4; if (rs < 0) rs = 0; if (rs > 8) rs = 8;
        const int cqA = 32 * p + q, cqB = cqA + 16; int csA = cqA - 8; if (csA < 0) csA = 0; if (csA > 48) csA = 48; int csB = cqB - 8; if (csB < 0) csB = 0; if (csB > 48) csB = 48;
        { const float* rpb = a.in[I_RPB] + (size_t)(l * 8 + h) * 15 * 31;
          float tv[8];
#pragma unroll
          for (int u = 0; u < 8; ++u) { const int i = lane + 64 * u; tv[u] = i < 465 ? rpb[i] : 0.f; }
#pragma unroll
          for (int u = 0; u < 8; ++u) { const int i = lane + 64 * u; if (i < 465) { const int rr = (i * 2115) >> 16; tab[rr * 32 + (i - rr * 31)] = tv[u]; } } }
        const bf16_t* kl = (const bf16_t*)(ws + O_KB) + (size_t)(NCTXT + bb * 1024) * 512 + h * 64;
        const bf16_t* vl = (const bf16_t*)(ws + O_VT) + (size_t)16 * 512 * 256 + ((size_t)bb * 512 + h * 64) * 1024;
        KVF f0, f1; KVOff oc = kv_off(64, 512, lane);
#pragma unroll 1
        for (int kb = 0; kb < 16; kb += 2) {
            kv_load(f0, ck + (size_t)kb * 32 * 64, cv + kb * 32, oc);
            kv_load(f1, ck + (size_t)(kb + 1) * 32 * 64, cv + (kb + 1) * 32, oc);
            attn_step2(f0, f1, qA, sA); attn_step2(f0, f1, qB, sB);
        }
        { const bf16_t* p2 = (const bf16_t*)(ws + O_QR) + (size_t)(tokq - NCTXT) * 512 + h * 64 + 8 * g; qA[0] = *(const bf16x8*)p2; qA[1] = *(const bf16x8*)(p2 + 32); qB[0] = *(const bf16x8*)(p2 + 16 * 512); qB[1] = *(const bf16x8*)(p2 + 16 * 512 + 32); }
        oc = kv_off(512, 1024, lane);
        const int kcA = (32 * p - 8) < 0 ? 0 : (32 * p - 8), kcB = (32 * p + 8) > 32 ? 32 : (32 * p + 8);
#pragma unroll 1
        for (int wi = 0; wi < 8; ++wi) {
            const int dr = rs + wi - r + 7; const int key0 = (rs + wi) * 64;
            kv_load(f0, kl + (size_t)(key0 + kcA) * 512, vl + key0 + kcA, oc);
            kv_load(f1, kl + (size_t)(key0 + kcB) * 512, vl + key0 + kcB, oc);
            local_bias(nb0, tab, dr, kcA, g, cqA, csA); attn_step(f0, qA, nb0, true, sA);
            local_bias(nb0, tab, dr, kcB, g, cqB, csB); attn_step(f1, qB, nb0, true, sB);
        }
    } else {
        const int it = item - 2048; const int bb = it >> 6; h = (it >> 3) & 7; const int qb = it & 7;
        tokq = bb * 256 + qb * 32 + q;
        bf16x8 qpA[2], qpB[2];
        { const bf16_t* pp = (const bf16_t*)(ws + O_QP) + (size_t)tokq * 512 + h * 64 + 8 * g; qpA[0] = *(const bf16x8*)pp; qpA[1] = *(const bf16x8*)(pp + 32); qpB[0] = *(const bf16x8*)(pp + 16 * 512); qpB[1] = *(const bf16x8*)(pp + 16 * 512 + 32); }
        const bf16_t* kl = (const bf16_t*)(ws + O_KB) + (size_t)(bb * 256) * 512 + h * 64;
        const bf16_t* vl = (const bf16_t*)(ws + O_VT) + ((size_t)bb * 512 + h * 64) * 256;
        KVF f0, f1; const KVOff oc = kv_off(512, 256, lane);
#pragma unroll 1
        for (int kb = 0; kb < 8; kb += 2) {
            kv_load(f0, kl + (size_t)kb * 32 * 512, vl + kb * 32, oc);
            kv_load(f1, kl + (size_t)(kb + 1) * 32 * 512, vl + (kb + 1) * 32, oc);
            attn_step2(f0, f1, qpA, sA); attn_step2(f0, f1, qpB, sB);
        }
    }
    bf16_t* op = (bf16_t*)(ws + O_BR) + (size_t)tokq * 2048 + h * 64 + 4 * g;
    attn_store(sA, op); attn_store(sB, op + (size_t)16 * 2048);
}

__device__ __forceinline__ void gmlp_item(const Args& a, int l, int item, int lane) {
    unsigned char* ws = a.ws;
    const int tt = item >> 4, gg = (item >> 2) & 3, pb = item & 3;
    const int i = lane & 15, g = lane >> 4;
    const bf16_t* A = (const bf16_t*)(ws + O_VNT) + ((size_t)tt * 512 + gg * 128) * 128;
    const bf16_t* B = (const bf16_t*)(ws + O_WSB) + ((size_t)(l * 4 + gg) * 128 + pb * 32) * 128;
    f32x4 acc[8][2];
#pragma unroll
    for (int mi = 0; mi < 8; ++mi) { acc[mi][0] = (f32x4){0.f, 0.f, 0.f, 0.f}; acc[mi][1] = (f32x4){0.f, 0.f, 0.f, 0.f}; }
    const unsigned offA = (unsigned)(i * 128 + 8 * g) * 2u, offB = offA;
    const char* Ac = (const char*)A; const char* Bc = (const char*)B;
#define GM_LOAD(af, b0, b1, ks) do { b0 = *(const bf16x8*)(Bc + offB + (ks) * 64); b1 = *(const bf16x8*)(Bc + offB + 16 * 256 + (ks) * 64); \
        _Pragma("unroll") for (int mi = 0; mi < 8; ++mi) af[mi] = *(const bf16x8*)(Ac + offA + mi * 16 * 256 + (ks) * 64); } while (0)
#define GM_MMA(af, b0, b1) do { _Pragma("unroll") for (int mi = 0; mi < 8; ++mi) { acc[mi][0] = MFMA16(af[mi], b0, acc[mi][0]); acc[mi][1] = MFMA16(af[mi], b1, acc[mi][1]); } } while (0)
    bf16x8 afA[8], afB[4], bA0, bA1, bB0, bB1;
#define GM_LOADH(af, b0, b1, ks) do { b0 = *(const bf16x8*)(Bc + offB + (ks) * 64); b1 = *(const bf16x8*)(Bc + offB + 16 * 256 + (ks) * 64); \
        _Pragma("unroll") for (int mi = 0; mi < 4; ++mi) af[mi] = *(const bf16x8*)(Ac + offA + mi * 16 * 256 + (ks) * 64); } while (0)
#define GM_STEP(ks, last) do { \
        _Pragma("unroll") for (int mi = 0; mi < 4; ++mi) afA[mi] = afB[mi]; bA0 = bB0; bA1 = bB1; \
        _Pragma("unroll") for (int mi = 4; mi < 8; ++mi) afA[mi] = *(const bf16x8*)(Ac + offA + mi * 16 * 256 + (ks) * 64); \
        if (!(last)) GM_LOADH(afB, bB0, bB1, (ks) + 1); \
        GM_MMA(afA, bA0, bA1); } while (0)
    GM_LOADH(afB, bB0, bB1, 0);
    GM_STEP(0, false); GM_STEP(1, false); GM_STEP(2, false); GM_STEP(3, true);
#undef GM_LOADH
#undef GM_STEP
#undef GM_LOAD
#undef GM_MMA
    const bf16_t* Zm = (const bf16_t*)(ws + O_ZM);
#pragma unroll
    for (int nj = 0; nj < 2; ++nj) { const int p = pb * 32 + 16 * nj + i; const int tok = tt * 128 + p; const float bs = a.in[I_BSP][(l * 4 + gg) * 128 + p];
        u32x2 uw[8];
#pragma unroll
        for (int mi = 0; mi < 8; ++mi) uw[mi] = *(const u32x2*)(Zm + (size_t)tok * 4096 + 1536 + gg * 128 + 16 * mi + 4 * g);
#pragma unroll
        for (int mi = 0; mi < 8; ++mi) { const int c = gg * 128 + 16 * mi + 4 * g; const f32x4 v = acc[mi][nj];
            u32x2 ow; ow.x = cvt_pk_bf16(bflo(uw[mi].x) * (v[0] + bs), bfhi(uw[mi].x) * (v[1] + bs)); ow.y = cvt_pk_bf16(bflo(uw[mi].y) * (v[2] + bs), bfhi(uw[mi].y) * (v[3] + bs));
            *(u32x2*)((bf16_t*)(ws + O_BR) + (size_t)tok * 2048 + 512 + c) = ow; } }
}

#define XB_TMO      128
#define XB_XCNT(j)  (256  + 64 * (j))
#define XB_XSUB(j)  (1280 + 64 * (j))
#define XB_XGEN(j)  (2304 + 64 * (j))
#define XB_TOP      3328
#define XB_TOPGEN   3392
#define XCD_BAR_WORDS 3456
#define XB_SPIN_CAP (1u << 22)
constexpr int CW_BAR = 4096, CW_FLAG = 8192;
__device__ __forceinline__ unsigned xb_ld(unsigned* p)              { return __hip_atomic_load(p, __ATOMIC_RELAXED, __HIP_MEMORY_SCOPE_AGENT); }
__device__ __forceinline__ unsigned xb_add(unsigned* p, unsigned v) { return __hip_atomic_fetch_add(p, v, __ATOMIC_RELAXED, __HIP_MEMORY_SCOPE_AGENT); }
__device__ __forceinline__ unsigned xb_xcc_id() { return (unsigned)__builtin_amdgcn_s_getreg((3 << 11) | 20) & 0xFu; }
#define XB_SPIN(cond, bar) do { unsigned _sp = 0; while (cond) { __builtin_amdgcn_s_sleep(1); \
    if ((++_sp & 255u) == 0u) { if (xb_ld(&(bar)[XB_TMO])) break; if (_sp > XB_SPIN_CAP) { atomicAdd(&(bar)[XB_TMO], 1u); break; } } } } while (0)
struct XcdBarrier { unsigned* bar; unsigned x; volatile LAS unsigned* st; };
__device__ __forceinline__ XcdBarrier xcd_barrier_post(unsigned* bar, volatile LAS unsigned* st) {
    XcdBarrier b; b.bar = bar; b.x = xb_xcc_id(); b.st = st;
    if (threadIdx.x == 0) (void)xb_add(&bar[XB_XCNT(b.x)], 1u);
    return b;
}
__device__ __forceinline__ void xcd_barrier_complete(unsigned* bar, unsigned x, unsigned& nloc, unsigned& nx) {
    const unsigned G = gridDim.x * gridDim.y * gridDim.z;
    unsigned sum, cnt, mine, sp = 0u;
    for (;;) {
        sum = 0u; cnt = 0u; mine = 0u;
#pragma unroll
        for (unsigned j = 0; j < 16; ++j) { const unsigned c = xb_ld(&bar[XB_XCNT(j)]); sum += c; cnt += (c > 0u) ? 1u : 0u; mine = (j == x) ? c : mine; }
        if (sum == G) break;
        __builtin_amdgcn_s_sleep(1);
        if ((++sp & 255u) == 0u) { if (xb_ld(&bar[XB_TMO])) break; if (sp > XB_SPIN_CAP) { atomicAdd(&bar[XB_TMO], 1u); break; } }
    }
    nloc = mine > 0u ? mine : 1u; nx = cnt > 0u ? cnt : 1u;
}
__device__ __forceinline__ void xcd_barrier(const XcdBarrier& b) {
    asm volatile("s_waitcnt vmcnt(0)" ::: "memory");
    __syncthreads();
    if (threadIdx.x == 0) {
        unsigned* bar = b.bar;
        __builtin_amdgcn_s_waitcnt(0);
        unsigned nloc = b.st[0], nx = b.st[1];
        if (nloc == 0u) { xcd_barrier_complete(bar, b.x, nloc, nx); b.st[0] = nloc; b.st[1] = nx; }
        const unsigned old = xb_add(&bar[XB_XSUB(b.x)], 1u);
        const unsigned gen = old / nloc;
        if (old + 1u == (gen + 1u) * nloc) {
            __builtin_amdgcn_fence(__ATOMIC_RELEASE, "agent");
            asm volatile("s_waitcnt vmcnt(0)" ::: "memory");
            const unsigned og = xb_add(&bar[XB_TOP], 1u);
            const unsigned tg = og / nx;
            if (og + 1u == (tg + 1u) * nx) xb_add(&bar[XB_TOPGEN], 1u);
            else XB_SPIN(xb_ld(&bar[XB_TOPGEN]) == tg, bar);
            __builtin_amdgcn_fence(__ATOMIC_ACQUIRE, "agent");
            xb_add(&bar[XB_XGEN(b.x)], 1u);
            asm volatile("s_waitcnt vmcnt(0)" ::: "memory");
        } else {
            XB_SPIN(xb_ld(&bar[XB_XGEN(b.x)]) == gen, bar);
            __builtin_amdgcn_fence(__ATOMIC_ACQUIRE, "agent");
            asm volatile("s_waitcnt vmcnt(0)" ::: "memory");
        }
    }
    __syncthreads();
}

__global__ void __launch_bounds__(512, 2) fwd(Args a) {
    extern __shared__ __attribute__((aligned(16))) unsigned char lds_raw[];
    LAS unsigned char* lds = (LAS unsigned char*)lds_raw;
    cg::grid_group grid = cg::this_grid();
    int tid0 = threadIdx.x; const int wave = __builtin_amdgcn_readfirstlane(tid0 >> 6), G = gridDim.x, bid = blockIdx.x;
#define OPQ int tid = tid0; asm volatile("" : "+v"(tid)); const int lane = tid & 63; (void)lane;
    unsigned char* ws = a.ws;
    const int lo = a.ph_lo, hi = a.ph_hi;
    int ph = 0;
#ifndef EN
#define EN 0xFFFF
#endif
#define RUN(k) ((k) >= lo && (k) < hi)
#define ENB(t) if constexpr ((EN >> (t)) & 1)
#ifndef DUP
#define DUP 0
#endif
#define REP(t) _Pragma("nounroll") for (int rep = 0; rep < ((((DUP) >> (t)) & 1) ? 2 : 1); ++rep)
#define REPSYNC(t) do { if (((((DUP) >> (t)) & 1)) && rep == 0) xcd_barrier(xbar); } while (0)
#define SEAM(k) do { if ((k) + 1 < hi) xcd_barrier(xbar); } while (0)

    const bool ksplit = (G == 256) && (hi - lo > 1);
    XcdBarrier xbar; xbar.bar = (unsigned*)(ws + O_CTL) + CW_BAR; xbar.x = 0; xbar.st = (volatile LAS unsigned*)(lds + 131072 + 64);
    if (hi - lo > 1) {
        if (tid0 < 2) xbar.st[tid0] = 0u;
        if (bid == 0) { for (int i = tid0; i < XCD_BAR_WORDS; i += 512) xbar.bar[i] = 0u; if (tid0 < 16) ((unsigned*)(ws + O_CTL))[64 * tid0] = 0u; if (tid0 < 32) ((unsigned*)(ws + O_CTL))[1024 + 64 * tid0] = 0u;
            for (int i = tid0; i < 12288; i += 512) ((unsigned*)(ws + O_CTL))[CW_FLAG + i] = 0u; }
        grid.sync();
        xbar = xcd_barrier_post(xbar.bar, xbar.st);
    }
    if (RUN(0)) { REP(0) { ENB(0) { OPQ phase_p0(a, lds, tid, lane, wave, G, bid); } REPSYNC(0); } SEAM(0); }
    if (RUN(1)) { ENB(1) {
#pragma nounroll
        for (int pass = 0; pass < 2; ++pass) {
            pg8::SchedFold S{(const char*)(ws + (pass ? O_WBD : O_CS)), (const char*)(ws + (pass ? O_BDP : O_WFN)), pass, pass ? bid - 64 : bid};
            pg8::EpiStore E{(bf16_t*)(ws + (pass ? O_WBT : O_WINT)), 2048};
            pg8::gemm_phase(lds, pass ? 512 : 256, pass ? 512 : 128, pass ? 512 : 256, S, E); }
        { OPQ phase_p1_modreduce(a, tid, G, bid); } }
        SEAM(1);
    }
    for (int l = 0; l < 2; ++l) {
        const int p0 = 2 + 9 * l;
        const float* mod_l = (const float*)(ws + O_MOD) + (size_t)l * NCOND * 6 * 2048;
        if (RUN(p0 + 0)) {
#ifdef EXP_NANFILL
            { OPQ for (int i = bid * 512 + tid; i < 12288 * 1024; i += G * 512) ((u32x4*)(ws + O_ZG))[i] = (u32x4){0x7fc07fc0u, 0x7fc07fc0u, 0x7fc07fc0u, 0x7fc07fc0u}; }
#endif
            REP(2) { ENB(2) { OPQ phase_norm(a, l, 0, l == 0, lane, wave, G, bid); } REPSYNC(2); } SEAM(p0 + 0); }
        if (RUN(p0 + 1)) { REP(3) { ENB(3) {
            pg8::SchedMN S{(const char*)(ws + O_H), (const char*)(ws + O_WINT) + (size_t)l * 12288 * 2048 * 2, 2048, 2048, 48, 48, G, bid, 0, 48 * 48, 0, 0, 0, 0};
            pg8::EpiZ E{(bf16_t*)(ws + O_ZM), (bf16_t*)(ws + O_ZG), a.in[I_BGATE] + (size_t)l * 8192};
            pg8::gemm_phase(lds, 2048, 2048, 2048, S, E); } REPSYNC(3); }
            SEAM(p0 + 1);
        }
        if (RUN(p0 + 2)) { REP(4) { ENB(4) { OPQ phase_prep(a, l, lds, tid, lane, wave, G, bid); } REPSYNC(4); } SEAM(p0 + 2); }
        if (RUN(p0 + 3)) { REP(5) { ENB(5) {
#pragma nounroll
            for (int pass = 0; pass < 2; ++pass) { const int lat = 1 - pass, Kd = lat ? 2048 : 512;
              pg8::SchedDFT S{(const char*)(ws + (lat ? O_DFT1024 : O_DFT256)), (const char*)(ws + O_TT) + (lat ? (size_t)16 * 512 * 512 * 2 : 0), lat, lat ? bid : bid - 64}; pg8::EpiStore E{(bf16_t*)(ws + O_BR), 2048};
              pg8::gemm_phase(lds, Kd, Kd, Kd, S, E); }
            } ENB(10) { OPQ
            unsigned* cbase = (unsigned*)(ws + O_CTL) + 1024 + (l + 2 * rep) * 8 * 64;
            const int myx = (int)(xb_xcc_id() & 7u);
            constexpr int CPX = (3072 + 1536) / 8;
#pragma unroll 1
            for (int k = 0; k < 8; ++k) {
                const int x = (myx + k) & 7; unsigned* ctr = cbase + x * 64;
                for (;;) {
                    int c = CPX;
                    if (lane == 0) { if (__hip_atomic_load(ctr, __ATOMIC_RELAXED, __HIP_MEMORY_SCOPE_AGENT) < (unsigned)CPX) c = (int)atomicAdd(ctr, 1u); }
                    c = __builtin_amdgcn_readfirstlane(c);
                    if (c >= CPX) break;
                    const int idx = (((c >> 5) * 8 + x) << 5) + (c & 31);
                    if (idx < 3072) attn_item(a, l, idx, lane, (LAS float*)(lds + 131072 + 512 + wave * 1920)); else gmlp_item(a, l, idx - 3072, lane);
                }
            } } REPSYNC(5); }
            SEAM(p0 + 3);
        }
        if (RUN(p0 + 4)) { REP(6) { ENB(6) {
            const int nps = ksplit ? 2 : 1;
#pragma nounroll
            for (int pass = 0; pass < nps; ++pass) {
                pg8::SchedMN S{(const char*)(ws + O_BR), (const char*)(ws + O_WBT) + (size_t)l * DM * DM * 2, 2048, 2048, 48, 8, G, bid, 0, ksplit ? 256 : 384, pass, 256, 128, 1024 * 2};
                pg8::EpiBR E{(const bf16_t*)(ws + O_ZG), (bf16_t*)(ws + O_H), (float*)(ws + O_ZM), (unsigned*)(ws + O_CTL) + CW_FLAG + (4 + l) * 128 * 16};
                pg8::gemm_phase(lds, 2048, 2048, pass ? 1024 : 2048, S, E); } } REPSYNC(6); }
            SEAM(p0 + 4);
        }
        if (RUN(p0 + 5)) { ENB(7) {
            const int nps = ksplit ? 2 : 1;
#pragma nounroll
            for (int pass = 0; pass < nps; ++pass) {
                pg8::SchedMN S{(const char*)(ws + O_H), (const char*)(ws + O_WOT) + (size_t)l * DM * DM * 2, 2048, 2048, 48, 8, G, bid, 0, ksplit ? 256 : 384, pass, 256, 128, 1024 * 2};
                pg8::EpiRes E{l == 0 ? a.in[I_XP] : a.out, l == 0 ? a.in[I_XS] : a.out + (size_t)NCTXT * DM, a.out, mod_l, 2, (float*)(ws + O_ZM), (unsigned*)(ws + O_CTL) + CW_FLAG + (l * 2 + 0) * 128 * 16};
                pg8::gemm_phase(lds, 2048, 2048, pass ? 1024 : 2048, S, E); } }
            SEAM(p0 + 5);
        }
        if (RUN(p0 + 6)) { ENB(2) { OPQ phase_norm(a, l, 3, false, lane, wave, G, bid); } SEAM(p0 + 6); }
        if (RUN(p0 + 7)) { REP(8) { ENB(8) {
            pg8::SchedMN S{(const char*)(ws + O_H), (const char*)(ws + O_W1T) + (size_t)l * DFF * DM * 2, 2048, 2048, 48, 32, G, bid, 0, 48 * 32, 0, 0, 0, 0};
            pg8::EpiHid E{(bf16_t*)(ws + O_ZG)};
            pg8::gemm_phase(lds, 2048, 2048, 2048, S, E); } REPSYNC(8); }
            SEAM(p0 + 7);
        }
        if (RUN(p0 + 8)) { ENB(9) {
            const int nps = ksplit ? 2 : 1;
#pragma nounroll
            for (int pass = 0; pass < nps; ++pass) {
                pg8::SchedMN S{(const char*)(ws + O_ZG), (const char*)(ws + O_W2T) + (size_t)l * DM * DFF * 2, 8192, 8192, 48, 8, G, bid, 0, ksplit ? 256 : 384, pass, 256, 128, 4096 * 2};
                pg8::EpiRes E{a.out, a.out + (size_t)NCTXT * DM, a.out, mod_l, 5, (float*)(ws + O_ZM), (unsigned*)(ws + O_CTL) + CW_FLAG + (l * 2 + 1) * 128 * 16};
                pg8::gemm_phase(lds, 8192, 8192, pass ? 4096 : 8192, S, E); } }
            SEAM(p0 + 8);
        }
    }
    (void)ph;
}

extern "C" void kernel_launch(void* const* d_in, const int* in_sizes, int n_in, void* d_out, int out_size, void* d_ws, size_t ws_size, hipStream_t stream) {
    static int grid = 0;
    if (grid == 0) {
        if (n_in != 24 || ws_size < WS_NEED) { fprintf(stderr, "kernel_launch: need 24 inputs and %zu B of workspace (got %d, %zu)\n", (size_t)WS_NEED, n_in, ws_size); grid = -1; return; }
        int dev = 0, cus = 0, per_cu = 0;
        hipGetDevice(&dev); hipDeviceGetAttribute(&cus, hipDeviceAttributeMultiprocessorCount, dev);
        if (hipFuncSetAttribute((const void*)fwd, hipFuncAttributeMaxDynamicSharedMemorySize, LDS_BYTES) != hipSuccess) { fprintf(stderr, "kernel_launch: hipFuncSetAttribute failed\n"); grid = -1; return; }
        if (hipOccupancyMaxActiveBlocksPerMultiprocessor(&per_cu, (const void*)fwd, 512, LDS_BYTES) != hipSuccess || per_cu < 1) { fprintf(stderr, "kernel_launch: occupancy query says %d\n", per_cu); per_cu = 1; }
        (void)hipGetLastError();
        grid = cus;
    }
    if (grid < 0) return;
    Args a{};
    for (int i = 0; i < 24; ++i) a.in[i] = (const float*)d_in[i];
    a.out = (float*)d_out; a.ws = (unsigned char*)d_ws;
#if N_LAUNCH_MODE == 1
    a.ph_lo = 0; a.ph_hi = NPHASE;
    void* args[] = {&a};
    hipError_t e = hipLaunchCooperativeKernel((const void*)fwd, dim3(grid), dim3(512), args, LDS_BYTES, stream);
    if (e != hipSuccess) fprintf(stderr, "kernel_launch: cooperative launch failed: %s (grid %d)\n", hipGetErrorString(e), grid);
#else
    for (int p = 0; p < NPHASE; ++p) { a.ph_lo = p; a.ph_hi = p + 1; hipLaunchKernelGGL(fwd, dim3(grid), dim3(512), LDS_BYTES, stream, a); }
#endif
}
```

```cpp
#include <hip/hip_runtime.h>
#include <hip/hip_cooperative_groups.h>
#include <cstdio>
#include <cstdint>
namespace cg = cooperative_groups;


#ifndef N_LAUNCH_MODE
#define N_LAUNCH_MODE 1
#endif

#define LAS __attribute__((address_space(3)))
typedef unsigned short bf16_t;
typedef short bf16x8 __attribute__((ext_vector_type(8)));
typedef float f32x4 __attribute__((ext_vector_type(4)));
typedef float f32x2 __attribute__((ext_vector_type(2)));
typedef unsigned u32x4 __attribute__((ext_vector_type(4)));
typedef unsigned u32x2 __attribute__((ext_vector_type(2)));

constexpr int DM = 2048, NTOK = 12288, NCTXT = 4096, DFF = 8192, INC = 11776;
constexpr int NCOND = 9;
constexpr size_t MiB = 1u << 20;
constexpr size_t O_CTL = 0, O_WINT = 1 * MiB, O_WBT = 97 * MiB, O_WOT = 113 * MiB, O_W1T = 129 * MiB, O_W2T = 193 * MiB,
                 O_WFN = 257 * MiB, O_WBD = 261 * MiB, O_BDP = 265 * MiB, O_CS = 266 * MiB, O_DFT256 = 267 * MiB, O_DFT1024 = 268 * MiB,
                 O_WSB = 272 * MiB, O_MODP = 273 * MiB, O_MOD = 287 * MiB, O_CK = 288 * MiB, O_VTC = 296 * MiB, O_H = 304 * MiB,
                 O_ZM = 352 * MiB, O_ZG = 448 * MiB, O_QP = 640 * MiB, O_QR = 652 * MiB, O_KB = 660 * MiB, O_VT = 672 * MiB,
                 O_VNT = 684 * MiB, O_TT = 696 * MiB, O_BR = 720 * MiB, WS_NEED = 768 * MiB;
constexpr size_t OUTK = (size_t)NTOK * DM, OUTV = OUTK + (size_t)16 * 2 * 8 * 256 * 64;
constexpr int LDS_BYTES = 147456;
constexpr int NPHASE = 2 + 9 * 2;

struct Args { const float* in[24]; float* out; unsigned char* ws; int ph_lo, ph_hi; };
enum { I_XP = 0, I_XS, I_CK, I_CV, I_C, I_CCTX, I_N1G, I_WIN, I_BGATE, I_QNG, I_KNG, I_RPB, I_GNG, I_WSP, I_BSP, I_WPOOL, I_PSC, I_WBR, I_WOUT, I_N2G, I_W1, I_W2, I_WADA, I_BADA };

typedef __bf16 bf16x2_t __attribute__((ext_vector_type(2)));
__device__ __forceinline__ unsigned cvt_pk_bf16(float lo, float hi) { const f32x2 v = {lo, hi}; const bf16x2_t b = __builtin_convertvector(v, bf16x2_t); return __builtin_bit_cast(unsigned, b); }
__device__ __forceinline__ float bf2f(unsigned short u) { return __uint_as_float(((unsigned)u) << 16); }
__device__ __forceinline__ float bflo(unsigned u) { return __uint_as_float(u << 16); }
__device__ __forceinline__ float bfhi(unsigned u) { return __uint_as_float(u & 0xffff0000u); }
__device__ __forceinline__ bf16_t f2bf(float f) { return (bf16_t)(cvt_pk_bf16(f, 0.f) & 0xffffu); }
__device__ __forceinline__ float wave_sum(float v) {
#pragma unroll
    for (int o = 1; o < 64; o <<= 1) v += __shfl_xor(v, o);
    return v;
}
__device__ __forceinline__ float fast_exp(float x) { return __builtin_amdgcn_exp2f(x * 1.44269504089f); }
__device__ __forceinline__ float sigmoidf_(float x) { return __builtin_amdgcn_rcpf(1.0f + fast_exp(-x)); }
__device__ __forceinline__ float gelu_tanh(float x) { const float u = 0.7978845608f * (x + 0.044715f * x * x * x); return x * sigmoidf_(2.0f * u); }
#define LDS_WAIT() asm volatile("s_waitcnt lgkmcnt(0)" ::: "memory")
#define VM_WAIT() asm volatile("s_waitcnt vmcnt(0)" ::: "memory")

namespace pg8 {
constexpr int BM = 256, BK = 64, HALF = 128, HTB = HALF * BK * 2, STAGE_BYTES = 8 * HTB;
__device__ __forceinline__ int lds_byte(int r, int c) { const int st = (r >> 4) * 2 + (c >> 5), rr = r & 15, cc = c & 31, ob = rr * 64 + cc * 2; return st * 1024 + (ob ^ (((ob >> 9) & 1) << 5)); }
__device__ __forceinline__ void stage_rc(int b, int& R, int& C) { const int st = b / 1024, sb = b % 1024, swz = sb ^ (((sb >> 9) & 1) << 5); R = (st >> 1) * 16 + swz / 64; C = (st & 1) * 32 + (swz % 64) / 2; }
__device__ __forceinline__ int perm32(int rho) { const int n = rho >> 4, i = rho & 15; return 8 * (i >> 2) + 4 * n + (i & 3); }

struct Unit { const char* A; const char* B; long hA; int orow0, orow1, ocol, aux; };
__device__ __forceinline__ void tile_map(int L, int nM, int nN, int& pm, int& pn) {
    const int nwg = nM * nN; int wgid = L;
    { const int q = nwg / 8, r = nwg % 8, xcd = wgid % 8, off = wgid / 8; wgid = (xcd < r ? xcd * (q + 1) : r * (q + 1) + (xcd - r) * q) + off; }
    const int nig = 8 * nN, gid = wgid / nig, fm = gid * 8, gsz = (nM - fm) < 8 ? (nM - fm) : 8;
    pm = fm + ((wgid % nig) % gsz); pn = (wgid % nig) / gsz;
}
template <class Epi, class Sched>
__device__ __forceinline__ void gemm_phase(LAS unsigned char* lds, const int lda, const int ldb, const int K, const Sched& S, const Epi& E) {
    int tid = threadIdx.x; asm volatile("" : "+v"(tid));
    const int wid = __builtin_amdgcn_readfirstlane(tid >> 6), lane = tid & 63, wr = wid >> 2, wc = wid & 3, fr = lane & 15, fq = lane >> 4;
    const int nt = K / BK;
    unsigned voffA[2], voffB[2];
#pragma unroll
    for (int i = 0; i < 2; ++i) { int R, C; stage_rc(tid * 16 + i * 8192, R, C); const int Rb = (R & ~31) + perm32(R & 31);
        voffA[i] = (unsigned)(R * lda + C) * 2u; voffB[i] = (unsigned)(Rb * ldb + C) * 2u; }
    const size_t kstep = (size_t)(BK * 2);
    const size_t hstepB = (size_t)HALF * ldb * 2;
    const unsigned ldsw = (unsigned)wid * 1024u;
    const int aoff = lds_byte(wr * 64 + fr, fq * 8), boff = lds_byte(wc * 32 + fr, fq * 8);
#define PG8_SA(b, h) (((b) * 2 + (h)) * HTB)
#define PG8_SB(b, h) ((4 + (b) * 2 + (h)) * HTB)
#define PG8_STAGE(bufoff, gbase, voff) do { _Pragma("unroll") for (int _i = 0; _i < 2; ++_i) \
        __builtin_amdgcn_global_load_lds((const unsigned*)((const char*)(gbase) + (voff)[_i]), (LAS unsigned*)(lds + (bufoff) + ldsw + _i * 8192), 16, 0, 0); } while (0)
#define PG8_LDA(dst, b, h) do { _Pragma("unroll") for (int m = 0; m < 4; ++m) _Pragma("unroll") for (int k = 0; k < 2; ++k) dst[m][k] = *(const LAS bf16x8*)(lds + PG8_SA(b, h) + aoff + m * 2048 + k * 1024); } while (0)
#define PG8_LDB(dst, b, h) do { _Pragma("unroll") for (int n = 0; n < 2; ++n) _Pragma("unroll") for (int k = 0; k < 2; ++k) dst[n][k] = *(const LAS bf16x8*)(lds + PG8_SB(b, h) + boff + n * 2048 + k * 1024); } while (0)
#define PG8_MMA(ai, bj, At, Bt) do { __builtin_amdgcn_s_setprio(1); _Pragma("unroll") for (int m = 0; m < 4; ++m) _Pragma("unroll") for (int n = 0; n < 2; ++n) _Pragma("unroll") for (int k = 0; k < 2; ++k) \
        acc[ai][bj][m][n] = __builtin_amdgcn_mfma_f32_16x16x32_bf16(Bt[n][k], At[m][k], acc[ai][bj][m][n], 0, 0, 0); __builtin_amdgcn_s_setprio(0); } while (0)
#define PG8_WAIT_V(n) asm volatile("s_waitcnt vmcnt(" #n ")" ::: "memory")
#define PG8_WAIT_L(n) asm volatile("s_waitcnt lgkmcnt(" #n ")" ::: "memory")
#define PG8_BAR __builtin_amdgcn_s_barrier()
#define PG8_SCHED __builtin_amdgcn_sched_barrier(0)
    Unit cur, nxt; int ui = 0;
    if (!S.next(0, cur)) return;
    f32x4 acc[2][2][4][2];
#pragma unroll
    for (int a = 0; a < 2; ++a)
#pragma unroll
        for (int b = 0; b < 2; ++b)
#pragma unroll
            for (int m = 0; m < 4; ++m)
#pragma unroll
                for (int n = 0; n < 2; ++n) acc[a][b][m][n] = (f32x4){0.f, 0.f, 0.f, 0.f};
    bf16x8 At[4][2], B0[2][2], B1[2][2];
    const char* cA = cur.A; const char* cB = cur.B; long chA = cur.hA;
    PG8_STAGE(PG8_SB(0, 0), cB, voffB); PG8_STAGE(PG8_SB(0, 1), cB + hstepB, voffB); PG8_STAGE(PG8_SA(0, 0), cA, voffA); PG8_STAGE(PG8_SA(0, 1), cA + chA, voffA);
    if (wr == 1) PG8_BAR;
    PG8_WAIT_V(2); PG8_BAR;
    PG8_STAGE(PG8_SB(1, 0), cB + kstep, voffB); PG8_STAGE(PG8_SA(1, 0), cA + kstep, voffA); PG8_STAGE(PG8_SB(1, 1), cB + hstepB + kstep, voffB);
    PG8_WAIT_V(6); PG8_BAR;
    for (;;) {
        const bool has_next = S.next(ui + 1, nxt);
        const char* nA = has_next ? nxt.A : cA; const char* nB = has_next ? nxt.B : cB; const long nhA = has_next ? nxt.hA : chA;
        for (int t = 0; t < nt; t += 2) {
            const bool last = (t == nt - 2);
            const char* a1 = cA + (size_t)(t + 1) * kstep;
            const char* a2 = last ? nA : cA + (size_t)(t + 2) * kstep; const char* b2 = last ? nB : cB + (size_t)(t + 2) * kstep;
            const char* a3 = a2 + kstep; const char* b3 = b2 + kstep; const long h2 = last ? nhA : chA;
            PG8_LDB(B0, 0, 0); PG8_LDB(B1, 0, 1); PG8_SCHED; PG8_LDA(At, 0, 0); PG8_STAGE(PG8_SA(1, 1), a1 + chA, voffA);
            PG8_WAIT_V(8); PG8_WAIT_L(0); PG8_BAR; PG8_MMA(0, 0, At, B0); PG8_MMA(0, 1, At, B1); PG8_BAR; PG8_SCHED;
            PG8_LDA(At, 0, 1); PG8_STAGE(PG8_SB(0, 0), b2, voffB); PG8_STAGE(PG8_SB(0, 1), b2 + hstepB, voffB); PG8_STAGE(PG8_SA(0, 0), a2, voffA);
            PG8_WAIT_V(8); PG8_WAIT_L(0); PG8_BAR; PG8_MMA(1, 0, At, B0); PG8_MMA(1, 1, At, B1); PG8_BAR; PG8_SCHED;
            PG8_LDB(B0, 1, 0); PG8_LDB(B1, 1, 1); PG8_SCHED; PG8_LDA(At, 1, 0); PG8_STAGE(PG8_SA(0, 1), a2 + h2, voffA);
            PG8_WAIT_V(8); PG8_WAIT_L(0); PG8_BAR; PG8_MMA(0, 0, At, B0); PG8_MMA(0, 1, At, B1); PG8_BAR; PG8_SCHED;
            PG8_LDA(At, 1, 1); PG8_STAGE(PG8_SB(1, 0), b3, voffB); PG8_STAGE(PG8_SB(1, 1), b3 + hstepB, voffB); PG8_STAGE(PG8_SA(1, 0), a3, voffA);
            PG8_WAIT_V(8); PG8_WAIT_L(0); PG8_BAR; PG8_MMA(1, 0, At, B0); PG8_MMA(1, 1, At, B1); PG8_BAR; PG8_SCHED;
            if constexpr (Epi::MID) { if (((t + 2) & 7) == 0 && t + 2 < nt) E.mid(acc, cur, (t + 2) >> 3, wr, wc, fr, fq); }
        }
        if (wr == 0) PG8_BAR;
        E(acc, cur, wr, wc, fr, fq);
        if (!has_next) break;
#pragma unroll
        for (int a = 0; a < 2; ++a)
#pragma unroll
            for (int b = 0; b < 2; ++b)
#pragma unroll
                for (int m = 0; m < 4; ++m)
#pragma unroll
                    for (int n = 0; n < 2; ++n) acc[a][b][m][n] = (f32x4){0.f, 0.f, 0.f, 0.f};
        cur = nxt; cA = nA; cB = nB; chA = nhA; ++ui;
        if (wr == 1) PG8_BAR;
    }
    PG8_WAIT_V(0);
    PG8_BAR;
#undef PG8_SA
#undef PG8_SB
#undef PG8_STAGE
#undef PG8_LDA
#undef PG8_LDB
#undef PG8_MMA
#undef PG8_WAIT_V
#undef PG8_WAIT_L
#undef PG8_BAR
#undef PG8_SCHED
}

struct SchedMN {
    const char* A; const char* B; int lda, ldb, nM, nN, G, c, ocol_off, lim, split, L0, nsplit, khalf_bytes;
    __device__ __forceinline__ bool next(int i, Unit& u) const {
        int L, kh = 0, aux = 0;
        if (!split) { L = i * G + c; if (c < 0 || L >= lim) return false; }
        else { if (i > 0 || c >= 2 * nsplit) return false; const int j = c >> 1; kh = c & 1; L = L0 + j; aux = (j << 2) | 2 | kh; }
        int pm, pn; tile_map(L, nM, nN, pm, pn);
        const long h = (long)128 * lda * 2;
        u.A = A + (size_t)pm * 256 * lda * 2 + (size_t)kh * khalf_bytes + (kh ? h : 0); u.B = B + (size_t)pn * 256 * ldb * 2 + (size_t)kh * khalf_bytes;
        u.hA = kh ? -h : h;
        u.orow0 = pm * 256 + (kh ? 128 : 0); u.orow1 = pm * 256 + (kh ? 0 : 128); u.ocol = pn * 256 + ocol_off; u.aux = aux; return true;
    }
};
struct SchedBR {
    const char* A; const char* B; int G, c;
    __device__ __forceinline__ bool next(int i, Unit& u) const {
#ifdef EXP_B3
        const int L = i * G + c; if (L >= 48 * 8) return false;
        const int b = 3; int pm, pn; tile_map(L, 48, 8, pm, pn);
#else
        const int L = (i >> 2) * G + c; if (L >= 48 * 8) return false;
        const int b = i & 3; int pm, pn; tile_map(L, 48, 8, pm, pn);
#endif
        u.A = A + (size_t)pm * 256 * 2048 * 2 + b * 1024; u.B = B + (size_t)pn * 256 * 2048 * 2 + b * 1024; u.hA = (long)128 * 2048 * 2; u.orow0 = pm * 256; u.orow1 = pm * 256 + 128; u.ocol = pn * 256; u.aux = b; return true;
    }
};
struct SchedFold {
    const char* A0; const char* B0; int mode, c;
    __device__ __forceinline__ bool next(int i, Unit& u) const {
        if (i > 0 || c < 0) return false;
        if (mode == 0) { if (c >= 64) return false; const int l = c >> 5, g = (c >> 3) & 3, pn = c & 7;
            u.A = A0; u.hA = (long)128 * 256 * 2; u.B = B0 + ((size_t)(l * 4 + g) * 2048 + pn * 256) * 128 * 2; u.orow0 = l * 12288 + 2560 + g * 128; u.orow1 = l * 12288 + 3072 + g * 128; u.ocol = pn * 256; u.aux = g; }
        else { if (c >= 32) return false; const int l = c >> 4, pm = (c & 15) >> 1, pn = c & 1;
            u.A = A0 + ((size_t)l * 2048 + pm * 256) * 512 * 2; u.hA = (long)128 * 512 * 2; u.B = B0 + ((size_t)l * 512 + pn * 256) * 512 * 2; u.orow0 = l * 2048 + pm * 256; u.orow1 = u.orow0 + 128; u.ocol = 1536 + pn * 256; u.aux = 0; }
        return true;
    }
};
struct SchedDFT {
    const char* Amat; const char* TT; int latent, c;
    __device__ __forceinline__ bool next(int i, Unit& u) const {
        if (i > 0 || c < 0) return false;
        if (latent) { if (c >= 64) return false; const int bb = c >> 3, pm = (c & 7) >> 1, pn = c & 1;
            u.A = Amat + (size_t)pm * 256 * 2048 * 2; u.hA = (long)128 * 2048 * 2; u.B = TT + ((size_t)bb * 512 + pn * 256) * 2048 * 2; u.orow0 = NCTXT + bb * 1024 + pm * 256; u.orow1 = u.orow0 + 128; u.ocol = 1024 + pn * 256; }
        else { if (c >= 32) return false; const int bb = c >> 1, pn = c & 1;
            u.A = Amat; u.hA = (long)128 * 512 * 2; u.B = TT + ((size_t)bb * 512 + pn * 256) * 512 * 2; u.orow0 = bb * 256; u.orow1 = u.orow0 + 128; u.ocol = 1024 + pn * 256; }
        u.aux = 0; return true;
    }
};

__device__ __forceinline__ u32x4 pack8(const f32x4 v0, const f32x4 v1) { u32x4 w; w.x = cvt_pk_bf16(v0[0], v0[1]); w.y = cvt_pk_bf16(v0[2], v0[3]); w.z = cvt_pk_bf16(v1[0], v1[1]); w.w = cvt_pk_bf16(v1[2], v1[3]); return w; }
struct EpiStore {
    static constexpr bool MID = false;
    bf16_t* O; int ldc;
    __device__ __forceinline__ void operator()(const f32x4 (&acc)[2][2][4][2], const Unit& u, int wr, int wc, int fr, int fq) const {
        asm volatile("" : "+v"(fr), "+v"(fq));
#pragma unroll
        for (int ai = 0; ai < 2; ++ai)
#pragma unroll
            for (int m = 0; m < 4; ++m) { bf16_t* rowp = O + (size_t)((ai ? u.orow1 : u.orow0) + wr * 64 + m * 16 + fr) * ldc + u.ocol + wc * 32 + 8 * fq;
#pragma unroll
                for (int bj = 0; bj < 2; ++bj) *(u32x4*)(rowp + bj * 128) = pack8(acc[ai][bj][m][0], acc[ai][bj][m][1]); }
    }
};
struct EpiZ {
    static constexpr bool MID = false;
    bf16_t* Zm; bf16_t* Zg; const float* bgate;
    __device__ __forceinline__ void operator()(const f32x4 (&acc)[2][2][4][2], const Unit& u, int wr, int wc, int fr, int fq) const {
        asm volatile("" : "+v"(fr), "+v"(fq));
        const int pn = u.ocol >> 8; const int cb = wc * 32 + 8 * fq;
        if (pn >= 16) {
            const int col0 = u.ocol - 4096 + cb;
            f32x4 bv[2][2];
#pragma unroll
            for (int bj = 0; bj < 2; ++bj)
#pragma unroll
                for (int n = 0; n < 2; ++n) bv[bj][n] = *(const f32x4*)(bgate + col0 + bj * 128 + 4 * n);
#pragma unroll
            for (int ai = 0; ai < 2; ++ai)
#pragma unroll
                for (int m = 0; m < 4; ++m) { bf16_t* rowp = Zg + (size_t)((ai ? u.orow1 : u.orow0) + wr * 64 + m * 16 + fr) * 8192 + col0;
#pragma unroll
                    for (int bj = 0; bj < 2; ++bj) { f32x4 v0 = acc[ai][bj][m][0] + bv[bj][0], v1 = acc[ai][bj][m][1] + bv[bj][1];
#pragma unroll
                        for (int e = 0; e < 4; ++e) { v0[e] = sigmoidf_(v0[e]); v1[e] = sigmoidf_(v1[e]); }
                        *(u32x4*)(rowp + bj * 128) = pack8(v0, v1); } }
        } else {
            const bool gel = (pn >= 6 && pn < 10);
#pragma unroll
            for (int ai = 0; ai < 2; ++ai)
#pragma unroll
                for (int m = 0; m < 4; ++m) { bf16_t* rowp = Zm + (size_t)((ai ? u.orow1 : u.orow0) + wr * 64 + m * 16 + fr) * 4096 + u.ocol + cb;
#pragma unroll
                    for (int bj = 0; bj < 2; ++bj) { f32x4 v0 = acc[ai][bj][m][0], v1 = acc[ai][bj][m][1];
                        if (gel) {
#pragma unroll
                            for (int e = 0; e < 4; ++e) { v0[e] = gelu_tanh(v0[e]); v1[e] = gelu_tanh(v1[e]); } }
                        *(u32x4*)(rowp + bj * 128) = pack8(v0, v1); } }
        }
    }
};
struct EpiHid {
    static constexpr bool MID = false;
    bf16_t* O;
    __device__ __forceinline__ void operator()(const f32x4 (&acc)[2][2][4][2], const Unit& u, int wr, int wc, int fr, int fq) const {
        asm volatile("" : "+v"(fr), "+v"(fq));
#pragma unroll
        for (int ai = 0; ai < 2; ++ai)
#pragma unroll
            for (int m = 0; m < 4; ++m) { bf16_t* rowp = O + (size_t)((ai ? u.orow1 : u.orow0) + wr * 64 + m * 16 + fr) * DFF + u.ocol + wc * 32 + 8 * fq;
#pragma unroll
                for (int bj = 0; bj < 2; ++bj) { f32x4 v0 = acc[ai][bj][m][0], v1 = acc[ai][bj][m][1];
#pragma unroll
                    for (int e = 0; e < 4; ++e) { const float a = fmaxf(v0[e], 0.f), b = fmaxf(v1[e], 0.f); v0[e] = a * a; v1[e] = b * b; }
                    *(u32x4*)(rowp + bj * 128) = pack8(v0, v1); } }
    }
};
__device__ __forceinline__ void ho_send(const f32x4 (&acc)[2][2][4][2], unsigned long long* sb, unsigned* flag, int tidp) {
#pragma unroll
    for (int m = 0; m < 4; ++m)
#pragma unroll
        for (int bj = 0; bj < 2; ++bj)
#pragma unroll
            for (int n = 0; n < 2; ++n) { const f32x4 v = acc[1][bj][m][n]; unsigned long long* p = sb + (size_t)(((m * 2 + bj) * 2 + n) * 1024);
                __hip_atomic_store(p, ((unsigned long long)__float_as_uint(v[1]) << 32) | __float_as_uint(v[0]), __ATOMIC_RELAXED, __HIP_MEMORY_SCOPE_AGENT);
                __hip_atomic_store(p + 1, ((unsigned long long)__float_as_uint(v[3]) << 32) | __float_as_uint(v[2]), __ATOMIC_RELAXED, __HIP_MEMORY_SCOPE_AGENT); }
    asm volatile("s_waitcnt vmcnt(0)" ::: "memory");
    __syncthreads();
    if (tidp == 0) __hip_atomic_store(flag, 1u, __ATOMIC_RELEASE, __HIP_MEMORY_SCOPE_AGENT);
}
__device__ __forceinline__ void ho_wait(unsigned* flag, int tidp) {
    if (tidp == 0) { unsigned spin = 0; while (__hip_atomic_load(flag, __ATOMIC_ACQUIRE, __HIP_MEMORY_SCOPE_AGENT) == 0u) { __builtin_amdgcn_s_sleep(2); if (++spin > (1u << 24)) break; } }
    __syncthreads();
}
__device__ __forceinline__ f32x4 ho_get(unsigned long long* sb, int m, int bj, int n) {
    unsigned long long* p = sb + (size_t)(((m * 2 + bj) * 2 + n) * 1024);
    const unsigned long long a0 = __hip_atomic_load(p, __ATOMIC_RELAXED, __HIP_MEMORY_SCOPE_AGENT), a1 = __hip_atomic_load(p + 1, __ATOMIC_RELAXED, __HIP_MEMORY_SCOPE_AGENT);
    return (f32x4){__uint_as_float((unsigned)a0), __uint_as_float((unsigned)(a0 >> 32)), __uint_as_float((unsigned)a1), __uint_as_float((unsigned)(a1 >> 32))};
}
struct EpiRes {
    static constexpr bool MID = false;
    const float* xp; const float* xs; float* out; const float* mod; int gsel;
    float* S; unsigned* flags;
    __device__ __forceinline__ void operator()(const f32x4 (&acc)[2][2][4][2], const Unit& u, int wr, int wc, int fr, int fq) const {
        asm volatile("" : "+v"(fr), "+v"(fq));
        const int sp = u.aux & 2, jt = u.aux >> 2;
        const int tidp = (wr * 4 + wc) * 64 + fq * 16 + fr;
        const int kh = u.aux & 1;
        unsigned long long* sbs = (unsigned long long*)(S + (size_t)jt * 65536 + kh * 32768) + (size_t)tidp * 2;
        unsigned long long* sb = (unsigned long long*)(S + (size_t)jt * 65536 + (1 - kh) * 32768) + (size_t)tidp * 2;
        if (sp) { ho_send(acc, sbs, flags + jt * 16 + kh * 8, tidp); ho_wait(flags + jt * 16 + (1 - kh) * 8, tidp); }
        const int pm = u.orow0 >> 8; const int cond = pm < 16 ? 0 : 1 + ((pm - 16) >> 2);
        const int col0 = u.ocol + wc * 32 + 8 * fq;
        const float* gp = mod + ((size_t)cond * 6 + gsel) * 2048 + col0;
        f32x4 gv[2][2];
#pragma unroll
        for (int bj = 0; bj < 2; ++bj)
#pragma unroll
            for (int n = 0; n < 2; ++n) gv[bj][n] = *(const f32x4*)(gp + bj * 128 + 4 * n);
        const float* src = pm < 16 ? xp : xs - (size_t)NCTXT * DM;
#pragma unroll
        for (int ai = 0; ai < 2; ++ai) {
            if (ai == 1 && sp) break;
#pragma unroll
            for (int m = 0; m < 4; ++m) {
                f32x4 xv[2][2], pv[2][2]; const size_t off = (size_t)((ai ? u.orow1 : u.orow0) + wr * 64 + m * 16 + fr) * DM + col0;
#pragma unroll
                for (int bj = 0; bj < 2; ++bj)
#pragma unroll
                    for (int n = 0; n < 2; ++n) { xv[bj][n] = *(const f32x4*)(src + off + bj * 128 + 4 * n); if (ai == 0 && sp) pv[bj][n] = ho_get(sb, m, bj, n); }
#pragma unroll
                for (int bj = 0; bj < 2; ++bj)
#pragma unroll
                    for (int n = 0; n < 2; ++n) { f32x4 v = acc[ai][bj][m][n]; if (ai == 0 && sp) v += pv[bj][n];
                        *(f32x4*)(out + off + bj * 128 + 4 * n) = xv[bj][n] + gv[bj][n] * v; }
                asm volatile("" ::: "memory"); } }
    }
};
struct EpiBR {
    static constexpr bool MID = true;
    const bf16_t* Zg; bf16_t* merged; float* S; unsigned* flags;
    __device__ __forceinline__ void scale(f32x4 (&acc)[2][2][4][2], const Unit& u, int b, bool ratio, int wr, int wc, int fr, int fq) const {
        const int col0 = u.ocol + wc * 32 + 8 * fq;
#pragma unroll
        for (int ai = 0; ai < 2; ++ai) {
            u32x4 gw[4][2], nw[4][2];
#pragma unroll
            for (int m = 0; m < 4; ++m)
#pragma unroll
                for (int bj = 0; bj < 2; ++bj) { const bf16_t* gp = Zg + (size_t)((ai ? u.orow1 : u.orow0) + wr * 64 + m * 16 + fr) * 8192 + b * 2048 + col0 + bj * 128;
                    gw[m][bj] = *(const u32x4*)gp; if (ratio) nw[m][bj] = *(const u32x4*)(gp + 2048); }
#pragma unroll
            for (int m = 0; m < 4; ++m)
#pragma unroll
                for (int bj = 0; bj < 2; ++bj) { const u32x4 g4 = gw[m][bj];
                    float g[8] = {bflo(g4.x), bfhi(g4.x), bflo(g4.y), bfhi(g4.y), bflo(g4.z), bfhi(g4.z), bflo(g4.w), bfhi(g4.w)};
#pragma unroll
                    for (int e = 0; e < 8; ++e) g[e] = fmaxf(g[e], 1e-6f);
                    if (ratio) { const u32x4 n4 = nw[m][bj];
                        const float gn[8] = {bflo(n4.x), bfhi(n4.x), bflo(n4.y), bfhi(n4.y), bflo(n4.z), bfhi(n4.z), bflo(n4.w), bfhi(n4.w)};
#pragma unroll
                        for (int e = 0; e < 8; ++e) g[e] *= __builtin_amdgcn_rcpf(fmaxf(gn[e], 1e-6f)); }
                    f32x4 v0 = acc[ai][bj][m][0], v1 = acc[ai][bj][m][1];
                    v0[0] *= g[0]; v0[1] *= g[1]; v0[2] *= g[2]; v0[3] *= g[3]; v1[0] *= g[4]; v1[1] *= g[5]; v1[2] *= g[6]; v1[3] *= g[7];
                    acc[ai][bj][m][0] = v0; acc[ai][bj][m][1] = v1; }
            asm volatile("" ::: "memory"); }
    }
    __device__ __forceinline__ void mid(f32x4 (&acc)[2][2][4][2], const Unit& u, int seg, int wr, int wc, int fr, int fq) const {
        asm volatile("" : "+v"(fr), "+v"(fq));
        const int base = (u.aux & 2) ? (u.aux & 1) * 2 : 0;
        scale(acc, u, base + seg - 1, true, wr, wc, fr, fq);
    }
    __device__ __forceinline__ void operator()(f32x4 (&acc)[2][2][4][2], const Unit& u, int wr, int wc, int fr, int fq) const {
        asm volatile("" : "+v"(fr), "+v"(fq));
        const int sp = u.aux & 2, kh = u.aux & 1, jt = u.aux >> 2;
        const int tidp = (wr * 4 + wc) * 64 + fq * 16 + fr;
        unsigned long long* sbs = (unsigned long long*)(S + (size_t)jt * 65536 + kh * 32768) + (size_t)tidp * 2;
        unsigned long long* sb = (unsigned long long*)(S + (size_t)jt * 65536 + (1 - kh) * 32768) + (size_t)tidp * 2;
        scale(acc, u, sp ? kh * 2 + 1 : 3, false, wr, wc, fr, fq);
        if (sp) { ho_send(acc, sbs, flags + jt * 16 + kh * 8, tidp); ho_wait(flags + jt * 16 + (1 - kh) * 8, tidp); }
        const int col0 = u.ocol + wc * 32 + 8 * fq;
        if (sp) {
            f32x4 pv[4][2][2];
#pragma unroll
            for (int m = 0; m < 4; ++m)
#pragma unroll
                for (int bj = 0; bj < 2; ++bj) { pv[m][bj][0] = ho_get(sb, m, bj, 0); pv[m][bj][1] = ho_get(sb, m, bj, 1); }
#pragma unroll
            for (int m = 0; m < 4; ++m) { const size_t row = (size_t)(u.orow0 + wr * 64 + m * 16 + fr);
#pragma unroll
                for (int bj = 0; bj < 2; ++bj) *(u32x4*)(merged + row * DM + col0 + bj * 128) = pack8(acc[0][bj][m][0] + pv[m][bj][0], acc[0][bj][m][1] + pv[m][bj][1]); }
        } else {
#pragma unroll
            for (int ai = 0; ai < 2; ++ai)
#pragma unroll
                for (int m = 0; m < 4; ++m) { const size_t row = (size_t)((ai ? u.orow1 : u.orow0) + wr * 64 + m * 16 + fr);
#pragma unroll
                    for (int bj = 0; bj < 2; ++bj) *(u32x4*)(merged + row * DM + col0 + bj * 128) = pack8(acc[ai][bj][m][0], acc[ai][bj][m][1]); }
        }
    }
};
}

__device__ __forceinline__ void transpose_item(const float* W, int N, int k0, int n0, bf16_t* D, int ldo, int dn0, int dk0, LAS float* scr, int lane, bool gran = false) {
#pragma unroll 8
    for (int i = 0; i < 32; ++i) { const int kk = 2 * i + (lane >> 5); scr[kk * 33 + (lane & 31)] = W[(size_t)(k0 + kk) * N + n0 + (lane & 31)]; }
    LDS_WAIT(); asm volatile("" ::: "memory");
    const int c = lane & 7;
#pragma unroll
    for (int j = 0; j < 4; ++j) { const int n = (lane >> 3) + 8 * j; const LAS float* s = scr + (8 * c) * 33 + n;
        u32x4 o; o.x = cvt_pk_bf16(s[0 * 33], s[1 * 33]); o.y = cvt_pk_bf16(s[2 * 33], s[3 * 33]); o.z = cvt_pk_bf16(s[4 * 33], s[5 * 33]); o.w = cvt_pk_bf16(s[6 * 33], s[7 * 33]);
        if (gran) *(u32x4*)(D + ((size_t)((dk0 + 8 * c) >> 3) * 64 + (dn0 + n)) * 8) = o;
        else *(u32x4*)(D + (size_t)(dn0 + n) * ldo + dk0 + 8 * c) = o; }
    LDS_WAIT(); asm volatile("" ::: "memory");
}

__device__ __forceinline__ void phase_p0(const Args& a, LAS unsigned char* lds, int tid, int lane, int wave, int G, int bid) {
    unsigned char* ws = a.ws;
    LAS float* scr = (LAS float*)(lds + wave * 16384);
    const int gw = bid * 8 + wave, NGW = G * 8;
    if (bid == 0 && tid < 16) ((unsigned*)(ws + O_CTL))[64 * tid] = 0u;
    if (bid == 0 && tid < 32) ((unsigned*)(ws + O_CTL))[1024 + 64 * tid] = 0u;
    constexpr int IT_WIN = 32 * 368, IT_WBR = 32 * 64, IT_WOUT = 32 * 64, IT_W1 = 32 * 256, IT_W2 = 128 * 64, IT_L = IT_WIN + IT_WBR + IT_WOUT + IT_W1 + IT_W2;
    constexpr int IT_CV = 128 * 16;
    for (int it = gw; it < 2 * IT_L + IT_CV; it += NGW) {
        if (it >= 2 * IT_L) {
            const int r = it - 2 * IT_L, mtx = r >> 4, kb = (r >> 1) & 7, nb = r & 1;
            transpose_item(a.in[I_CV] + (size_t)mtx * 512 * 64, 64, kb * 64, nb * 32, (bf16_t*)(ws + O_VTC) + (size_t)mtx * 64 * 512, 512, nb * 32, kb * 64, scr, lane, true);
            continue;
        }
        const int l = it / IT_L; int r = it % IT_L;
        if (r < IT_WIN) {
            const int kb = r / 368, nb = r % 368, k0 = kb * 64, n0 = nb * 32;
            const float* W = a.in[I_WIN] + (size_t)l * DM * INC;
            if (n0 >= 2560 && n0 < 3072) {
                const int g = (n0 - 2560) >> 7, c0 = (n0 - 2560) & 127;
                bf16_t* D = (bf16_t*)(ws + O_WFN) + ((size_t)(l * 4 + g) * 2048) * 128;
#pragma unroll 8
                for (int i = 0; i < 32; ++i) { const int kk = 2 * i + (lane >> 5); D[(size_t)(k0 + kk) * 128 + c0 + (lane & 31)] = f2bf(W[(size_t)(k0 + kk) * INC + n0 + (lane & 31)]); }
            } else {
                const int dn0 = n0 < 2560 ? n0 : n0 + 512;
                transpose_item(W, INC, k0, n0, (bf16_t*)(ws + O_WINT) + (size_t)l * 12288 * 2048, 2048, dn0, k0, scr, lane);
            }
            continue;
        } r -= IT_WIN;
        if (r < IT_WBR) {
            const int kb = r / 64, nb = r % 64, k0 = kb * 64, n0 = nb * 32;
            const float* W = a.in[I_WBR] + (size_t)l * DM * DM;
            if (k0 < 1536) transpose_item(W, DM, k0, n0, (bf16_t*)(ws + O_WBT) + (size_t)l * DM * DM, 2048, n0, k0, scr, lane);
            else transpose_item(W, DM, k0, n0, (bf16_t*)(ws + O_WBD) + (size_t)l * DM * 512, 512, n0, k0 - 1536, scr, lane);
            continue;
        } r -= IT_WBR;
        if (r < IT_WOUT) { const int kb = r / 64, nb = r % 64; transpose_item(a.in[I_WOUT] + (size_t)l * DM * DM, DM, kb * 64, nb * 32, (bf16_t*)(ws + O_WOT) + (size_t)l * DM * DM, 2048, nb * 32, kb * 64, scr, lane); continue; } r -= IT_WOUT;
        if (r < IT_W1) { const int kb = r / 256, nb = r % 256; transpose_item(a.in[I_W1] + (size_t)l * DM * DFF, DFF, kb * 64, nb * 32, (bf16_t*)(ws + O_W1T) + (size_t)l * DFF * DM, 2048, nb * 32, kb * 64, scr, lane); continue; } r -= IT_W1;
        { const int kb = r / 64, nb = r % 64; transpose_item(a.in[I_W2] + (size_t)l * DFF * DM, DM, kb * 64, nb * 32, (bf16_t*)(ws + O_W2T) + (size_t)l * DM * DFF, 8192, nb * 32, kb * 64, scr, lane); }
    }
    const int gt = bid * 512 + tid, NGT = G * 512;
    for (int i = gt; i < 2 * 512 * 512; i += NGT) {
        const int l = i >> 18, c = (i >> 9) & 511, d = i & 511; float v = 0.f;
        if ((c >> 7) == (d >> 7)) v = a.in[I_WPOOL][(((size_t)l * 4 + (c >> 7)) * 128 + (c & 127)) * 128 + (d & 127)] * a.in[I_PSC][l * 512 + d];
        ((bf16_t*)(ws + O_BDP))[i] = f2bf(v);
    }
    for (int i = gt; i < 256 * 256; i += NGT) {
        const int r = i >> 8, c = i & 255, cp = r & 127; const float t = (float)((cp * c) & 127) * (2.0f / 128.0f);
        ((bf16_t*)(ws + O_CS))[i] = f2bf(c < 128 ? (r < 128 ? cospif(t) : sinpif(t)) * 0.08838834764831845f : 0.f);
    }
    for (int i = gt; i < 256 * 512; i += NGT) {
        const int k = i >> 9, c = i & 511, n = c & 255; const float t = (float)((k * n) & 255) * (2.0f / 256.0f);
        ((bf16_t*)(ws + O_DFT256))[i] = f2bf((c < 256 ? cospif(t) : -sinpif(t)) * 0.0625f);
    }
    for (int i = gt; i < 1024 * 2048; i += NGT) {
        const int k = i >> 11, c = i & 2047, n = c & 1023; const float t = (float)((k * n) & 1023) * (2.0f / 1024.0f);
        ((bf16_t*)(ws + O_DFT1024))[i] = f2bf((c < 1024 ? cospif(t) : -sinpif(t)) * 0.03125f);
    }
    for (int i = gt; i < 2 * 4 * 128 * 128; i += NGT) ((bf16_t*)(ws + O_WSB))[i] = f2bf(a.in[I_WSP][i]);
    for (int i = gt; i < 8 * 2 * 8 * 512 * 64 / 4; i += NGT) { const f32x4 v = ((const f32x4*)a.in[I_CK])[i]; u32x2 w; w.x = cvt_pk_bf16(v[0], v[1]); w.y = cvt_pk_bf16(v[2], v[3]); ((u32x2*)(ws + O_CK))[i] = w; }
    __syncthreads();
    for (int it = gw; it < 2 * 16 * 48; it += NGW) {
        const int l = it / 768, rem = it % 768, dch = rem / 48, cb = rem % 48, j0 = cb * 256 + lane * 4, d0 = dch * 128;
        for (int i = lane; i < NCOND * 128; i += 64) { const int cond = i >> 7, d = i & 127; const float x = cond == 0 ? a.in[I_CCTX][d0 + d] : a.in[I_C][(size_t)(cond - 1) * DM + d0 + d]; scr[i] = x * sigmoidf_(x); }
        LDS_WAIT(); asm volatile("" ::: "memory");
        f32x4 acc[NCOND];
#pragma unroll
        for (int c = 0; c < NCOND; ++c) acc[c] = (f32x4){0.f, 0.f, 0.f, 0.f};
        const float* wp = a.in[I_WADA] + ((size_t)l * DM + d0) * 12288 + j0;
#pragma unroll 1
        for (int d0b = 0; d0b < 128; d0b += 16) {
            f32x4 w[16];
#pragma unroll
            for (int u = 0; u < 16; ++u) w[u] = *(const f32x4*)(wp + (size_t)(d0b + u) * 12288);
#pragma unroll
            for (int u = 0; u < 16; ++u)
#pragma unroll
                for (int c = 0; c < NCOND; ++c) acc[c] += w[u] * scr[c * 128 + d0b + u]; }
#pragma unroll
        for (int c = 0; c < NCOND; ++c) *(f32x4*)((float*)(ws + O_MODP) + ((size_t)(dch * 2 + l) * NCOND + c) * 12288 + j0) = acc[c];
        LDS_WAIT(); asm volatile("" ::: "memory");
    }
}

__device__ __forceinline__ void phase_p1_modreduce(const Args& a, int tid, int G, int bid) {
    const int gt = bid * 512 + tid, NGT = G * 512;
    const float* P = (const float*)(a.ws + O_MODP); float* M = (float*)(a.ws + O_MOD);
    for (int i = gt; i < 2 * NCOND * 2048; i += NGT) {
        const int l = i / (NCOND * 2048), cond = (i / 2048) % NCOND, col = i & 2047;
        float m[6];
#pragma unroll
        for (int s = 0; s < 6; ++s) { float v = a.in[I_BADA][l * 12288 + s * 2048 + col]; float pp[16];
#pragma unroll
            for (int dch = 0; dch < 16; ++dch) pp[dch] = P[((size_t)(dch * 2 + l) * NCOND + cond) * 12288 + s * 2048 + col];
#pragma unroll
            for (int dch = 0; dch < 16; ++dch) v += pp[dch];
            m[s] = v; }
        float* o = M + ((size_t)(l * NCOND + cond) * 6) * 2048 + col;
        o[0] = a.in[I_N1G][l * 2048 + col] * (1.f + m[1]); o[2048] = m[0]; o[2 * 2048] = m[2];
        o[3 * 2048] = a.in[I_N2G][l * 2048 + col] * (1.f + m[4]); o[4 * 2048] = m[3]; o[5 * 2048] = m[5];
    }
}

__device__ __forceinline__ void phase_norm(const Args& a, int l, int which, bool from_input, int lane, int wave, int G, int bid) {
    const int gw = bid * 8 + wave, NGW = G * 8;
    bf16_t* H = (bf16_t*)(a.ws + O_H);
    const int chunk = (NTOK + NGW - 1) / NGW;
    int row = gw * chunk; const int rend = (row + chunk) < NTOK ? (row + chunk) : NTOK;
    if (row >= rend) return;
#define NORM_XPTR(r) (from_input ? ((r) < NCTXT ? a.in[I_XP] + (size_t)(r) * DM : a.in[I_XS] + (size_t)((r) - NCTXT) * DM) : a.out + (size_t)(r) * DM)
    f32x4 v[8], vn[8], av[8], sv[8]; int ccond = -1;
    { const float* xr = NORM_XPTR(row);
#pragma unroll
      for (int j = 0; j < 8; ++j) v[j] = *(const f32x4*)(xr + j * 256 + lane * 4); }
    if (row + 1 < rend) { const float* xr = NORM_XPTR(row + 1);
#pragma unroll
      for (int j = 0; j < 8; ++j) vn[j] = *(const f32x4*)(xr + j * 256 + lane * 4); }
    for (; row < rend; ++row) {
        f32x4 vnn[8];
        if (row + 2 < rend) { const float* xr = NORM_XPTR(row + 2);
#pragma unroll
            for (int j = 0; j < 8; ++j) vnn[j] = *(const f32x4*)(xr + j * 256 + lane * 4); }
        const int cond = row < NCTXT ? 0 : 1 + ((row - NCTXT) >> 10);
        if (cond != ccond) { ccond = cond; const float* ap = (const float*)(a.ws + O_MOD) + ((size_t)(l * NCOND + cond) * 6 + which) * 2048;
#pragma unroll
            for (int j = 0; j < 8; ++j) { av[j] = *(const f32x4*)(ap + j * 256 + lane * 4); sv[j] = *(const f32x4*)(ap + 2048 + j * 256 + lane * 4); } }
        float s = 0.f;
#pragma unroll
        for (int j = 0; j < 8; ++j) s += (v[j][0] * v[j][0] + v[j][1] * v[j][1]) + (v[j][2] * v[j][2] + v[j][3] * v[j][3]);
        const float r = rsqrtf(wave_sum(s) * (1.0f / DM) + 1e-6f);
#pragma unroll
        for (int j = 0; j < 8; ++j) { const f32x4 o = v[j] * r * av[j] + sv[j]; u32x2 w; w.x = cvt_pk_bf16(o[0], o[1]); w.y = cvt_pk_bf16(o[2], o[3]);
            *(u32x2*)(H + (size_t)row * DM + j * 256 + lane * 4) = w; }
#pragma unroll
        for (int j = 0; j < 8; ++j) { v[j] = vn[j]; vn[j] = vnn[j]; }
    }
#undef NORM_XPTR
}

template <bool SCALE, bool GRAN = false>
__device__ __forceinline__ void transpose128(const bf16_t* src, int ld_src, bf16_t* dst, int ld_dst, LAS unsigned char* lds, int tid, const LAS float* rtab, const float* gvec) {
    LAS bf16_t* T = (LAS bf16_t*)lds;
    u32x4 vv[4];
#pragma unroll
    for (int j = 0; j < 4; ++j) { const int ch = tid + j * 512, row = ch >> 4, cc = ch & 15; vv[j] = *(const u32x4*)(src + (size_t)row * ld_src + cc * 8); }
    f32x4 g0 = {0.f, 0.f, 0.f, 0.f}, g1 = {0.f, 0.f, 0.f, 0.f};
    if (SCALE) { const int cc = tid & 15; g0 = *(const f32x4*)(gvec + cc * 8); g1 = *(const f32x4*)(gvec + cc * 8 + 4); }
#pragma unroll
    for (int j = 0; j < 4; ++j) { const int ch = tid + j * 512, row = ch >> 4, cc = ch & 15;
        u32x4 v = vv[j];
        if (SCALE) { const float r = rtab[row];
            v.x = cvt_pk_bf16(bflo(v.x) * r * g0[0], bfhi(v.x) * r * g0[1]); v.y = cvt_pk_bf16(bflo(v.y) * r * g0[2], bfhi(v.y) * r * g0[3]);
            v.z = cvt_pk_bf16(bflo(v.z) * r * g1[0], bfhi(v.z) * r * g1[1]); v.w = cvt_pk_bf16(bflo(v.w) * r * g1[2], bfhi(v.w) * r * g1[3]); }
        *(LAS u32x4*)(T + row * 136 + cc * 8) = v; }
    __syncthreads();
#pragma unroll
    for (int j = 0; j < 4; ++j) { const int ch = tid + j * 512, c = ch & 127, qc = ch >> 7;
        unsigned short e[8];
#pragma unroll
        for (int k = 0; k < 8; ++k) e[k] = T[(qc * 8 + k) * 136 + c];
        u32x4 o; o.x = e[0] | ((unsigned)e[1] << 16); o.y = e[2] | ((unsigned)e[3] << 16); o.z = e[4] | ((unsigned)e[5] << 16); o.w = e[6] | ((unsigned)e[7] << 16);
        if (GRAN) { const int cg = ld_dst + c; *(u32x4*)(dst + ((size_t)(cg >> 6) * 1536 + qc) * 512 + (cg & 63) * 8) = o; }
        else *(u32x4*)(dst + (size_t)c * ld_dst + qc * 8) = o; }
    __syncthreads();
}

template <int W>
__device__ __forceinline__ void pool_rows(const bf16_t* base, bf16_t* outp, int pos0, int npos, int tl0, int tsub) {
#pragma unroll 2
    for (int it = 0; it < 16; ++it) {
        const int tl = tl0 + it * 4 + tsub, pos = pos0 + tl;
        int lo = pos - (W >> 1); if (lo < 0) lo = 0; int hi = pos + (W >> 1) - 1; if (hi > npos - 1) hi = npos - 1;
        u32x4 x[W];
#pragma unroll
        for (int j = 0; j < W; ++j) { int p = pos - (W >> 1) + j; p = p < lo ? lo : (p > hi ? hi : p); x[j] = *(const u32x4*)(base + (size_t)p * 4096); }
        float s[8] = {0.f, 0.f, 0.f, 0.f, 0.f, 0.f, 0.f, 0.f};
#pragma unroll
        for (int j = 0; j < W; ++j) { const int p = pos - (W >> 1) + j; const float wgt = (p >= lo && p <= hi) ? 1.f : 0.f;
            s[0] += wgt * bflo(x[j].x); s[1] += wgt * bfhi(x[j].x); s[2] += wgt * bflo(x[j].y); s[3] += wgt * bfhi(x[j].y);
            s[4] += wgt * bflo(x[j].z); s[5] += wgt * bfhi(x[j].z); s[6] += wgt * bflo(x[j].w); s[7] += wgt * bfhi(x[j].w); }
        const u32x4 xc = x[W >> 1]; const float inv = 1.0f / (float)(hi - lo + 1);
        u32x4 o; o.x = cvt_pk_bf16(s[0] * inv - bflo(xc.x), s[1] * inv - bfhi(xc.x)); o.y = cvt_pk_bf16(s[2] * inv - bflo(xc.y), s[3] * inv - bfhi(xc.y));
        o.z = cvt_pk_bf16(s[4] * inv - bflo(xc.z), s[5] * inv - bfhi(xc.z)); o.w = cvt_pk_bf16(s[6] * inv - bflo(xc.w), s[7] * inv - bfhi(xc.w));
        *(u32x4*)(outp + (size_t)tl * 2048) = o;
    }
}

__device__ __forceinline__ void phase_prep(const Args& a, int l, LAS unsigned char* lds, int tid, int lane, int wave, int G, int bid) {
    unsigned char* ws = a.ws;
    const bf16_t* Zm = (const bf16_t*)(ws + O_ZM);
    unsigned* qctr = (unsigned*)(ws + O_CTL) + 64 * (8 + l);
    LAS int* qslot = (LAS int*)(lds + 131072 + 128);
    for (;;) {
        __syncthreads();
        if (tid == 0) *qslot = (int)atomicAdd(qctr, 1u);
        __syncthreads();
        const int qi = *qslot; if (qi >= 96 * 6) break;
        const int ord = qi / 96, tt = qi % 96; const int task = ord == 0 ? 0 : (ord == 1 ? 5 : ord - 1);
        const bool ctx = tt < 32; const int bb = ctx ? (tt >> 1) : ((tt - 32) >> 3); const int pos0 = ctx ? (tt & 1) * 128 : ((tt - 32) & 7) * 128; const int npos = ctx ? 256 : 1024;
        const int tok0 = tt * 128;
        if (task == 0) {
            const int j = lane & 7, hd = lane >> 3;
            const f32x4 gq0 = *(const f32x4*)(a.in[I_QNG] + l * 64 + j * 8), gq1 = *(const f32x4*)(a.in[I_QNG] + l * 64 + j * 8 + 4);
            const f32x4 gk0 = *(const f32x4*)(a.in[I_KNG] + l * 64 + j * 8), gk1 = *(const f32x4*)(a.in[I_KNG] + l * 64 + j * 8 + 4);
            const int ax = j >> 2; const bool isx2 = (j & 2) != 0; const int i0 = (j & 1) * 8;
            float invf[8];
#pragma unroll
            for (int e = 0; e < 8; ++e) invf[e] = __builtin_amdgcn_exp2f(-(float)(i0 + e) * (13.287712379549449f / 16.0f));
#pragma unroll 1
            for (int tb = 0; tb < 4; ++tb) {
                u32x4 qw4[4], kw4[4];
#pragma unroll
                for (int u = 0; u < 4; ++u) { const int tok = tok0 + wave * 16 + tb * 4 + u; qw4[u] = *(const u32x4*)(Zm + (size_t)tok * 4096 + lane * 8); kw4[u] = *(const u32x4*)(Zm + (size_t)tok * 4096 + 512 + lane * 8); }
#pragma unroll
                for (int u = 0; u < 4; ++u) {
                    const int tl = wave * 16 + tb * 4 + u, tok = tok0 + tl, pos = pos0 + tl;
                    const u32x4 qw = qw4[u], kw = kw4[u];
                    float q[8] = {bflo(qw.x), bfhi(qw.x), bflo(qw.y), bfhi(qw.y), bflo(qw.z), bfhi(qw.z), bflo(qw.w), bfhi(qw.w)};
                    float k[8] = {bflo(kw.x), bfhi(kw.x), bflo(kw.y), bfhi(kw.y), bflo(kw.z), bfhi(kw.z), bflo(kw.w), bfhi(kw.w)};
                    float sq = 0.f, sk = 0.f;
#pragma unroll
                    for (int e = 0; e < 8; ++e) { sq += q[e] * q[e]; sk += k[e] * k[e]; }
                    sq += __shfl_xor(sq, 1); sq += __shfl_xor(sq, 2); sq += __shfl_xor(sq, 4);
                    sk += __shfl_xor(sk, 1); sk += __shfl_xor(sk, 2); sk += __shfl_xor(sk, 4);
                    const float rq = rsqrtf(sq * (1.f / 64.f) + 1e-6f), rk = rsqrtf(sk * (1.f / 64.f) + 1e-6f);
#pragma unroll
                    for (int e = 0; e < 8; ++e) { q[e] *= rq * (e < 4 ? gq0[e & 3] : gq1[e & 3]); k[e] *= rk * (e < 4 ? gk0[e & 3] : gk1[e & 3]); }
                    { u32x4 o; o.x = cvt_pk_bf16(q[0] * 0.125f, q[1] * 0.125f); o.y = cvt_pk_bf16(q[2] * 0.125f, q[3] * 0.125f); o.z = cvt_pk_bf16(q[4] * 0.125f, q[5] * 0.125f); o.w = cvt_pk_bf16(q[6] * 0.125f, q[7] * 0.125f);
                      *(u32x4*)((bf16_t*)(ws + O_QP) + (size_t)tok * 512 + lane * 8) = o; }
                    if (ctx) {
                        u32x4 o; o.x = cvt_pk_bf16(k[0], k[1]); o.y = cvt_pk_bf16(k[2], k[3]); o.z = cvt_pk_bf16(k[4], k[5]); o.w = cvt_pk_bf16(k[6], k[7]);
                        *(u32x4*)((bf16_t*)(ws + O_KB) + ((size_t)hd * 12288 + tok) * 64 + j * 8) = o;
                        float* ok = a.out + OUTK + ((((size_t)bb * 2 + l) * 8 + hd) * 256 + pos) * 64 + j * 8;
                        *(f32x4*)ok = (f32x4){k[0], k[1], k[2], k[3]}; *(f32x4*)(ok + 4) = (f32x4){k[4], k[5], k[6], k[7]};
                    } else {
                        const float p = (float)(ax == 0 ? (pos >> 6) : (pos & 63));
                        float qr[8], kr[8];
#pragma unroll
                        for (int e = 0; e < 8; ++e) {
                            const float ang = p * invf[e]; const float cs = __cosf(ang), sn = __sinf(ang);
                            const float pq = __shfl_xor(q[e], 2), pk = __shfl_xor(k[e], 2);
                            qr[e] = q[e] * cs + (isx2 ? pq : -pq) * sn; kr[e] = k[e] * cs + (isx2 ? pk : -pk) * sn;
                        }
                        u32x4 o; o.x = cvt_pk_bf16(qr[0] * 0.125f, qr[1] * 0.125f); o.y = cvt_pk_bf16(qr[2] * 0.125f, qr[3] * 0.125f); o.z = cvt_pk_bf16(qr[4] * 0.125f, qr[5] * 0.125f); o.w = cvt_pk_bf16(qr[6] * 0.125f, qr[7] * 0.125f);
                        *(u32x4*)((bf16_t*)(ws + O_QR) + (size_t)(tok - NCTXT) * 512 + lane * 8) = o;
                        u32x4 o2; o2.x = cvt_pk_bf16(kr[0], kr[1]); o2.y = cvt_pk_bf16(kr[2], kr[3]); o2.z = cvt_pk_bf16(kr[4], kr[5]); o2.w = cvt_pk_bf16(kr[6], kr[7]);
                        *(u32x4*)((bf16_t*)(ws + O_KB) + ((size_t)hd * 12288 + tok) * 64 + j * 8) = o2;
                    }
                }
            }
        } else if (task == 1) {
            bf16_t* vt = (bf16_t*)(ws + O_VT) + (size_t)(tok0 >> 3) * 512;
            if (ctx) {
                const int j = lane & 7, hd = lane >> 3;
#pragma unroll 1
                for (int tb = 0; tb < 2; ++tb) {
                    u32x4 w8[8];
#pragma unroll
                    for (int u = 0; u < 8; ++u) w8[u] = *(const u32x4*)(Zm + (size_t)(tok0 + wave * 16 + tb * 8 + u) * 4096 + 1024 + lane * 8);
#pragma unroll
                    for (int u = 0; u < 8; ++u) { const int pos = pos0 + wave * 16 + tb * 8 + u; const u32x4 w = w8[u];
                        float* ov = a.out + OUTV + ((((size_t)bb * 2 + l) * 8 + hd) * 256 + pos) * 64 + j * 8;
                        *(f32x4*)ov = (f32x4){bflo(w.x), bfhi(w.x), bflo(w.y), bfhi(w.y)}; *(f32x4*)(ov + 4) = (f32x4){bflo(w.z), bfhi(w.z), bflo(w.w), bfhi(w.w)}; }
                }
            }
            for (int sub = 0; sub < 4; ++sub)
                transpose128<false, true>(Zm + (size_t)tok0 * 4096 + 1024 + sub * 128, 4096, vt, sub * 128, lds, tid, nullptr, nullptr);
        } else if (task == 2) {
            LAS float* rtab = (LAS float*)(lds + 40960);
#pragma unroll 1
            for (int tb = 0; tb < 2; ++tb) {
                u32x4 w8[8];
#pragma unroll
                for (int u = 0; u < 8; ++u) w8[u] = *(const u32x4*)(Zm + (size_t)(tok0 + wave * 16 + tb * 8 + u) * 4096 + 2048 + lane * 8);
#pragma unroll
                for (int u = 0; u < 8; ++u) { const u32x4 w = w8[u];
                    float s = bflo(w.x) * bflo(w.x) + bfhi(w.x) * bfhi(w.x) + bflo(w.y) * bflo(w.y) + bfhi(w.y) * bfhi(w.y) + bflo(w.z) * bflo(w.z) + bfhi(w.z) * bfhi(w.z) + bflo(w.w) * bflo(w.w) + bfhi(w.w) * bfhi(w.w);
                    s = wave_sum(s); if (lane == 0) rtab[wave * 16 + tb * 8 + u] = rsqrtf(s * (1.f / 512.f) + 1e-6f); }
            }
            __syncthreads();
            for (int sub = 0; sub < 4; ++sub)
                transpose128<true>(Zm + (size_t)tok0 * 4096 + 2048 + sub * 128, 4096, (bf16_t*)(ws + O_VNT) + ((size_t)tt * 512 + sub * 128) * 128, 128, lds, tid, rtab, a.in[I_GNG] + l * 512 + sub * 128);
        } else if (task == 3 || task == 4) {
            const int part = task - 3;
            bf16_t* tb = (bf16_t*)(ws + O_TT) + (ctx ? (size_t)bb * 512 * 512 : (size_t)16 * 512 * 512 + (size_t)bb * 512 * 2048) + part * npos + pos0;
            for (int sub = 0; sub < 4; ++sub)
                transpose128<false>(Zm + (size_t)tok0 * 4096 + 2560 + part * 512 + sub * 128, 4096, tb + (size_t)sub * 128 * 2 * npos, 2 * npos, lds, tid, nullptr, nullptr);
        } else {
            const int gi = wave & 3, half = wave >> 2, tsub = lane >> 4, c8 = gi * 16 + (lane & 15);
            const bf16_t* base = Zm + (size_t)(tok0 - pos0) * 4096 + 3584 + c8 * 8;
            bf16_t* outp = (bf16_t*)(ws + O_BR) + (size_t)tok0 * 2048 + 1536 + c8 * 8;
            if (gi == 0) pool_rows<2>(base, outp, pos0, npos, half * 64, tsub);
            else if (gi == 1) pool_rows<4>(base, outp, pos0, npos, half * 64, tsub);
            else if (gi == 2) pool_rows<8>(base, outp, pos0, npos, half * 64, tsub);
            else pool_rows<16>(base, outp, pos0, npos, half * 64, tsub);
        }
    }
}

#define MFMA16(a, b, c) __builtin_amdgcn_mfma_f32_16x16x32_bf16(a, b, c, 0, 0, 0)
struct KVF { bf16x8 k[4]; bf16x8 v[4]; };
struct KVOff { unsigned k0, k1, v[4]; };
__device__ __forceinline__ KVOff kv_off(int lane) {
    const int i = lane & 15, g = lane >> 4; const int ko0 = 8 * (i >> 2) + (i & 3);
    KVOff o; o.k0 = (unsigned)(ko0 * 64 + 8 * g) * 2u; o.k1 = o.k0 + 512u;
#pragma unroll
    for (int dt = 0; dt < 4; ++dt) o.v[dt] = (unsigned)(g * 1024 + dt * 256 + i * 16);
    return o;
}
__device__ __forceinline__ void kv_load(KVF& f, const bf16_t* kp, const bf16_t* vp, const KVOff& o) {
    const char* kc = (const char*)kp; const char* vc = (const char*)vp;
    f.k[0] = *(const bf16x8*)(kc + o.k0); f.k[1] = *(const bf16x8*)(kc + o.k0 + 64); f.k[2] = *(const bf16x8*)(kc + o.k1); f.k[3] = *(const bf16x8*)(kc + o.k1 + 64);
#pragma unroll
    for (int dt = 0; dt < 4; ++dt) f.v[dt] = *(const bf16x8*)(vc + o.v[dt]);
}
struct QSt { f32x4 o[4]; float m, lsum; };
__device__ __forceinline__ void attn_step(const KVF& f, const bf16x8 (&qf)[2], const float (&sb)[8], bool use_sb, QSt& st) {
    f32x4 s0 = {0.f, 0.f, 0.f, 0.f}, s1 = {0.f, 0.f, 0.f, 0.f};
    s0 = MFMA16(f.k[0], qf[0], s0); s0 = MFMA16(f.k[1], qf[1], s0);
    s1 = MFMA16(f.k[2], qf[0], s1); s1 = MFMA16(f.k[3], qf[1], s1);
    float s[8] = {s0[0], s0[1], s0[2], s0[3], s1[0], s1[1], s1[2], s1[3]};
    if (use_sb) {
#pragma unroll
        for (int e = 0; e < 8; ++e) s[e] = sb[e] < -1e29f ? -3e30f : s[e] + sb[e];
    }
    float mx = fmaxf(fmaxf(fmaxf(s[0], s[1]), fmaxf(s[2], s[3])), fmaxf(fmaxf(s[4], s[5]), fmaxf(s[6], s[7])));
    mx = fmaxf(mx, __shfl_xor(mx, 16)); mx = fmaxf(mx, __shfl_xor(mx, 32));
    const float mn = fmaxf(st.m, mx); const float alpha = fast_exp(st.m - mn); st.m = mn;
    float ps = 0.f;
#pragma unroll
    for (int e = 0; e < 8; ++e) { s[e] = fast_exp(s[e] - mn); ps += s[e]; }
    st.lsum = st.lsum * alpha + ps;
#pragma unroll
    for (int dt = 0; dt < 4; ++dt) st.o[dt] *= alpha;
    u32x4 pw; pw.x = cvt_pk_bf16(s[0], s[1]); pw.y = cvt_pk_bf16(s[2], s[3]); pw.z = cvt_pk_bf16(s[4], s[5]); pw.w = cvt_pk_bf16(s[6], s[7]);
    const bf16x8 pf = __builtin_bit_cast(bf16x8, pw);
#pragma unroll
    for (int dt = 0; dt < 4; ++dt) st.o[dt] = MFMA16(f.v[dt], pf, st.o[dt]);
}
__device__ __forceinline__ void attn_step2(const KVF& f0, const KVF& f1, const bf16x8 (&qf)[2], QSt& st) {
    f32x4 s0 = {0.f, 0.f, 0.f, 0.f}, s1 = {0.f, 0.f, 0.f, 0.f}, s2 = {0.f, 0.f, 0.f, 0.f}, s3 = {0.f, 0.f, 0.f, 0.f};
    s0 = MFMA16(f0.k[0], qf[0], s0); s1 = MFMA16(f0.k[2], qf[0], s1); s2 = MFMA16(f1.k[0], qf[0], s2); s3 = MFMA16(f1.k[2], qf[0], s3);
    s0 = MFMA16(f0.k[1], qf[1], s0); s1 = MFMA16(f0.k[3], qf[1], s1); s2 = MFMA16(f1.k[1], qf[1], s2); s3 = MFMA16(f1.k[3], qf[1], s3);
    float s[16] = {s0[0], s0[1], s0[2], s0[3], s1[0], s1[1], s1[2], s1[3], s2[0], s2[1], s2[2], s2[3], s3[0], s3[1], s3[2], s3[3]};
    float mx = fmaxf(fmaxf(fmaxf(s[0], s[1]), fmaxf(s[2], s[3])), fmaxf(fmaxf(s[4], s[5]), fmaxf(s[6], s[7])));
    mx = fmaxf(mx, fmaxf(fmaxf(fmaxf(s[8], s[9]), fmaxf(s[10], s[11])), fmaxf(fmaxf(s[12], s[13]), fmaxf(s[14], s[15]))));
    mx = fmaxf(mx, __shfl_xor(mx, 16)); mx = fmaxf(mx, __shfl_xor(mx, 32));
    const float mn = fmaxf(st.m, mx); const float alpha = fast_exp(st.m - mn); st.m = mn;
    float ps = 0.f;
#pragma unroll
    for (int e = 0; e < 16; ++e) { s[e] = fast_exp(s[e] - mn); ps += s[e]; }
    st.lsum = st.lsum * alpha + ps;
#pragma unroll
    for (int dt = 0; dt < 4; ++dt) st.o[dt] *= alpha;
    u32x4 pw0, pw1; pw0.x = cvt_pk_bf16(s[0], s[1]); pw0.y = cvt_pk_bf16(s[2], s[3]); pw0.z = cvt_pk_bf16(s[4], s[5]); pw0.w = cvt_pk_bf16(s[6], s[7]);
    pw1.x = cvt_pk_bf16(s[8], s[9]); pw1.y = cvt_pk_bf16(s[10], s[11]); pw1.z = cvt_pk_bf16(s[12], s[13]); pw1.w = cvt_pk_bf16(s[14], s[15]);
    const bf16x8 pf0 = __builtin_bit_cast(bf16x8, pw0), pf1 = __builtin_bit_cast(bf16x8, pw1);
#pragma unroll
    for (int dt = 0; dt < 4; ++dt) { st.o[dt] = MFMA16(f0.v[dt], pf0, st.o[dt]); st.o[dt] = MFMA16(f1.v[dt], pf1, st.o[dt]); }
}
__device__ __forceinline__ void attn_store(const QSt& st0, bf16_t* op) {
    QSt st = st0; st.lsum += __shfl_xor(st.lsum, 16); st.lsum += __shfl_xor(st.lsum, 32);
    const float inv = 1.0f / st.lsum;
#pragma unroll
    for (int dt = 0; dt < 4; ++dt) { u32x2 w2; w2.x = cvt_pk_bf16(st.o[dt][0] * inv, st.o[dt][1] * inv); w2.y = cvt_pk_bf16(st.o[dt][2] * inv, st.o[dt][3] * inv); *(u32x2*)(op + 16 * dt) = w2; }
}
__device__ __forceinline__ void local_bias(float (&sb)[8], const LAS float* tab, int dr, int kc0, int g, int cq, int cs) {
    asm volatile("" : "+v"(g));
#pragma unroll
    for (int e = 0; e < 8; ++e) { const int kc = kc0 + 8 * g + e; const bool vis = (kc >= cs) && (kc < cs + 16);
        const float bv = tab[dr * 32 + (vis ? (kc - cq + 15) : 15)]; sb[e] = vis ? bv : -1e30f; }
}

__device__ __forceinline__ void attn_item(const Args& a, int l, int item, int lane, LAS float* tab) {
    unsigned char* ws = a.ws;
    const int q = lane & 15, g = lane >> 4;
    QSt sA, sB;
#pragma unroll
    for (int dt = 0; dt < 4; ++dt) { sA.o[dt] = (f32x4){0.f, 0.f, 0.f, 0.f}; sB.o[dt] = (f32x4){0.f, 0.f, 0.f, 0.f}; }
    sA.m = -1e30f; sA.lsum = 0.f; sB.m = -1e30f; sB.lsum = 0.f;
    float nb0[8];
    int tokq, h;
    if (item < 2048) {
        const int bb = item >> 8; h = (item >> 5) & 7; const int r = (item >> 1) & 15, p = item & 1;
        tokq = NCTXT + bb * 1024 + r * 64 + 32 * p + q;
        bf16x8 qA[2], qB[2];
        { const bf16_t* pp = (const bf16_t*)(ws + O_QP) + (size_t)tokq * 512 + h * 64 + 8 * g; qA[0] = *(const bf16x8*)pp; qA[1] = *(const bf16x8*)(pp + 32); qB[0] = *(const bf16x8*)(pp + 16 * 512); qB[1] = *(const bf16x8*)(pp + 16 * 512 + 32); }
        const bf16_t* ck = (const bf16_t*)(ws + O_CK) + (((size_t)bb * 2 + l) * 8 + h) * 512 * 64;
        const bf16_t* cv = (const bf16_t*)(ws + O_VTC) + (((size_t)bb * 2 + l) * 8 + h) * 64 * 512;
        int rs = r - 4; if (rs < 0) rs = 0; if (rs > 8) rs = 8;
        const int cqA = 32 * p + q, cqB = cqA + 16; int csA = cqA - 8; if (csA < 0) csA = 0; if (csA > 48) csA = 48; int csB = cqB - 8; if (csB < 0) csB = 0; if (csB > 48) csB = 48;
        { const float* rpb = a.in[I_RPB] + (size_t)(l * 8 + h) * 15 * 31;
          float tv[8];
#pragma unroll
          for (int u = 0; u < 8; ++u) { const int i = lane + 64 * u; tv[u] = i < 465 ? rpb[i] : 0.f; }
#pragma unroll
          for (int u = 0; u < 8; ++u) { const int i = lane + 64 * u; if (i < 465) { const int rr = (i * 2115) >> 16; tab[rr * 32 + (i - rr * 31)] = tv[u]; } } }
        const bf16_t* kl = (const bf16_t*)(ws + O_KB) + ((size_t)h * 12288 + NCTXT + bb * 1024) * 64;
        const bf16_t* vl = (const bf16_t*)(ws + O_VT) + ((size_t)h * 1536 + (NCTXT + bb * 1024) / 8) * 512;
        KVF f0, f1; const KVOff oc = kv_off(lane);
#pragma unroll 1
        for (int kb = 0; kb < 16; kb += 2) {
            kv_load(f0, ck + (size_t)kb * 32 * 64, cv + (size_t)kb * 4 * 512, oc);
            kv_load(f1, ck + (size_t)(kb + 1) * 32 * 64, cv + (size_t)(kb + 1) * 4 * 512, oc);
            attn_step2(f0, f1, qA, sA); attn_step2(f0, f1, qB, sB);
        }
        { const bf16_t* p2 = (const bf16_t*)(ws + O_QR) + (size_t)(tokq - NCTXT) * 512 + h * 64 + 8 * g; qA[0] = *(const bf16x8*)p2; qA[1] = *(const bf16x8*)(p2 + 32); qB[0] = *(const bf16x8*)(p2 + 16 * 512); qB[1] = *(const bf16x8*)(p2 + 16 * 512 + 32); }
        const int kcA = (32 * p - 8) < 0 ? 0 : (32 * p - 8), kcB = (32 * p + 8) > 32 ? 32 : (32 * p + 8);
#pragma unroll 1
        for (int wi = 0; wi < 8; ++wi) {
            const int dr = rs + wi - r + 7; const int key0 = (rs + wi) * 64;
            kv_load(f0, kl + (size_t)(key0 + kcA) * 64, vl + (size_t)((key0 + kcA) >> 3) * 512, oc);
            kv_load(f1, kl + (size_t)(key0 + kcB) * 64, vl + (size_t)((key0 + kcB) >> 3) * 512, oc);
            local_bias(nb0, tab, dr, kcA, g, cqA, csA); attn_step(f0, qA, nb0, true, sA);
            local_bias(nb0, tab, dr, kcB, g, cqB, csB); attn_step(f1, qB, nb0, true, sB);
        }
    } else {
        const int it = item - 2048; const int bb = it >> 6; h = (it >> 3) & 7; const int qb = it & 7;
        tokq = bb * 256 + qb * 32 + q;
        bf16x8 qpA[2], qpB[2];
        { const bf16_t* pp = (const bf16_t*)(ws + O_QP) + (size_t)tokq * 512 + h * 64 + 8 * g; qpA[0] = *(const bf16x8*)pp; qpA[1] = *(const bf16x8*)(pp + 32); qpB[0] = *(const bf16x8*)(pp + 16 * 512); qpB[1] = *(const bf16x8*)(pp + 16 * 512 + 32); }
        const bf16_t* kl = (const bf16_t*)(ws + O_KB) + ((size_t)h * 12288 + bb * 256) * 64;
        const bf16_t* vl = (const bf16_t*)(ws + O_VT) + ((size_t)h * 1536 + bb * 32) * 512;
        KVF f0, f1; const KVOff oc = kv_off(lane);
#pragma unroll 1
        for (int kb = 0; kb < 8; kb += 2) {
            kv_load(f0, kl + (size_t)kb * 32 * 64, vl + (size_t)kb * 4 * 512, oc);
            kv_load(f1, kl + (size_t)(kb + 1) * 32 * 64, vl + (size_t)(kb + 1) * 4 * 512, oc);
            attn_step2(f0, f1, qpA, sA); attn_step2(f0, f1, qpB, sB);
        }
    }
    bf16_t* op = (bf16_t*)(ws + O_BR) + (size_t)tokq * 2048 + h * 64 + 4 * g;
    attn_store(sA, op); attn_store(sB, op + (size_t)16 * 2048);
}

__device__ __forceinline__ void gmlp_item(const Args& a, int l, int item, int lane) {
    unsigned char* ws = a.ws;
    const int tt = item >> 4, gg = (item >> 2) & 3, pb = item & 3;
    const int i = lane & 15, g = lane >> 4;
    const bf16_t* A = (const bf16_t*)(ws + O_VNT) + ((size_t)tt * 512 + gg * 128) * 128;
    const bf16_t* B = (const bf16_t*)(ws + O_WSB) + ((size_t)(l * 4 + gg) * 128 + pb * 32) * 128;
    f32x4 acc[8][2];
#pragma unroll
    for (int mi = 0; mi < 8; ++mi) { acc[mi][0] = (f32x4){0.f, 0.f, 0.f, 0.f}; acc[mi][1] = (f32x4){0.f, 0.f, 0.f, 0.f}; }
    const unsigned offA = (unsigned)(i * 128 + 8 * g) * 2u, offB = offA;
    const char* Ac = (const char*)A; const char* Bc = (const char*)B;
#define GM_LOAD(af, b0, b1, ks) do { b0 = *(const bf16x8*)(Bc + offB + (ks) * 64); b1 = *(const bf16x8*)(Bc + offB + 16 * 256 + (ks) * 64); \
        _Pragma("unroll") for (int mi = 0; mi < 8; ++mi) af[mi] = *(const bf16x8*)(Ac + offA + mi * 16 * 256 + (ks) * 64); } while (0)
#define GM_MMA(af, b0, b1) do { _Pragma("unroll") for (int mi = 0; mi < 8; ++mi) { acc[mi][0] = MFMA16(af[mi], b0, acc[mi][0]); acc[mi][1] = MFMA16(af[mi], b1, acc[mi][1]); } } while (0)
    bf16x8 afA[8], afB[4], bA0, bA1, bB0, bB1;
#define GM_LOADH(af, b0, b1, ks) do { b0 = *(const bf16x8*)(Bc + offB + (ks) * 64); b1 = *(const bf16x8*)(Bc + offB + 16 * 256 + (ks) * 64); \
        _Pragma("unroll") for (int mi = 0; mi < 4; ++mi) af[mi] = *(const bf16x8*)(Ac + offA + mi * 16 * 256 + (ks) * 64); } while (0)
#define GM_STEP(ks, last) do { \
        _Pragma("unroll") for (int mi = 0; mi < 4; ++mi) afA[mi] = afB[mi]; bA0 = bB0; bA1 = bB1; \
        _Pragma("unroll") for (int mi = 4; mi < 8; ++mi) afA[mi] = *(const bf16x8*)(Ac + offA + mi * 16 * 256 + (ks) * 64); \
        if (!(last)) GM_LOADH(afB, bB0, bB1, (ks) + 1); \
        GM_MMA(afA, bA0, bA1); } while (0)
    GM_LOADH(afB, bB0, bB1, 0);
    GM_STEP(0, false); GM_STEP(1, false); GM_STEP(2, false); GM_STEP(3, true);
#undef GM_LOADH
#undef GM_STEP
#undef GM_LOAD
#undef GM_MMA
    const bf16_t* Zm = (const bf16_t*)(ws + O_ZM);
#pragma unroll
    for (int nj = 0; nj < 2; ++nj) { const int p = pb * 32 + 16 * nj + i; const int tok = tt * 128 + p; const float bs = a.in[I_BSP][(l * 4 + gg) * 128 + p];
        u32x2 uw[8];
#pragma unroll
        for (int mi = 0; mi < 8; ++mi) uw[mi] = *(const u32x2*)(Zm + (size_t)tok * 4096 + 1536 + gg * 128 + 16 * mi + 4 * g);
#pragma unroll
        for (int mi = 0; mi < 8; ++mi) { const int c = gg * 128 + 16 * mi + 4 * g; const f32x4 v = acc[mi][nj];
            u32x2 ow; ow.x = cvt_pk_bf16(bflo(uw[mi].x) * (v[0] + bs), bfhi(uw[mi].x) * (v[1] + bs)); ow.y = cvt_pk_bf16(bflo(uw[mi].y) * (v[2] + bs), bfhi(uw[mi].y) * (v[3] + bs));
            *(u32x2*)((bf16_t*)(ws + O_BR) + (size_t)tok * 2048 + 512 + c) = ow; } }
}

#define XB_TMO      128
#define XB_XCNT(j)  (256  + 64 * (j))
#define XB_XSUB(j)  (1280 + 64 * (j))
#define XB_XGEN(j)  (2304 + 64 * (j))
#define XB_TOP      3328
#define XB_TOPGEN   3392
#define XCD_BAR_WORDS 3456
#define XB_SPIN_CAP (1u << 22)
constexpr int CW_BAR = 4096, CW_FLAG = 8192;
__device__ __forceinline__ unsigned xb_ld(unsigned* p)              { return __hip_atomic_load(p, __ATOMIC_RELAXED, __HIP_MEMORY_SCOPE_AGENT); }
__device__ __forceinline__ unsigned xb_add(unsigned* p, unsigned v) { return __hip_atomic_fetch_add(p, v, __ATOMIC_RELAXED, __HIP_MEMORY_SCOPE_AGENT); }
__device__ __forceinline__ unsigned xb_xcc_id() { return (unsigned)__builtin_amdgcn_s_getreg((3 << 11) | 20) & 0xFu; }
#define XB_SPIN(cond, bar) do { unsigned _sp = 0; while (cond) { __builtin_amdgcn_s_sleep(1); \
    if ((++_sp & 255u) == 0u) { if (xb_ld(&(bar)[XB_TMO])) break; if (_sp > XB_SPIN_CAP) { atomicAdd(&(bar)[XB_TMO], 1u); break; } } } } while (0)
struct XcdBarrier { unsigned* bar; unsigned x; volatile LAS unsigned* st; };
__device__ __forceinline__ XcdBarrier xcd_barrier_post(unsigned* bar, volatile LAS unsigned* st) {
    XcdBarrier b; b.bar = bar; b.x = xb_xcc_id(); b.st = st;
    if (threadIdx.x == 0) (void)xb_add(&bar[XB_XCNT(b.x)], 1u);
    return b;
}
__device__ __forceinline__ void xcd_barrier_complete(unsigned* bar, unsigned x, unsigned& nloc, unsigned& nx) {
    const unsigned G = gridDim.x * gridDim.y * gridDim.z;
    unsigned sum, cnt, mine, sp = 0u;
    for (;;) {
        sum = 0u; cnt = 0u; mine = 0u;
#pragma unroll
        for (unsigned j = 0; j < 16; ++j) { const unsigned c = xb_ld(&bar[XB_XCNT(j)]); sum += c; cnt += (c > 0u) ? 1u : 0u; mine = (j == x) ? c : mine; }
        if (sum == G) break;
        __builtin_amdgcn_s_sleep(1);
        if ((++sp & 255u) == 0u) { if (xb_ld(&bar[XB_TMO])) break; if (sp > XB_SPIN_CAP) { atomicAdd(&bar[XB_TMO], 1u); break; } }
    }
    nloc = mine > 0u ? mine : 1u; nx = cnt > 0u ? cnt : 1u;
}
__device__ __forceinline__ void xcd_barrier(const XcdBarrier& b) {
    asm volatile("s_waitcnt vmcnt(0)" ::: "memory");
    __syncthreads();
    if (threadIdx.x == 0) {
        unsigned* bar = b.bar;
        __builtin_amdgcn_s_waitcnt(0);
        unsigned nloc = b.st[0], nx = b.st[1];
        if (nloc == 0u) { xcd_barrier_complete(bar, b.x, nloc, nx); b.st[0] = nloc; b.st[1] = nx; }
        const unsigned old = xb_add(&bar[XB_XSUB(b.x)], 1u);
        const unsigned gen = old / nloc;
        if (old + 1u == (gen + 1u) * nloc) {
            __builtin_amdgcn_fence(__ATOMIC_RELEASE, "agent");
            asm volatile("s_waitcnt vmcnt(0)" ::: "memory");
            const unsigned og = xb_add(&bar[XB_TOP], 1u);
            const unsigned tg = og / nx;
            if (og + 1u == (tg + 1u) * nx) xb_add(&bar[XB_TOPGEN], 1u);
            else XB_SPIN(xb_ld(&bar[XB_TOPGEN]) == tg, bar);
            __builtin_amdgcn_fence(__ATOMIC_ACQUIRE, "agent");
            xb_add(&bar[XB_XGEN(b.x)], 1u);
            asm volatile("s_waitcnt vmcnt(0)" ::: "memory");
        } else {
            XB_SPIN(xb_ld(&bar[XB_XGEN(b.x)]) == gen, bar);
            __builtin_amdgcn_fence(__ATOMIC_ACQUIRE, "agent");
            asm volatile("s_waitcnt vmcnt(0)" ::: "memory");
        }
    }
    __syncthreads();
}

__global__ void __launch_bounds__(512, 2) fwd(Args a) {
    extern __shared__ __attribute__((aligned(16))) unsigned char lds_raw[];
    LAS unsigned char* lds = (LAS unsigned char*)lds_raw;
    cg::grid_group grid = cg::this_grid();
    int tid0 = threadIdx.x; const int wave = __builtin_amdgcn_readfirstlane(tid0 >> 6), G = gridDim.x, bid = blockIdx.x;
#define OPQ int tid = tid0; asm volatile("" : "+v"(tid)); const int lane = tid & 63; (void)lane;
    unsigned char* ws = a.ws;
    const int lo = a.ph_lo, hi = a.ph_hi;
    int ph = 0;
#ifndef EN
#define EN 0xFFFF
#endif
#define RUN(k) ((k) >= lo && (k) < hi)
#define ENB(t) if constexpr ((EN >> (t)) & 1)
#ifndef DUP
#define DUP 0
#endif
#define REP(t) _Pragma("nounroll") for (int rep = 0; rep < ((((DUP) >> (t)) & 1) ? 2 : 1); ++rep)
#define REPSYNC(t) do { if (((((DUP) >> (t)) & 1)) && rep == 0) xcd_barrier(xbar); } while (0)
#define SEAM(k) do { if ((k) + 1 < hi) xcd_barrier(xbar); } while (0)

    const bool ksplit = (G == 256) && (hi - lo > 1);
    XcdBarrier xbar; xbar.bar = (unsigned*)(ws + O_CTL) + CW_BAR; xbar.x = 0; xbar.st = (volatile LAS unsigned*)(lds + 131072 + 64);
    if (hi - lo > 1) {
        if (tid0 < 2) xbar.st[tid0] = 0u;
        if (bid == 0) { for (int i = tid0; i < XCD_BAR_WORDS; i += 512) xbar.bar[i] = 0u; if (tid0 < 16) ((unsigned*)(ws + O_CTL))[64 * tid0] = 0u; if (tid0 < 32) ((unsigned*)(ws + O_CTL))[1024 + 64 * tid0] = 0u;
            for (int i = tid0; i < 12288; i += 512) ((unsigned*)(ws + O_CTL))[CW_FLAG + i] = 0u; }
        grid.sync();
        xbar = xcd_barrier_post(xbar.bar, xbar.st);
    }
    if (RUN(0)) { REP(0) { ENB(0) { OPQ phase_p0(a, lds, tid, lane, wave, G, bid); } REPSYNC(0); } SEAM(0); }
    if (RUN(1)) { ENB(1) {
#pragma nounroll
        for (int pass = 0; pass < 2; ++pass) {
            pg8::SchedFold S{(const char*)(ws + (pass ? O_WBD : O_CS)), (const char*)(ws + (pass ? O_BDP : O_WFN)), pass, pass ? bid - 64 : bid};
            pg8::EpiStore E{(bf16_t*)(ws + (pass ? O_WBT : O_WINT)), 2048};
            pg8::gemm_phase(lds, pass ? 512 : 256, pass ? 512 : 128, pass ? 512 : 256, S, E); }
        { OPQ phase_p1_modreduce(a, tid, G, bid); } }
        SEAM(1);
    }
    for (int l = 0; l < 2; ++l) {
        const int p0 = 2 + 9 * l;
        const float* mod_l = (const float*)(ws + O_MOD) + (size_t)l * NCOND * 6 * 2048;
        if (RUN(p0 + 0)) {
#ifdef EXP_NANFILL
            { OPQ for (int i = bid * 512 + tid; i < 12288 * 1024; i += G * 512) ((u32x4*)(ws + O_ZG))[i] = (u32x4){0x7fc07fc0u, 0x7fc07fc0u, 0x7fc07fc0u, 0x7fc07fc0u}; }
#endif
            REP(2) { ENB(2) { OPQ phase_norm(a, l, 0, l == 0, lane, wave, G, bid); } REPSYNC(2); } SEAM(p0 + 0); }
        if (RUN(p0 + 1)) { REP(3) { ENB(3) {
            pg8::SchedMN S{(const char*)(ws + O_H), (const char*)(ws + O_WINT) + (size_t)l * 12288 * 2048 * 2, 2048, 2048, 48, 48, G, bid, 0, 48 * 48, 0, 0, 0, 0};
            pg8::EpiZ E{(bf16_t*)(ws + O_ZM), (bf16_t*)(ws + O_ZG), a.in[I_BGATE] + (size_t)l * 8192};
            pg8::gemm_phase(lds, 2048, 2048, 2048, S, E); } REPSYNC(3); }
            SEAM(p0 + 1);
        }
        if (RUN(p0 + 2)) { REP(4) { ENB(4) { OPQ phase_prep(a, l, lds, tid, lane, wave, G, bid); } REPSYNC(4); } SEAM(p0 + 2); }
        if (RUN(p0 + 3)) { REP(5) { ENB(5) {
#pragma nounroll
            for (int pass = 0; pass < 2; ++pass) { const int lat = 1 - pass, Kd = lat ? 2048 : 512;
              pg8::SchedDFT S{(const char*)(ws + (lat ? O_DFT1024 : O_DFT256)), (const char*)(ws + O_TT) + (lat ? (size_t)16 * 512 * 512 * 2 : 0), lat, lat ? bid : bid - 64}; pg8::EpiStore E{(bf16_t*)(ws + O_BR), 2048};
              pg8::gemm_phase(lds, Kd, Kd, Kd, S, E); }
            } ENB(10) { OPQ
            unsigned* cbase = (unsigned*)(ws + O_CTL) + 1024 + (l + 2 * rep) * 8 * 64;
            const int myx = (int)(xb_xcc_id() & 7u);
            constexpr int CPX = (3072 + 1536) / 8;
#pragma unroll 1
            for (int k = 0; k < 8; ++k) {
                const int x = (myx + k) & 7; unsigned* ctr = cbase + x * 64;
                for (;;) {
                    int c = CPX;
                    if (lane == 0) { if (__hip_atomic_load(ctr, __ATOMIC_RELAXED, __HIP_MEMORY_SCOPE_AGENT) < (unsigned)CPX) c = (int)atomicAdd(ctr, 1u); }
                    c = __builtin_amdgcn_readfirstlane(c);
                    if (c >= CPX) break;
                    const int idx = (((c >> 5) * 8 + x) << 5) + (c & 31);
                    if (idx < 3072) attn_item(a, l, idx, lane, (LAS float*)(lds + 131072 + 512 + wave * 1920)); else gmlp_item(a, l, idx - 3072, lane);
                }
            } } REPSYNC(5); }
            SEAM(p0 + 3);
        }
        if (RUN(p0 + 4)) { REP(6) { ENB(6) {
            const int nps = ksplit ? 2 : 1;
#pragma nounroll
            for (int pass = 0; pass < nps; ++pass) {
                pg8::SchedMN S{(const char*)(ws + O_BR), (const char*)(ws + O_WBT) + (size_t)l * DM * DM * 2, 2048, 2048, 48, 8, G, bid, 0, ksplit ? 256 : 384, pass, 256, 128, 1024 * 2};
                pg8::EpiBR E{(const bf16_t*)(ws + O_ZG), (bf16_t*)(ws + O_H), (float*)(ws + O_ZM), (unsigned*)(ws + O_CTL) + CW_FLAG + (4 + l) * 128 * 16};
                pg8::gemm_phase(lds, 2048, 2048, pass ? 1024 : 2048, S, E); } } REPSYNC(6); }
            SEAM(p0 + 4);
        }
        if (RUN(p0 + 5)) { ENB(7) {
            const int nps = ksplit ? 2 : 1;
#pragma nounroll
            for (int pass = 0; pass < nps; ++pass) {
                pg8::SchedMN S{(const char*)(ws + O_H), (const char*)(ws + O_WOT) + (size_t)l * DM * DM * 2, 2048, 2048, 48, 8, G, bid, 0, ksplit ? 256 : 384, pass, 256, 128, 1024 * 2};
                pg8::EpiRes E{l == 0 ? a.in[I_XP] : a.out, l == 0 ? a.in[I_XS] : a.out + (size_t)NCTXT * DM, a.out, mod_l, 2, (float*)(ws + O_ZM), (unsigned*)(ws + O_CTL) + CW_FLAG + (l * 2 + 0) * 128 * 16};
                pg8::gemm_phase(lds, 2048, 2048, pass ? 1024 : 2048, S, E); } }
            SEAM(p0 + 5);
        }
        if (RUN(p0 + 6)) { ENB(2) { OPQ phase_norm(a, l, 3, false, lane, wave, G, bid); } SEAM(p0 + 6); }
        if (RUN(p0 + 7)) { REP(8) { ENB(8) {
            pg8::SchedMN S{(const char*)(ws + O_H), (const char*)(ws + O_W1T) + (size_t)l * DFF * DM * 2, 2048, 2048, 48, 32, G, bid, 0, 48 * 32, 0, 0, 0, 0};
            pg8::EpiHid E{(bf16_t*)(ws + O_ZG)};
            pg8::gemm_phase(lds, 2048, 2048, 2048, S, E); } REPSYNC(8); }
            SEAM(p0 + 7);
        }
        if (RUN(p0 + 8)) { ENB(9) {
            const int nps = ksplit ? 2 : 1;
#pragma nounroll
            for (int pass = 0; pass < nps; ++pass) {
                pg8::SchedMN S{(const char*)(ws + O_ZG), (const char*)(ws + O_W2T) + (size_t)l * DM * DFF * 2, 8192, 8192, 48, 8, G, bid, 0, ksplit ? 256 : 384, pass, 256, 128, 4096 * 2};
                pg8::EpiRes E{a.out, a.out + (size_t)NCTXT * DM, a.out, mod_l, 5, (float*)(ws + O_ZM), (unsigned*)(ws + O_CTL) + CW_FLAG + (l * 2 + 1) * 128 * 16};
                pg8::gemm_phase(lds, 8192, 8192, pass ? 4096 : 8192, S, E); } }
            SEAM(p0 + 8);
        }
    }
    (void)ph;
}

extern "C" void kernel_launch(void* const* d_in, const int* in_sizes, int n_in, void* d_out, int out_size, void* d_ws, size_t ws_size, hipStream_t stream) {
    static int grid = 0;
    if (grid == 0) {
        if (n_in != 24 || ws_size < WS_NEED) { fprintf(stderr, "kernel_launch: need 24 inputs and %zu B of workspace (got %d, %zu)\n", (size_t)WS_NEED, n_in, ws_size); grid = -1; return; }
        int dev = 0, cus = 0, per_cu = 0;
        hipGetDevice(&dev); hipDeviceGetAttribute(&cus, hipDeviceAttributeMultiprocessorCount, dev);
        if (hipFuncSetAttribute((const void*)fwd, hipFuncAttributeMaxDynamicSharedMemorySize, LDS_BYTES) != hipSuccess) { fprintf(stderr, "kernel_launch: hipFuncSetAttribute failed\n"); grid = -1; return; }
        if (hipOccupancyMaxActiveBlocksPerMultiprocessor(&per_cu, (const void*)fwd, 512, LDS_BYTES) != hipSuccess || per_cu < 1) { fprintf(stderr, "kernel_launch: occupancy query says %d\n", per_cu); per_cu = 1; }
        (void)hipGetLastError();
        grid = cus;
    }
    if (grid < 0) return;
    Args a{};
    for (int i = 0; i < 24; ++i) a.in[i] = (const float*)d_in[i];
    a.out = (float*)d_out; a.ws = (unsigned char*)d_ws;
#if N_LAUNCH_MODE == 1
    a.ph_lo = 0; a.ph_hi = NPHASE;
    void* args[] = {&a};
    hipError_t e = hipLaunchCooperativeKernel((const void*)fwd, dim3(grid), dim3(512), args, LDS_BYTES, stream);
    if (e != hipSuccess) fprintf(stderr, "kernel_launch: cooperative launch failed: %s (grid %d)\n", hipGetErrorString(e), grid);
#else
    for (int p = 0; p < NPHASE; ++p) { a.ph_lo = p; a.ph_hi = p + 1; hipLaunchKernelGGL(fwd, dim3(grid), dim3(512), LDS_BYTES, stream, a); }
#endif
}
```
